# Optimizing an MI355X kernel written in HIP

```python
import math
import jax
import jax.numpy as jnp
from jax import lax
import numpy as np

D_MODEL = 2048
BATCH = 1
SEQ = 8192
DEPTH = 4

PLE_DIM = 256
D_FF = 5632
N_BRANCH = 3
MIX_W = D_MODEL // 2
N_NORMS = 8
HALF = 0.5
EPS = 1e-6

RW_HEAD = 64
RW_HEADS = MIX_W // RW_HEAD
RW_DECAY_LORA = 64
RW_AAA_LORA = 64
RW_GATE_LORA = 160
RW_LNX_EPS = 64e-5
RW_COLS = 3 * MIX_W + RW_DECAY_LORA + RW_AAA_LORA + RW_GATE_LORA

DSA_HEAD_DIM = 128
DSA_HEADS = MIX_W // DSA_HEAD_DIM
DSA_KV_RANK = 256
IDX_HEADS = 16
IDX_DIM = 64
TOPK_MAX = 256
Q_BLOCK = 128
DSA_COLS = DSA_HEADS * DSA_HEAD_DIM + DSA_KV_RANK + IDX_HEADS * IDX_DIM + IDX_DIM + IDX_HEADS

ML_HEADS = 4
ML_V = MIX_W // ML_HEADS
ML_QK = ML_V // 2
ML_CONV = 4
ML_CHUNK = 128
ML_COLS = 2 * ML_HEADS * ML_QK + 2 * MIX_W + 2 * ML_HEADS

GATE_COLS = N_BRANCH * D_MODEL
N_IN = RW_COLS + DSA_COLS + ML_COLS + GATE_COLS

REL_BUCKETS = 32
REL_MAX_DIST = 128

kernel_name = 'hybrid_rwkv7_dsa_mlstm_macaron_trunk'


def _split(z, sizes):
    out, off = [], 0
    for s in sizes:
        out.append(z[..., off:off + s])
        off += s
    return out


def rms_norm(x, g):
    xf = x.astype(jnp.float32)
    y = xf * lax.rsqrt(jnp.mean(xf * xf, axis=-1, keepdims=True) + EPS)
    return (y * g.astype(jnp.float32)).astype(x.dtype)


def swiglu(x, w_gate, w_up, w_down):
    return (jax.nn.silu(x @ w_gate) * (x @ w_up)) @ w_down


def shift_right(z):
    return jnp.pad(z, ((0, 0), (1, 0), (0, 0)))[:, :-1]


def causal_dwconv(z, w):
    k_w, c = w.shape
    return lax.conv_general_dilated(z, w[:, None, :].astype(z.dtype), window_strides=(1,),
                                    padding=[(k_w - 1, 0)],
                                    dimension_numbers=('NWC', 'WIO', 'NWC'),
                                    feature_group_count=c)


def t5_bucket(dist):
    max_exact = REL_BUCKETS // 2
    n = jnp.maximum(dist, 0)
    nf = jnp.maximum(n, 1).astype(jnp.float32)
    large = max_exact + (jnp.log(nf / max_exact) / math.log(REL_MAX_DIST / max_exact)
                         * (REL_BUCKETS - max_exact)).astype(jnp.int32)
    large = jnp.minimum(large, REL_BUCKETS - 1)
    return jnp.where(n < max_exact, n, large)


def _rwkv7_step(state, inp):
    r_t, w_t, k_t, v_t, a_t, b_t = inp
    sa = jnp.einsum('bhvk,bhk->bhv', state, a_t)
    state = (state * w_t[:, :, None, :] + sa[..., None] * b_t[:, :, None, :]
             + v_t[..., None] * k_t[:, :, None, :])
    y = jnp.einsum('bhvk,bhk->bhv', state, r_t)
    return state, y


def rwkv7_mixer(z, mu, w0, w_up, a0, a_up, g_up, k_k, k_a, r_k, lnx_g, lnx_b):
    B, T, _ = z.shape
    H, N = RW_HEADS, RW_HEAD
    f32 = jnp.float32
    z = z + (shift_right(z) - z) * mu
    r, k, v, wd, ad, gd = _split(z, (MIX_W, MIX_W, MIX_W, RW_DECAY_LORA, RW_AAA_LORA, RW_GATE_LORA))
    w_log = -jax.nn.softplus(-(w0 + jnp.tanh(wd) @ w_up)) - 0.5
    decay = jnp.exp(-jnp.exp(w_log.astype(f32)))
    a = jax.nn.sigmoid((a0 + ad @ a_up).astype(f32))
    g = jax.nn.sigmoid(gd) @ g_up
    kk = (k * k_k).astype(f32).reshape(B, T, H, N)
    kk = kk / jnp.maximum(jnp.sqrt(jnp.sum(kk * kk, axis=-1, keepdims=True)), 1e-12)
    k = k.astype(f32) * (1.0 + (a - 1.0) * k_a)

    def heads(t):
        return t.astype(f32).reshape(B, T, H, N)

    rh, wh, kh, vh, ah = heads(r), heads(decay), heads(k), heads(v), heads(a)
    aa = -kk
    bb = kk * ah
    xs = tuple(jnp.moveaxis(t, 1, 0) for t in (rh, wh, kh, vh, aa, bb))
    s0 = jnp.zeros((B, H, N, N), f32)
    _, y = lax.scan(_rwkv7_step, s0, xs)
    y = jnp.moveaxis(y, 0, 1)
    mean = jnp.mean(y, axis=-1, keepdims=True)
    var = jnp.mean(jnp.square(y - mean), axis=-1, keepdims=True)
    y = ((y - mean) * lax.rsqrt(var + RW_LNX_EPS)).reshape(B, T, MIX_W) * lnx_g + lnx_b
    bonus = jnp.sum(rh * kh * r_k.reshape(H, N), axis=-1, keepdims=True) * vh
    y = y + bonus.reshape(B, T, MIX_W)
    return (y * g).astype(z.dtype)


def dsa_mixer(q, ckv, q_idx, k_idx, w_idx, ckv_g, kidx_g, w_uk, w_uv, rel_bias):
    B, T, _ = q.shape
    n_blk = T // Q_BLOCK
    topk = min(TOPK_MAX, T // 4)
    f32 = jnp.float32
    c = rms_norm(ckv, ckv_g)
    k_i = rms_norm(k_idx, kidx_g).astype(f32)
    q_lat = jnp.einsum('bthd,hdr->bthr', q.reshape(B, T, DSA_HEADS, DSA_HEAD_DIM), w_uk)
    q_i = q_idx.reshape(B, T, IDX_HEADS, IDX_DIM).astype(f32)
    w_i = w_idx.astype(f32) * (IDX_HEADS ** -0.5)
    key_pos = jnp.arange(T)

    def to_blocks(t):
        return jnp.moveaxis(t.reshape((B, n_blk, Q_BLOCK) + t.shape[2:]), 1, 0)

    def attend_block(args):
        blk, ql, qi, wi = args
        t_pos = blk * Q_BLOCK + jnp.arange(Q_BLOCK)
        rel = jnp.einsum('bqhd,bsd->bqhs', qi, k_i) * (IDX_DIM ** -0.5)
        score = jnp.einsum('bqh,bqhs->bqs', wi, jax.nn.relu(rel))
        score = jnp.where((key_pos[None, :] <= t_pos[:, None])[None], score, -jnp.inf)
        _, idx = lax.top_k(score, topk)
        c_sel = jax.vmap(lambda cb, ib: cb[ib])(c, idx)
        dist = t_pos[None, :, None] - idx
        bias = jnp.moveaxis(rel_bias[t5_bucket(dist)], -1, 1)
        logits = (jnp.einsum('bqhr,bqkr->bhqk', ql, c_sel).astype(f32)
                  * (DSA_HEAD_DIM ** -0.5) + bias)
        logits = jnp.where((dist >= 0)[:, None], logits, -jnp.inf)
        probs = jax.nn.softmax(logits, axis=-1).astype(c.dtype)
        return jnp.einsum('bhqk,bqkr->bqhr', probs, c_sel)

    o_lat = lax.map(attend_block, (jnp.arange(n_blk), to_blocks(q_lat), to_blocks(q_i), to_blocks(w_i)))
    o_lat = jnp.moveaxis(o_lat, 0, 1).reshape(B, T, DSA_HEADS, DSA_KV_RANK)
    out = jnp.einsum('bthr,hrd->bthd', o_lat, w_uv)
    return out.reshape(B, T, MIX_W)


def mlstm_mixer(q, k, v, o, ig, fg, conv_w, b_i, b_f, hn_g):
    B, T, _ = q.shape
    H, dk, dv, L = ML_HEADS, ML_QK, ML_V, ML_CHUNK
    nc = T // L
    f32 = jnp.float32
    qk = jax.nn.silu(causal_dwconv(jnp.concatenate([q, k], axis=-1), conv_w))
    q, k = qk[..., :H * dk], qk[..., H * dk:]

    def chunks(t, d):
        return t.astype(f32).reshape(B, nc, L, H, d).transpose(1, 0, 3, 2, 4)

    def gate_chunks(t):
        return t.reshape(B, nc, L, H).transpose(1, 0, 3, 2)

    qc = chunks(q, dk) * (dk ** -0.5)
    kc = chunks(k, dk)
    vc = chunks(v, dv)
    li = gate_chunks((ig + b_i).astype(f32))
    lf = gate_chunks(jax.nn.log_sigmoid((fg + b_f).astype(f32)))
    gc = jnp.cumsum(lf, axis=-1)
    tril = jnp.tril(jnp.ones((L, L), dtype=bool))

    def chunk_step(carry, inp):
        c_st, n_st, m_st = carry
        q_c, k_c, v_c, g_c, i_c = inp
        a_log = g_c + m_st[..., None]
        d_log = g_c[..., :, None] - g_c[..., None, :] + i_c[..., None, :]
        d_log = jnp.where(tril, d_log, -jnp.inf)
        m_q = jnp.maximum(a_log, jnp.max(d_log, axis=-1))
        inter = jnp.exp(a_log - m_q)
        s_w = jnp.einsum('bhjd,bhsd->bhjs', q_c, k_c) * jnp.exp(d_log - m_q[..., None])
        num = (inter[..., None] * jnp.einsum('bhjd,bhde->bhje', q_c, c_st)
               + jnp.einsum('bhjs,bhse->bhje', s_w, v_c))
        den = inter * jnp.einsum('bhjd,bhd->bhj', q_c, n_st) + jnp.sum(s_w, axis=-1)
        h = num / jnp.maximum(jnp.abs(den), jnp.exp(-m_q))[..., None]
        g_tot = g_c[..., -1]
        w_log = g_tot[..., None] - g_c + i_c
        m_new = jnp.maximum(g_tot + m_st, jnp.max(w_log, axis=-1))
        carry_decay = jnp.exp(g_tot + m_st - m_new)
        kw = k_c * jnp.exp(w_log - m_new[..., None])[..., None]
        c_new = carry_decay[..., None, None] * c_st + jnp.einsum('bhsd,bhse->bhde', kw, v_c)
        n_new = carry_decay[..., None] * n_st + jnp.sum(kw, axis=2)
        return (c_new, n_new, m_new), h

    init = (jnp.zeros((B, H, dk, dv), f32), jnp.zeros((B, H, dk), f32), jnp.zeros((B, H), f32))
    _, h = lax.scan(chunk_step, init, (qc, kc, vc, gc, li))
    h = h.transpose(1, 0, 3, 2, 4).reshape(B, T, H, dv)
    h = h * lax.rsqrt(jnp.mean(h * h, axis=-1, keepdims=True) + EPS) * hn_g.reshape(H, dv)
    return (jax.nn.sigmoid(o.astype(f32)) * h.reshape(B, T, H * dv)).astype(q.dtype)


def setup_inputs(seed: int = 0) -> dict:
    key = jax.random.key(seed)
    keys = iter(jax.random.split(key, 48))
    f32 = jnp.float32
    L, D, F = DEPTH, D_MODEL, D_FF

    def normal(shape, scale):
        return jax.random.normal(next(keys), shape, f32) * scale

    def gain(shape):
        return 1.0 + 0.02 * jax.random.normal(next(keys), shape, f32)

    return {
        'x': normal((BATCH, SEQ, D), 1.0),
        'p': normal((L, BATCH, SEQ, PLE_DIM), 1.0),
        'norm_gains': gain((L, N_NORMS, D)),
        'ffn1_gate': normal((L, D, F), D ** -0.5),
        'ffn1_up': normal((L, D, F), D ** -0.5),
        'ffn1_down': normal((L, F, D), F ** -0.5),
        'w_in': normal((L, D, N_IN), D ** -0.5),
        'rw_mu': jax.random.uniform(next(keys), (L, RW_COLS), f32),
        'rw_w0': jax.random.uniform(next(keys), (L, MIX_W), f32, minval=-6.0, maxval=-1.0),
        'rw_w_up': normal((L, RW_DECAY_LORA, MIX_W), 0.1 * RW_DECAY_LORA ** -0.5),
        'rw_a0': normal((L, MIX_W), 0.1),
        'rw_a_up': normal((L, RW_AAA_LORA, MIX_W), 0.1 * RW_AAA_LORA ** -0.5),
        'rw_g_up': normal((L, RW_GATE_LORA, MIX_W), RW_GATE_LORA ** -0.5),
        'rw_k_k': 0.85 + normal((L, MIX_W), 0.02),
        'rw_k_a': gain((L, MIX_W)),
        'rw_r_k': normal((L, MIX_W), 0.1),
        'rw_lnx_g': gain((L, MIX_W)),
        'rw_lnx_b': normal((L, MIX_W), 0.02),
        'dsa_ckv_g': gain((L, DSA_KV_RANK)),
        'dsa_kidx_g': gain((L, IDX_DIM)),
        'dsa_w_uk': normal((L, DSA_HEADS, DSA_HEAD_DIM, DSA_KV_RANK), DSA_KV_RANK ** -0.5),
        'dsa_w_uv': normal((L, DSA_HEADS, DSA_KV_RANK, DSA_HEAD_DIM), DSA_KV_RANK ** -0.5),
        'rel_bias': normal((REL_BUCKETS, DSA_HEADS), 0.5),
        'ml_conv': normal((L, ML_CONV, 2 * ML_HEADS * ML_QK), ML_CONV ** -0.5),
        'ml_b_i': normal((L, ML_HEADS), 0.1),
        'ml_b_f': 3.0 + normal((L, ML_HEADS), 0.5),
        'ml_hn_g': gain((L, MIX_W)),
        'w_branch': normal((L, N_BRANCH, MIX_W, D), MIX_W ** -0.5),
        'w_out': normal((L, D, D), D ** -0.5),
        'ffn2_gate': normal((L, D, F), D ** -0.5),
        'ffn2_up': normal((L, D, F), D ** -0.5),
        'ffn2_down': normal((L, F, D), F ** -0.5),
        'ple_proj': normal((L, PLE_DIM, D), PLE_DIM ** -0.5),
        'ple_gate': normal((L, D, D), D ** -0.5),
    }


def reference(x, p, norm_gains, ffn1_gate, ffn1_up, ffn1_down, w_in, rw_mu, rw_w0, rw_w_up,
              rw_a0, rw_a_up, rw_g_up, rw_k_k, rw_k_a, rw_r_k, rw_lnx_g, rw_lnx_b, dsa_ckv_g,
              dsa_kidx_g, dsa_w_uk, dsa_w_uv, rel_bias, ml_conv, ml_b_i, ml_b_f, ml_hn_g,
              w_branch, w_out, ffn2_gate, ffn2_up, ffn2_down, ple_proj, ple_gate):
    B, T, _ = x.shape
    h = x
    for i in range(DEPTH):
        ng = norm_gains[i]
        f = swiglu(rms_norm(h, ng[0]), ffn1_gate[i], ffn1_up[i], ffn1_down[i])
        h = h + HALF * rms_norm(f, ng[1])

        u = rms_norm(h, ng[2])
        z = u @ w_in[i]
        z_rw, z_dsa, z_ml, z_gate = _split(z, (RW_COLS, DSA_COLS, ML_COLS, GATE_COLS))
        y_rw = rwkv7_mixer(z_rw, rw_mu[i], rw_w0[i], rw_w_up[i], rw_a0[i], rw_a_up[i], rw_g_up[i],
                           rw_k_k[i], rw_k_a[i], rw_r_k[i], rw_lnx_g[i], rw_lnx_b[i])
        d_q, d_ckv, d_qi, d_ki, d_wi = _split(z_dsa, (DSA_HEADS * DSA_HEAD_DIM, DSA_KV_RANK,
                                                     IDX_HEADS * IDX_DIM, IDX_DIM, IDX_HEADS))
        y_dsa = dsa_mixer(d_q, d_ckv, d_qi, d_ki, d_wi, dsa_ckv_g[i], dsa_kidx_g[i],
                          dsa_w_uk[i], dsa_w_uv[i], rel_bias)
        m_q, m_k, m_v, m_o, m_i, m_f = _split(z_ml, (ML_HEADS * ML_QK, ML_HEADS * ML_QK, MIX_W,
                                                    MIX_W, ML_HEADS, ML_HEADS))
        y_ml = mlstm_mixer(m_q, m_k, m_v, m_o, m_i, m_f, ml_conv[i], ml_b_i[i], ml_b_f[i], ml_hn_g[i])

        ys = jnp.stack([y_rw.astype(x.dtype), y_dsa.astype(x.dtype), y_ml.astype(x.dtype)], axis=2)
        proj = jnp.einsum('btnc,ncd->btnd', ys, w_branch[i])
        gates = jax.nn.sigmoid(z_gate.reshape(B, T, N_BRANCH, D_MODEL))
        mix = jnp.sum(gates * proj, axis=2) @ w_out[i]
        h = h + rms_norm(mix, ng[3])

        f = swiglu(rms_norm(h, ng[4]), ffn2_gate[i], ffn2_up[i], ffn2_down[i])
        h = h + HALF * rms_norm(f, ng[5])

        e = p[i] @ ple_proj[i]
        pg = jax.nn.sigmoid(rms_norm(h, ng[6]) @ ple_gate[i])
        h = h + rms_norm(pg * e, ng[7])
    return h
```

```cpp
#include <hip/hip_runtime.h>
#include <cstdio>
#include <cstdint>
namespace pg8 {
#define PG8_LAS __attribute__((address_space(3)))
typedef unsigned short bf16_t;
typedef short bf16x8 __attribute__((ext_vector_type(8)));
typedef float f32x4 __attribute__((ext_vector_type(4)));
typedef unsigned u32x4 __attribute__((ext_vector_type(4)));
constexpr int BM = 256, BK = 64, HALF = 128, HTB = HALF * BK * 2  , STAGE_BYTES = 8 * HTB, NXCD = 8, WGM = 8;

__host__ __device__ __forceinline__ int lds_byte(int r, int c) { const int st = (r >> 4) * 2 + (c >> 5), rr = r & 15, cc = c & 31, ob = rr * 64 + cc * 2; return st * 1024 + (ob ^ (((ob >> 9) & 1) << 5)); }
__host__ __device__ __forceinline__ void stage_rc(int b, int& R, int& C) { const int st = b / 1024, sb = b % 1024, swz = sb ^ (((sb >> 9) & 1) << 5); R = (st >> 1) * 16 + swz / 64; C = (st & 1) * 32 + (swz % 64) / 2; }
__host__ __device__ __forceinline__ int perm32(int rho) { const int n = rho >> 4, i = rho & 15; return 8 * (i >> 2) + 4 * n + (i & 3); }

struct Unit { int pm, pn; };
struct Gemm { const bf16_t* A; const bf16_t* Bt; int M, N, K; };

struct StaticOrder {
    int nM, nN, nwg, G, c;
    __host__ __device__ void init(int M, int N, int G_, int c_) { nM = M / BM; nN = N / BM; nwg = nM * nN; G = G_; c = c_; }
    __host__ __device__ bool next(int i, Unit& u) const {
        const long L = (long)i * G + c; if (L >= nwg) return false;
        int wgid = (int)L; { const int q = nwg / NXCD, r = nwg % NXCD, xcd = wgid % NXCD, off = wgid / NXCD; wgid = (xcd < r ? xcd * (q + 1) : r * (q + 1) + (xcd - r) * q) + off; }
        const int nig = WGM * nN, gid = wgid / nig, fm = gid * WGM, gsz = (nM - fm) < WGM ? (nM - fm) : WGM;
        u.pm = fm + ((wgid % nig) % gsz); u.pn = (wgid % nig) / gsz; return true;
    }
    __device__ __forceinline__ void a_ready(const Unit&) const {}
    __device__ __forceinline__ void done(const Unit&) const {}
};
__device__ __forceinline__ unsigned cvt_pk_bf16(float lo, float hi) { unsigned r; asm volatile("v_cvt_pk_bf16_f32 %0, %1, %2" : "=v"(r) : "v"(lo), "v"(hi)); return r; }
typedef float f32x2 __attribute__((ext_vector_type(2)));
__device__ __forceinline__ float fast_sigmoid(float x) { return __builtin_amdgcn_rcpf(1.0f + __builtin_amdgcn_exp2f(-1.44269504089f * x)); }
typedef unsigned u32x2 __attribute__((ext_vector_type(2)));
struct EpiSwiglu {
    static constexpr bool PERM = true, AFTER_DRAIN = false;
    bf16_t* O; int ldo; const float* rs; float inv_d, eps;
    __device__ __forceinline__ void operator()(const f32x4 (&acc)[2][2][4][2], const Unit& u, int wr, int wc, int fr, int fq) const {
        const int row0 = u.pm * BM + wr * 64 + fr, col0 = u.pn * HALF + wc * 32 + 8 * fq;
#pragma unroll
        for (int ai = 0; ai < 2; ++ai)
#pragma unroll
            for (int m = 0; m < 4; ++m) { const int row = row0 + ai * HALF + m * 16; const float rinv = __builtin_amdgcn_rsqf(rs[row] * inv_d + eps);
                float o[8];
#pragma unroll
                for (int n = 0; n < 2; ++n)
#pragma unroll
                    for (int j = 0; j < 4; ++j) { const float g = acc[ai][0][m][n][j] * rinv, up = acc[ai][1][m][n][j] * rinv; o[4 * n + j] = g * fast_sigmoid(g) * up; }
                u32x4 w; w.x = cvt_pk_bf16(o[0], o[1]); w.y = cvt_pk_bf16(o[2], o[3]); w.z = cvt_pk_bf16(o[4], o[5]); w.w = cvt_pk_bf16(o[6], o[7]);
                *(u32x4*)(O + (size_t)row * ldo + col0) = w; }
    }
};
struct EpiScaleBf16 {
    static constexpr bool PERM = true, AFTER_DRAIN = false;
    bf16_t* O; int ldo; const float* rs; float inv_d, eps;
    __device__ __forceinline__ void operator()(const f32x4 (&acc)[2][2][4][2], const Unit& u, int wr, int wc, int fr, int fq) const {
        const int row0 = u.pm * BM + wr * 64 + fr, col0 = u.pn * BM + wc * 32 + 8 * fq;
#pragma unroll
        for (int ai = 0; ai < 2; ++ai)
#pragma unroll
            for (int m = 0; m < 4; ++m) { const int row = row0 + ai * HALF + m * 16; const float rinv = rs ? __builtin_amdgcn_rsqf(rs[row] * inv_d + eps) : 1.0f;
                bf16_t* rowp = O + (size_t)row * ldo + col0;
#pragma unroll
                for (int bj = 0; bj < 2; ++bj) { const f32x4 v0 = acc[ai][bj][m][0] * rinv, v1 = acc[ai][bj][m][1] * rinv;
                    u32x4 w; w.x = cvt_pk_bf16(v0[0], v0[1]); w.y = cvt_pk_bf16(v0[2], v0[3]); w.z = cvt_pk_bf16(v1[0], v1[1]); w.w = cvt_pk_bf16(v1[2], v1[3]);
                    *(u32x4*)(rowp + bj * HALF) = w; } }
    }
};
struct EpiF32SS {
    static constexpr bool PERM = false, AFTER_DRAIN = false;
    float* C; int ldc; float* ss;
    __device__ __forceinline__ void operator()(const f32x4 (&acc)[2][2][4][2], const Unit& u, int wr, int wc, int fr, int fq) const {
        const int row0 = u.pm * BM + wr * 64 + fr, col0 = u.pn * BM + wc * 32 + 4 * fq;
#pragma unroll
        for (int ai = 0; ai < 2; ++ai)
#pragma unroll
            for (int m = 0; m < 4; ++m) { const int row = row0 + ai * HALF + m * 16; float* rowp = C + (size_t)row * ldc + col0; float s = 0.f;
#pragma unroll
                for (int bj = 0; bj < 2; ++bj)
#pragma unroll
                    for (int n = 0; n < 2; ++n) { const f32x4 v = acc[ai][bj][m][n]; *(f32x4*)(rowp + bj * HALF + n * 16) = v; s += (v[0] * v[0] + v[1] * v[1]) + (v[2] * v[2] + v[3] * v[3]); }
                (void)s; }
    }
};
struct EpiBranch {
    static constexpr bool PERM = false, AFTER_DRAIN = false;
    float* MIX; bf16_t* MIXG; const bf16_t* Z; int ldz, zg0;
    __device__ __forceinline__ void operator()(const f32x4 (&acc)[2][2][4][2], const Unit& u, int wr, int wc, int fr, int fq) const {
        const int b = u.pm >> 5, pm = u.pm & 31, pn = u.pn & 7;
        const int row0 = pm * BM + wr * 64 + fr, col0 = pn * BM + wc * 32 + 4 * fq;
#pragma unroll
        for (int ai = 0; ai < 2; ++ai)
#pragma unroll
            for (int m = 0; m < 4; ++m) { const int row = row0 + ai * HALF + m * 16; const bf16_t* zp = Z + (size_t)row * ldz + zg0 + b * 2048 + col0; float* mp = MIX + (size_t)row * 2048 + col0; bf16_t* op = MIXG + (size_t)row * 2048 + col0;
#pragma unroll
                for (int bj = 0; bj < 2; ++bj)
#pragma unroll
                    for (int n = 0; n < 2; ++n) { const int co = bj * HALF + n * 16; const u32x2 gz = *(const u32x2*)(zp + co);
                        f32x4 g; g[0] = fast_sigmoid(__uint_as_float(gz.x << 16)); g[1] = fast_sigmoid(__uint_as_float(gz.x & 0xffff0000u)); g[2] = fast_sigmoid(__uint_as_float(gz.y << 16)); g[3] = fast_sigmoid(__uint_as_float(gz.y & 0xffff0000u));
                        f32x4 v = acc[ai][bj][m][n] * g;
                        if (b > 0) { f32x4 o; o[0] = __hip_atomic_load(mp + co + 0, __ATOMIC_RELAXED, __HIP_MEMORY_SCOPE_AGENT); o[1] = __hip_atomic_load(mp + co + 1, __ATOMIC_RELAXED, __HIP_MEMORY_SCOPE_AGENT);
                            o[2] = __hip_atomic_load(mp + co + 2, __ATOMIC_RELAXED, __HIP_MEMORY_SCOPE_AGENT); o[3] = __hip_atomic_load(mp + co + 3, __ATOMIC_RELAXED, __HIP_MEMORY_SCOPE_AGENT); v += o; }
                        if (b < 2) *(f32x4*)(mp + co) = v;
                        else { u32x2 w; w.x = cvt_pk_bf16(v[0], v[1]); w.y = cvt_pk_bf16(v[2], v[3]); *(u32x2*)(op + co) = w; } } }
    }
};
struct EpiPleGate {
    static constexpr bool PERM = false, AFTER_DRAIN = false;
    float* C; int ldc; float* ss; const float* rs; const bf16_t* E; float inv_d, eps;
    __device__ __forceinline__ void operator()(const f32x4 (&acc)[2][2][4][2], const Unit& u, int wr, int wc, int fr, int fq) const {
        const int row0 = u.pm * BM + wr * 64 + fr, col0 = u.pn * BM + wc * 32 + 4 * fq;
#pragma unroll
        for (int ai = 0; ai < 2; ++ai)
#pragma unroll
            for (int m = 0; m < 4; ++m) { const int row = row0 + ai * HALF + m * 16; float* rowp = C + (size_t)row * ldc + col0; const bf16_t* ep = E + (size_t)row * ldc + col0; float s = 0.f;
                const float rinv = __builtin_amdgcn_rsqf(rs[row] * inv_d + eps);
#pragma unroll
                for (int bj = 0; bj < 2; ++bj)
#pragma unroll
                    for (int n = 0; n < 2; ++n) { const int co = bj * HALF + n * 16; const u32x2 ez = *(const u32x2*)(ep + co); f32x4 v = acc[ai][bj][m][n] * rinv;
                        v[0] = fast_sigmoid(v[0]) * __uint_as_float(ez.x << 16); v[1] = fast_sigmoid(v[1]) * __uint_as_float(ez.x & 0xffff0000u);
                        v[2] = fast_sigmoid(v[2]) * __uint_as_float(ez.y << 16); v[3] = fast_sigmoid(v[3]) * __uint_as_float(ez.y & 0xffff0000u);
                        *(f32x4*)(rowp + co) = v; s += (v[0] * v[0] + v[1] * v[1]) + (v[2] * v[2] + v[3] * v[3]); }
                (void)s; }
    }
};
struct BranchOrder {
    int G, c;
    __device__ __forceinline__ bool next(int i, Unit& u) const { const int tile = c + (i / 3) * G, b = i % 3; if (tile >= 256) return false; u.pm = b * 32 + (tile & 31); u.pn = b * 8 + (tile >> 5); return true; }
    __device__ __forceinline__ void a_ready(const Unit&) const {}
    __device__ __forceinline__ void done(const Unit&) const {}
};
template <class Epi, class Sched, bool ALIGN_EPI = false, bool SP2 = false>
__device__ __forceinline__ void gemm_phase(PG8_LAS unsigned char* lds, const Gemm g, const Sched& S, const Epi& E) {
    const int tid = threadIdx.x, wid = __builtin_amdgcn_readfirstlane(tid >> 6), lane = tid & 63, wr = wid >> 2, wc = wid & 3, fr = lane & 15, fq = lane >> 4;
    const int K = g.K, nt = K / BK;
    unsigned voffA[2], voffB[2];
#pragma unroll
    for (int i = 0; i < 2; ++i) { int R, C; stage_rc(tid * 16 + i * 8192, R, C); const int Rb = Epi::PERM ? ((R & ~31) + perm32(R & 31)) : R;
        voffA[i] = (unsigned)(R * K + C) * 2u; voffB[i] = (unsigned)(Rb * K + C) * 2u; }
    const size_t kstep = (size_t)(BK * 2);
    const size_t hstep = (size_t)HALF * K * 2;
    const size_t tstep = 2 * hstep;
    const unsigned ldsw = (unsigned)wid * 1024u;
    const int aoff = lds_byte(wr * 64 + fr, fq * 8), boff = lds_byte(wc * 32 + fr, fq * 8);
#define PG8_SA(b, h) (((b) * 2 + (h)) * HTB)
#define PG8_SB(b, h) ((4 + (b) * 2 + (h)) * HTB)
#define PG8_STAGE(bufoff, gbase, voff) do { _Pragma("unroll") for (int _i = 0; _i < 2; ++_i) \
        __builtin_amdgcn_global_load_lds((const unsigned*)((const char*)(gbase) + (voff)[_i]), (PG8_LAS unsigned*)(lds + (bufoff) + ldsw + _i * 8192), 16, 0, 0); } while (0)
#define PG8_LDA(dst, b, h) do { _Pragma("unroll") for (int m = 0; m < 4; ++m) _Pragma("unroll") for (int k = 0; k < 2; ++k) dst[m][k] = *(const PG8_LAS bf16x8*)(lds + PG8_SA(b, h) + aoff + m * 2048 + k * 1024); } while (0)
#define PG8_LDB(dst, b, h) do { _Pragma("unroll") for (int n = 0; n < 2; ++n) _Pragma("unroll") for (int k = 0; k < 2; ++k) dst[n][k] = *(const PG8_LAS bf16x8*)(lds + PG8_SB(b, h) + boff + n * 2048 + k * 1024); } while (0)
#define PG8_MMA(ai, bj, At, Bt) do { __builtin_amdgcn_s_setprio(1); _Pragma("unroll") for (int m = 0; m < 4; ++m) _Pragma("unroll") for (int n = 0; n < 2; ++n) _Pragma("unroll") for (int k = 0; k < 2; ++k) \
        acc[ai][bj][m][n] = __builtin_amdgcn_mfma_f32_16x16x32_bf16(Bt[n][k], At[m][k], acc[ai][bj][m][n], 0, 0, 0); __builtin_amdgcn_s_setprio(0); } while (0)
#define PG8_WAIT_V(n) asm volatile("s_waitcnt vmcnt(" #n ")" ::: "memory")
#define PG8_WAIT_L(n) asm volatile("s_waitcnt lgkmcnt(" #n ")" ::: "memory")
#define PG8_BAR __builtin_amdgcn_s_barrier()
#define PG8_SCHED __builtin_amdgcn_sched_barrier(0)
    Unit cur, nxt; int ui = 0;
    if (!S.next(0, cur)) return;
    f32x4 acc[2][2][4][2];
#pragma unroll
    for (int a = 0; a < 2; ++a)
#pragma unroll
        for (int b = 0; b < 2; ++b)
#pragma unroll
            for (int m = 0; m < 4; ++m)
#pragma unroll
                for (int n = 0; n < 2; ++n) acc[a][b][m][n] = (f32x4){0.f, 0.f, 0.f, 0.f};
    bf16x8 At[4][2], B0[2][2], B1[2][2];
    const char* cA = (const char*)g.A + (size_t)cur.pm * tstep; const char* cB = (const char*)g.Bt + (size_t)cur.pn * tstep;
    S.a_ready(cur);
    if constexpr (SP2) {
        PG8_STAGE(PG8_SB(0, 0), cB, voffB); PG8_STAGE(PG8_SB(0, 1), cB + hstep, voffB); PG8_STAGE(PG8_SA(0, 0), cA, voffA); PG8_STAGE(PG8_SA(0, 1), cA + hstep, voffA);
        if (wr == 1) PG8_BAR;
        PG8_WAIT_V(2); PG8_BAR;
        PG8_STAGE(PG8_SB(1, 0), cB + kstep, voffB); PG8_STAGE(PG8_SA(1, 0), cA + kstep, voffA); PG8_STAGE(PG8_SB(1, 1), cB + hstep + kstep, voffB);
        PG8_WAIT_V(6); PG8_BAR;
    } else {
        PG8_STAGE(PG8_SB(0, 0), cB, voffB); PG8_STAGE(PG8_SA(0, 0), cA, voffA); PG8_STAGE(PG8_SB(0, 1), cB + hstep, voffB); PG8_STAGE(PG8_SA(0, 1), cA + hstep, voffA);
        if (wr == 1) PG8_BAR;
        PG8_WAIT_V(4); PG8_BAR;
        PG8_STAGE(PG8_SB(1, 0), cB + kstep, voffB); PG8_STAGE(PG8_SA(1, 0), cA + kstep, voffA); PG8_STAGE(PG8_SB(1, 1), cB + hstep + kstep, voffB);
        PG8_WAIT_V(6); PG8_BAR;
    }
    for (;;) {
        const bool has_next = S.next(ui + 1, nxt);
        const char* nA = has_next ? (const char*)g.A + (size_t)nxt.pm * tstep : cA; const char* nB = has_next ? (const char*)g.Bt + (size_t)nxt.pn * tstep : cB;
        for (int t = 0; t < nt; t += 2) {
            const bool last = (t == nt - 2);
            const char* a1 = cA + (size_t)(t + 1) * kstep;
            const char* a2 = last ? nA : cA + (size_t)(t + 2) * kstep; const char* b2 = last ? nB : cB + (size_t)(t + 2) * kstep;
            const char* a3 = a2 + kstep; const char* b3 = b2 + kstep;
            if (last && has_next) S.a_ready(nxt);
            if constexpr (SP2) {
            PG8_LDB(B0, 0, 0); PG8_LDB(B1, 0, 1); PG8_SCHED; PG8_LDA(At, 0, 0); PG8_STAGE(PG8_SA(1, 1), a1 + hstep, voffA);
            PG8_WAIT_V(8); PG8_WAIT_L(0); PG8_BAR; PG8_MMA(0, 0, At, B0); PG8_MMA(0, 1, At, B1); PG8_BAR; PG8_SCHED;
            PG8_LDA(At, 0, 1); PG8_STAGE(PG8_SB(0, 0), b2, voffB); PG8_STAGE(PG8_SB(0, 1), b2 + hstep, voffB); PG8_STAGE(PG8_SA(0, 0), a2, voffA);
            PG8_WAIT_V(8); PG8_WAIT_L(0); PG8_BAR; PG8_MMA(1, 0, At, B0); PG8_MMA(1, 1, At, B1); PG8_BAR; PG8_SCHED;
            PG8_LDB(B0, 1, 0); PG8_LDB(B1, 1, 1); PG8_SCHED; PG8_LDA(At, 1, 0); PG8_STAGE(PG8_SA(0, 1), a2 + hstep, voffA);
            PG8_WAIT_V(8); PG8_WAIT_L(0); PG8_BAR; PG8_MMA(0, 0, At, B0); PG8_MMA(0, 1, At, B1); PG8_BAR; PG8_SCHED;
            PG8_LDA(At, 1, 1); PG8_STAGE(PG8_SB(1, 0), b3, voffB); PG8_STAGE(PG8_SB(1, 1), b3 + hstep, voffB); PG8_STAGE(PG8_SA(1, 0), a3, voffA);
            PG8_WAIT_V(8); PG8_WAIT_L(0); PG8_BAR; PG8_MMA(1, 0, At, B0); PG8_MMA(1, 1, At, B1); PG8_BAR; PG8_SCHED;
            } else {
            PG8_LDB(B0, 0, 0); PG8_SCHED; PG8_LDA(At, 0, 0); PG8_STAGE(PG8_SA(1, 1), a1 + hstep, voffA);
            PG8_WAIT_L(8); PG8_BAR; PG8_WAIT_L(0); PG8_MMA(0, 0, At, B0); PG8_BAR; PG8_SCHED;
            PG8_LDB(B1, 0, 1); PG8_STAGE(PG8_SB(0, 0), b2, voffB);
            PG8_BAR; PG8_WAIT_L(0); PG8_MMA(0, 1, At, B1); PG8_BAR;
            PG8_LDA(At, 0, 1); PG8_STAGE(PG8_SA(0, 0), a2, voffA);
            PG8_BAR; PG8_WAIT_L(0); PG8_MMA(1, 0, At, B0); PG8_BAR; PG8_SCHED;
            PG8_STAGE(PG8_SB(0, 1), b2 + hstep, voffB);
            PG8_WAIT_V(6); PG8_BAR; PG8_MMA(1, 1, At, B1); PG8_BAR;
            PG8_LDB(B0, 1, 0); PG8_SCHED; PG8_LDA(At, 1, 0); PG8_STAGE(PG8_SA(0, 1), a2 + hstep, voffA);
            PG8_WAIT_L(8); PG8_BAR; PG8_WAIT_L(0); PG8_MMA(0, 0, At, B0); PG8_BAR; PG8_SCHED;
            PG8_LDB(B1, 1, 1); PG8_STAGE(PG8_SB(1, 0), b3, voffB);
            PG8_BAR; PG8_WAIT_L(0); PG8_MMA(0, 1, At, B1); PG8_BAR;
            PG8_LDA(At, 1, 1); PG8_STAGE(PG8_SA(1, 0), a3, voffA);
            PG8_BAR; PG8_WAIT_L(0); PG8_MMA(1, 0, At, B0); PG8_BAR; PG8_SCHED;
            PG8_STAGE(PG8_SB(1, 1), b3 + hstep, voffB);
            PG8_WAIT_V(6); PG8_BAR; PG8_MMA(1, 1, At, B1); PG8_BAR;
            }
        }
        if constexpr (ALIGN_EPI) { if (wr == 0) PG8_BAR; }
        if constexpr (!Epi::AFTER_DRAIN) { E(acc, cur, wr, wc, fr, fq); S.done(cur); }
        if (!has_next) break;
#pragma unroll
        for (int a = 0; a < 2; ++a)
#pragma unroll
            for (int b = 0; b < 2; ++b)
#pragma unroll
                for (int m = 0; m < 4; ++m)
#pragma unroll
                    for (int n = 0; n < 2; ++n) acc[a][b][m][n] = (f32x4){0.f, 0.f, 0.f, 0.f};
        cur = nxt; cA = nA; cB = nB; ++ui;
        if constexpr (ALIGN_EPI) { if (wr == 1) PG8_BAR; }
    }
    PG8_WAIT_V(0);
    if constexpr (!ALIGN_EPI) { if (wr == 0) PG8_BAR; }
    PG8_BAR;
    if constexpr (Epi::AFTER_DRAIN) { E.fused(acc, cur, wr, wc, fr, fq, lds, wid, lane); S.done(cur); }
#undef PG8_SA
#undef PG8_SB
#undef PG8_STAGE
#undef PG8_LDA
#undef PG8_LDB
#undef PG8_MMA
#undef PG8_WAIT_V
#undef PG8_WAIT_L
#undef PG8_BAR
#undef PG8_SCHED
}
}
constexpr int T = 8192, D = 2048, FF = 5632, NL = 4, PLE = 256, NIN = 14968;
constexpr int NZ = 15104;
constexpr int ZR = 0, ZK = 1024, ZV = 2048, ZWD = 3072, ZAD = 3136, ZGD = 3200;
constexpr int ZDQ = 3360, ZCKV = 4384, ZQI = 4640, ZKI = 5664, ZWI = 5728;
constexpr int ZMQ = 5760, ZMK = 6272, ZMV = 6784, ZMO = 7808, ZMI = 8832, ZMF = 8836;
constexpr int ZG = 8864;
constexpr float EPS = 1e-6f;
constexpr int NWAVES = 8, NTHR = 512;

constexpr size_t MiB = 1u << 20;
constexpr size_t WS_CTL = 0, CTL_ZERO_BYTES = 1 * MiB;
constexpr size_t WS_WGU1 = 1 * MiB;
constexpr size_t WS_WD1 = WS_WGU1 + 44 * MiB;
constexpr size_t WS_WIN = WS_WD1 + 22 * MiB;
constexpr size_t WS_WBR = WS_WIN + 59 * MiB;
constexpr size_t WS_WOUT = WS_WBR + 12 * MiB;
constexpr size_t WS_WGU2 = WS_WOUT + 8 * MiB;
constexpr size_t WS_WD2 = WS_WGU2 + 44 * MiB;
constexpr size_t WS_WPG = WS_WD2 + 22 * MiB;
constexpr size_t WS_WPP = WS_WPG + 8 * MiB;
constexpr size_t WS_WLW = WS_WPP + 1 * MiB;
constexpr size_t WS_WLA = WS_WLW + 128 * 1024;
constexpr size_t WS_WLG = WS_WLA + 128 * 1024;
constexpr size_t WS_WUK = WS_WLG + 512 * 1024;
constexpr size_t WS_WUV = WS_WUK + 512 * 1024;
constexpr size_t WS_ACT0 = 224 * MiB;
static_assert(WS_WUV + 512 * 1024 <= WS_ACT0, "weights region");
constexpr size_t WS_HB = WS_ACT0;
constexpr size_t WS_ACT = WS_HB + 32 * MiB;
constexpr size_t WS_F = WS_ACT + 88 * MiB;
constexpr size_t WS_Z = WS_F + 64 * MiB;
constexpr size_t WS_RS = WS_Z + 236 * MiB;
constexpr size_t WS_FSS = WS_RS + 64 * 1024;
constexpr size_t WS_MISC = WS_FSS + 64 * 1024;
constexpr size_t WS_RW = WS_MISC + 896 * 1024;
constexpr size_t RW_STRIDE = 32 * MiB;
constexpr size_t WS_DSA = WS_RW + 9 * RW_STRIDE;
constexpr size_t WS_DC = WS_DSA;
constexpr size_t WS_DKI = WS_DC + 4 * MiB;
constexpr size_t WS_DWI = WS_DKI + 1 * MiB;
constexpr size_t WS_DIDX = WS_DWI + 1 * MiB;
constexpr size_t WS_DQL = WS_DIDX + 8 * MiB;
constexpr size_t WS_DOL = WS_DQL + 32 * MiB;
constexpr size_t WS_DSC = WS_DOL + 32 * MiB;
constexpr size_t WS_ML = WS_DSC + 256 * MiB;
constexpr size_t WS_MQK = WS_ML;
constexpr size_t WS_MKL = WS_MQK + 16 * MiB;
constexpr size_t WS_MCS = WS_MKL + 32 * MiB;
constexpr size_t WS_MSM = WS_MCS + 16 * MiB;
constexpr size_t WS_Y = WS_MSM + 2 * MiB;
constexpr size_t WS_MIXG = WS_Y + 48 * MiB;
constexpr size_t WS_E = WS_MIXG + 32 * MiB;
constexpr size_t WS_PB = WS_E + 32 * MiB;
constexpr size_t WS_END = WS_PB + 4 * MiB;
static_assert(WS_END <= (size_t)1800 * MiB, "workspace budget");
constexpr int CW_TMO = 0, CW_BAR = 4096;

constexpr int LDS_BYTES = 147456;
constexpr int LDSCTL_OFF = 146432, MISC_OFF = LDSCTL_OFF + 256;

#define GAS __attribute__((address_space(1)))
#define LAS __attribute__((address_space(3)))
#define DI __device__ __forceinline__
typedef unsigned short bf16;
typedef unsigned v4u __attribute__((ext_vector_type(4)));
typedef unsigned v2u __attribute__((ext_vector_type(2)));
typedef float f32x4 __attribute__((ext_vector_type(4)));
typedef float f32x2 __attribute__((ext_vector_type(2)));
typedef short bf16x8 __attribute__((ext_vector_type(8)));
typedef short bf16x4 __attribute__((ext_vector_type(4)));
typedef GAS unsigned gu32;
#define RLX_AGENT __ATOMIC_RELAXED, __HIP_MEMORY_SCOPE_AGENT
#define LDS_WAIT() asm volatile("s_waitcnt lgkmcnt(0)" ::: "memory")
#define VM_WAIT() asm volatile("s_waitcnt vmcnt(0)" ::: "memory")
DI unsigned f2bf(float f) { unsigned u = __builtin_bit_cast(unsigned, f); return (u + 0x7fffu + ((u >> 16) & 1u)) >> 16; }
DI unsigned pk2(float lo, float hi) { return f2bf(lo) | (f2bf(hi) << 16); }
DI float bf2f(unsigned short b) { return __uint_as_float(((unsigned)b) << 16); }
DI float bflo(unsigned w) { return __uint_as_float(w << 16); }
DI float bfhi(unsigned w) { return __uint_as_float(w & 0xffff0000u); }
DI float sigmoidf_(float x) { return 1.0f / (1.0f + __expf(-x)); }
DI float wave_sum(float v) {
#pragma unroll
    for (int o = 1; o < 64; o <<= 1) v += __shfl_xor(v, o);
    return v;
}
DI float wave_max(float v) {
#pragma unroll
    for (int o = 1; o < 64; o <<= 1) v = fmaxf(v, __shfl_xor(v, o));
    return v;
}
#define MFMA16(a, b, c) __builtin_amdgcn_mfma_f32_16x16x32_bf16((a), (b), (c), 0, 0, 0)
#define MFMA32(a, b, c) __builtin_amdgcn_mfma_f32_32x32x16_bf16((a), (b), (c), 0, 0, 0)
typedef float f32x16 __attribute__((ext_vector_type(16)));
DI bf16x4 tr_read(unsigned lds_addr) { bf16x4 r; asm volatile("ds_read_b64_tr_b16 %0, %1\n\ts_waitcnt lgkmcnt(0)" : "=&v"(r) : "v"(lds_addr) : "memory"); return r; }
DI bf16x8 cat8(bf16x4 lo, bf16x4 hi) { return __builtin_shufflevector(lo, hi, 0, 1, 2, 3, 4, 5, 6, 7); }
#define XB_TMO      128
#define XB_XCNT(j)  (256  + 64 * (j))
#define XB_XSUB(j)  (1280 + 64 * (j))
#define XB_XGEN(j)  (2304 + 64 * (j))
#define XB_TOP      3328
#define XB_TOPGEN   3392
#define XCD_BAR_WORDS 3456
#define XB_SPIN_CAP (1u << 18)

__device__ __forceinline__ unsigned xb_ld(unsigned* p)              { return __hip_atomic_load(p, __ATOMIC_RELAXED, __HIP_MEMORY_SCOPE_AGENT); }
__device__ __forceinline__ unsigned xb_add(unsigned* p, unsigned v) { return __hip_atomic_fetch_add(p, v, __ATOMIC_RELAXED, __HIP_MEMORY_SCOPE_AGENT); }
__device__ __forceinline__ unsigned xb_xcc_id() { return (unsigned)__builtin_amdgcn_s_getreg((3 << 11) | 20) & 0xFu; }
#define XB_SPIN(cond, bar) do { unsigned _sp = 0; while (cond) { __builtin_amdgcn_s_sleep(1); \
    if ((++_sp & 255u) == 0u) { if (xb_ld(&(bar)[XB_TMO])) break; if (_sp > XB_SPIN_CAP) { atomicAdd(&(bar)[XB_TMO], 1u); break; } } } } while (0)

struct XcdBarrier {
    unsigned* bar; unsigned x;
    volatile LAS unsigned* st;
};

__device__ __forceinline__ XcdBarrier xcd_barrier_post(unsigned* bar, volatile LAS unsigned* st) {
    XcdBarrier b; b.bar = bar; b.x = xb_xcc_id(); b.st = st;
    if (threadIdx.x == 0) (void)xb_add(&bar[XB_XCNT(b.x)], 1u);
    return b;
}
__device__ __forceinline__ void xcd_barrier_complete(unsigned* bar, unsigned x, unsigned& nloc, unsigned& nx) {
    const unsigned G = gridDim.x * gridDim.y * gridDim.z;
    unsigned sum, cnt, mine, sp = 0u;
    for (;;) {
        sum = 0u; cnt = 0u; mine = 0u;
#pragma unroll
        for (unsigned j = 0; j < 16; ++j) { const unsigned c = xb_ld(&bar[XB_XCNT(j)]); sum += c; cnt += (c > 0u) ? 1u : 0u; mine = (j == x) ? c : mine; }
        if (sum == G) break;
        __builtin_amdgcn_s_sleep(1);
        if ((++sp & 255u) == 0u) { if (xb_ld(&bar[XB_TMO])) break; if (sp > XB_SPIN_CAP) { atomicAdd(&bar[XB_TMO], 1u); break; } }
    }
    nloc = mine > 0u ? mine : 1u; nx = cnt > 0u ? cnt : 1u;
}

__device__ __forceinline__ void xcd_barrier(const XcdBarrier& b) {
    asm volatile("s_waitcnt vmcnt(0)" ::: "memory");
    __syncthreads();
    if (threadIdx.x == 0) {
        unsigned* bar = b.bar;
        __builtin_amdgcn_s_waitcnt(0);
        unsigned nloc = b.st[0], nx = b.st[1];
        if (nloc == 0u) { xcd_barrier_complete(bar, b.x, nloc, nx); b.st[0] = nloc; b.st[1] = nx; }
        const unsigned old = xb_add(&bar[XB_XSUB(b.x)], 1u);
        const unsigned gen = old / nloc;
        if (old + 1u == (gen + 1u) * nloc) {
            __builtin_amdgcn_fence(__ATOMIC_RELEASE, "agent");
            asm volatile("s_waitcnt vmcnt(0)" ::: "memory");
            const unsigned og = xb_add(&bar[XB_TOP], 1u);
            const unsigned tg = og / nx;
            if (og + 1u == (tg + 1u) * nx) xb_add(&bar[XB_TOPGEN], 1u);
            else XB_SPIN(xb_ld(&bar[XB_TOPGEN]) == tg, bar);
            __builtin_amdgcn_fence(__ATOMIC_ACQUIRE, "agent");
            xb_add(&bar[XB_XGEN(b.x)], 1u);
            asm volatile("s_waitcnt vmcnt(0)" ::: "memory");
        } else {
            XB_SPIN(xb_ld(&bar[XB_XGEN(b.x)]) == gen, bar);
            __builtin_amdgcn_fence(__ATOMIC_ACQUIRE, "agent");
            asm volatile("s_waitcnt vmcnt(0)" ::: "memory");
        }
    }
    __syncthreads();
}
struct Ctx { LAS unsigned char* lds; unsigned char* ws; int tid, lane, wave, gw, NGW, G, bid; };

DI void tr_item(const float* W, int ldn, int K, const float* gain, float scale, bf16* WT, int drow, int nvalid, int k0, LAS float* scr, int lane) {
#pragma unroll 8
    for (int i = 0; i < 32; ++i) { const int kk = 2 * i + (lane >> 5), c = lane & 31; float v = 0.f;
        if (c < nvalid) { v = W[(size_t)(k0 + kk) * ldn + c]; if (gain) v *= gain[k0 + kk]; v *= scale; }
        scr[kk * 33 + c] = v; }
    LDS_WAIT(); asm volatile("" ::: "memory");
    const int c8 = lane & 7;
#pragma unroll
    for (int j = 0; j < 4; ++j) { const int n = (lane >> 3) + 8 * j; const LAS float* s = scr + (8 * c8) * 33 + n;
        v4u o; o.x = pk2(s[0 * 33], s[1 * 33]); o.y = pk2(s[2 * 33], s[3 * 33]); o.z = pk2(s[4 * 33], s[5 * 33]); o.w = pk2(s[6 * 33], s[7 * 33]);
        *(v4u*)(WT + (size_t)(drow + n) * K + k0 + 8 * c8) = o; }
    LDS_WAIT(); asm volatile("" ::: "memory");
}
DI void conv_seg(const Ctx& F, const float* W, int ldn, int K, int ncols, int nsrc, const float* gain, float scale, bf16* WT, int dst0, int kind, int& base, LAS float* scr) {
    const int nblk = (ncols + 31) / 32, nitems = (K / 64) * nblk;
    const int start = (F.gw - base % F.NGW + F.NGW) % F.NGW;
    for (int it = start; it < nitems; it += F.NGW) {
        const int kb = it / nblk, nb = it - kb * nblk, n0 = nb * 32; int nvalid = nsrc - n0; nvalid = nvalid < 0 ? 0 : (nvalid > 32 ? 32 : nvalid);
        const int drow = kind ? (256 * (n0 >> 7) + dst0 + (n0 & 127)) : (dst0 + n0);
        tr_item(W + n0, ldn, K, gain, scale, WT, drow, nvalid, kb * 64, scr, F.lane);
    }
    base += nitems;
}
DI void phase_conv(const Ctx& F, const float* const* in, int l) {
    LAS float* scr = (LAS float*)(F.lds + F.wave * 16384);
    unsigned char* ws = F.ws; int base = 0;
    const float* ng = in[2] + (size_t)l * 8 * D;
    conv_seg(F, in[3] + (size_t)l * D * FF, FF, D, FF, FF, ng + 0 * D, 1.f, (bf16*)(ws + WS_WGU1), 0, 1, base, scr);
    conv_seg(F, in[4] + (size_t)l * D * FF, FF, D, FF, FF, ng + 0 * D, 1.f, (bf16*)(ws + WS_WGU1), 128, 1, base, scr);
    conv_seg(F, in[5] + (size_t)l * FF * D, D, FF, D, D, nullptr, 1.f, (bf16*)(ws + WS_WD1), 0, 0, base, scr);
    { const float* W = in[6] + (size_t)l * D * NIN; bf16* WT = (bf16*)(ws + WS_WIN); const float* g2 = ng + 2 * D;
      conv_seg(F, W + 0, NIN, D, 3360, 3360, g2, 1.f, WT, 0, 0, base, scr);
      conv_seg(F, W + 3360, NIN, D, 2400, 2384, g2, 1.f, WT, ZDQ, 0, base, scr);
      conv_seg(F, W + 5744, NIN, D, 3104, 3080, g2, 1.f, WT, ZMQ, 0, base, scr);
      conv_seg(F, W + 8824, NIN, D, 6144, 6144, g2, 1.f, WT, ZG, 0, base, scr);
      conv_seg(F, W, NIN, D, 96, 0, g2, 1.f, WT, 15008, 0, base, scr); }
    for (int b = 0; b < 3; ++b) conv_seg(F, in[27] + ((size_t)l * 3 + b) * 1024 * D, D, 1024, D, D, nullptr, 1.f, (bf16*)(ws + WS_WBR) + (size_t)b * D * 1024, 0, 0, base, scr);
    conv_seg(F, in[28] + (size_t)l * D * D, D, D, D, D, nullptr, 1.f, (bf16*)(ws + WS_WOUT), 0, 0, base, scr);
    conv_seg(F, in[29] + (size_t)l * D * FF, FF, D, FF, FF, ng + 4 * D, 1.f, (bf16*)(ws + WS_WGU2), 0, 1, base, scr);
    conv_seg(F, in[30] + (size_t)l * D * FF, FF, D, FF, FF, ng + 4 * D, 1.f, (bf16*)(ws + WS_WGU2), 128, 1, base, scr);
    conv_seg(F, in[31] + (size_t)l * FF * D, D, FF, D, D, nullptr, 1.f, (bf16*)(ws + WS_WD2), 0, 0, base, scr);
    conv_seg(F, in[33] + (size_t)l * D * D, D, D, D, D, ng + 6 * D, 1.f, (bf16*)(ws + WS_WPG), 0, 0, base, scr);
    conv_seg(F, in[32] + (size_t)l * PLE * D, D, PLE, D, D, nullptr, 1.f, (bf16*)(ws + WS_WPP), 0, 0, base, scr);
    conv_seg(F, in[9] + (size_t)l * 64 * 1024, 1024, 64, 1024, 1024, nullptr, 1.f, (bf16*)(ws + WS_WLW), 0, 0, base, scr);
    conv_seg(F, in[11] + (size_t)l * 64 * 1024, 1024, 64, 1024, 1024, nullptr, 1.f, (bf16*)(ws + WS_WLA), 0, 0, base, scr);
    for (int h = 0; h < 8; ++h) conv_seg(F, in[20] + ((size_t)l * 8 + h) * 128 * 256, 256, 128, 256, 256, nullptr, 0.08838834764831845f, (bf16*)(ws + WS_WUK) + (size_t)h * 256 * 128, 0, 0, base, scr);
    for (int h = 0; h < 8; ++h) conv_seg(F, in[21] + ((size_t)l * 8 + h) * 256 * 128, 128, 256, 128, 128, nullptr, 1.f, (bf16*)(ws + WS_WUV) + (size_t)h * 128 * 256, 0, 0, base, scr);
    { const float* W = in[12] + (size_t)l * 160 * 1024; bf16* WT = (bf16*)(ws + WS_WLG);
      for (int i = F.bid * NTHR + F.tid; i < 1024 * 160; i += F.G * NTHR) { const int n = i / 160, k = i - n * 160; WT[i] = (bf16)f2bf(W[(size_t)k * 1024 + n]); } }
    { const f32x4* P = (const f32x4*)(in[1] + (size_t)l * T * PLE); v2u* PB = (v2u*)(ws + WS_PB);
      for (int i = F.bid * NTHR + F.tid; i < T * PLE / 4; i += F.G * NTHR) { const f32x4 v = P[i]; v2u o; o.x = pk2(v[0], v[1]); o.y = pk2(v[2], v[3]); PB[i] = o; } }
}

template <bool INIT>
DI void phase_resid(const Ctx& F, const float* src, const float* gain, float alpha, float* h) {
    bf16* hb = (bf16*)(F.ws + WS_HB); float* rs = (float*)(F.ws + WS_RS);
    f32x4 g[8];
    if (!INIT) {
#pragma unroll
        for (int j = 0; j < 8; ++j) g[j] = *(const f32x4*)(gain + 4 * F.lane + 256 * j);
    }
    for (int m = F.gw; m < T; m += F.NGW) {
        const f32x4* sr = (const f32x4*)(src + (size_t)m * D) + F.lane; f32x4* hr = (f32x4*)(h + (size_t)m * D) + F.lane;
        v2u* ob = (v2u*)(hb + (size_t)m * D) + F.lane;
        f32x4 v[8]; float fs = 0.f;
#pragma unroll
        for (int j = 0; j < 8; ++j) { v[j] = sr[64 * j]; fs += (v[j][0] * v[j][0] + v[j][1] * v[j][1]) + (v[j][2] * v[j][2] + v[j][3] * v[j][3]); }
        float rinv = 0.f; if (!INIT) rinv = alpha * __builtin_amdgcn_rsqf(wave_sum(fs) * (1.0f / D) + EPS);
        float s2 = 0.f;
#pragma unroll
        for (int j = 0; j < 8; ++j) {
            f32x4 x = v[j];
            if (!INIT) x = hr[64 * j] + x * rinv * g[j];
            hr[64 * j] = x; v2u o; o.x = pk2(x[0], x[1]); o.y = pk2(x[2], x[3]); ob[64 * j] = o;
            s2 += (x[0] * x[0] + x[1] * x[1]) + (x[2] * x[2] + x[3] * x[3]);
        }
        s2 = wave_sum(s2);
        if (F.lane == 0) rs[m] = s2;
    }
}

DI void wave_gemm32_bf16(const bf16* A, int lda, const bf16* Bt, int ldb, int K, bf16* O, int ldo, int lane) {
    const int r = lane & 15, q = lane >> 4;
    f32x4 acc[2][2];
#pragma unroll
    for (int i = 0; i < 2; ++i)
#pragma unroll
        for (int j = 0; j < 2; ++j) acc[i][j] = (f32x4){0.f, 0.f, 0.f, 0.f};
    for (int k0 = 0; k0 < K; k0 += 32) {
        bf16x8 a[2], b[2];
#pragma unroll
        for (int i = 0; i < 2; ++i) { a[i] = *(const bf16x8*)(A + (size_t)(16 * i + r) * lda + k0 + 8 * q); b[i] = *(const bf16x8*)(Bt + (size_t)(16 * i + r) * ldb + k0 + 8 * q); }
#pragma unroll
        for (int i = 0; i < 2; ++i)
#pragma unroll
            for (int j = 0; j < 2; ++j) acc[i][j] = MFMA16(b[j], a[i], acc[i][j]);
    }
#pragma unroll
    for (int i = 0; i < 2; ++i)
#pragma unroll
        for (int j = 0; j < 2; ++j) { v2u w; w.x = pk2(acc[i][j][0], acc[i][j][1]); w.y = pk2(acc[i][j][2], acc[i][j][3]); *(v2u*)(O + (size_t)(16 * i + r) * ldo + 16 * j + 4 * q) = w; }
}
DI float* rwbuf(const Ctx& F, int i) { return (float*)(F.ws + WS_RW + (size_t)i * RW_STRIDE); }
enum { RW_R = 0, RW_W = 1, RW_K = 2, RW_V = 3, RW_AA = 4, RW_BB = 5, RW_G = 6, RW_Y = 7 };
DI f32x4 shift4(const bf16* Z, int t, int col, const float* mu) {
    const v2u c = *(const v2u*)(Z + (size_t)t * NZ + col); v2u p = (v2u){0u, 0u}; if (t > 0) p = *(const v2u*)(Z + (size_t)(t - 1) * NZ + col);
    const f32x4 m = *(const f32x4*)(mu + col);
    f32x4 cv = (f32x4){bflo(c.x), bfhi(c.x), bflo(c.y), bfhi(c.y)}, pv = (f32x4){bflo(p.x), bfhi(p.x), bflo(p.y), bfhi(p.y)};
    return cv + (pv - cv) * m;
}
DI void phase_rw_prep(const Ctx& F, const float* const* in, int l) {
    const bf16* Z = (const bf16*)(F.ws + WS_Z);
    const float* mu = in[7] + (size_t)l * 3360; const float* w0 = in[8] + (size_t)l * 1024; const float* a0 = in[10] + (size_t)l * 1024;
    const float* k_k = in[13] + (size_t)l * 1024; const float* k_a = in[14] + (size_t)l * 1024;
    const bf16* WLW = (const bf16*)(F.ws + WS_WLW); const bf16* WLA = (const bf16*)(F.ws + WS_WLA); const bf16* WLG = (const bf16*)(F.ws + WS_WLG);
    float* R = rwbuf(F, RW_R); float* W = rwbuf(F, RW_W); float* K2 = rwbuf(F, RW_K); float* V = rwbuf(F, RW_V); float* AA = rwbuf(F, RW_AA); float* BB = rwbuf(F, RW_BB); float* G = rwbuf(F, RW_G);
    LAS bf16* As = (LAS bf16*)F.lds;
    const int r = F.lane & 15, q = F.lane >> 4;
    for (int tile = F.bid; tile < T / 16; tile += F.G) {
        const int t0 = tile * 16;
        for (int i = F.tid; i < 16 * 288; i += NTHR) { const int row = i / 288, c = i - row * 288, t = t0 + row, zc = ZWD + c;
            const float cur = bf2f(Z[(size_t)t * NZ + zc]); const float prev = t > 0 ? bf2f(Z[(size_t)(t - 1) * NZ + zc]) : 0.f;
            const float zs = cur + (prev - cur) * mu[zc];
            const float val = c < 64 ? tanhf(zs) : (c < 128 ? zs : sigmoidf_(zs));
            As[row * 296 + c] = (bf16)f2bf(val); }
        __syncthreads();
        bf16x8 aw[2], aa[2], ag[5];
#pragma unroll
        for (int s = 0; s < 2; ++s) { aw[s] = *(const LAS bf16x8*)(As + r * 296 + 32 * s + 8 * q); aa[s] = *(const LAS bf16x8*)(As + r * 296 + 64 + 32 * s + 8 * q); }
#pragma unroll
        for (int s = 0; s < 5; ++s) ag[s] = *(const LAS bf16x8*)(As + r * 296 + 128 + 32 * s + 8 * q);
        const int t = t0 + r;
#pragma unroll 1
        for (int hh = 0; hh < 2; ++hh) {
            f32x4 kraw[4], av[4]; float ssq = 0.f;
#pragma unroll
            for (int ct = 0; ct < 4; ++ct) {
                const int n0 = F.wave * 128 + hh * 64 + ct * 16, n = n0 + 4 * q;
                f32x4 cw = (f32x4){0.f, 0.f, 0.f, 0.f}, ca = cw, cg = cw;
#pragma unroll
                for (int s = 0; s < 2; ++s) { cw = MFMA16(*(const bf16x8*)(WLW + (size_t)(n0 + r) * 64 + 32 * s + 8 * q), aw[s], cw); ca = MFMA16(*(const bf16x8*)(WLA + (size_t)(n0 + r) * 64 + 32 * s + 8 * q), aa[s], ca); }
#pragma unroll
                for (int s = 0; s < 5; ++s) cg = MFMA16(*(const bf16x8*)(WLG + (size_t)(n0 + r) * 160 + 32 * s + 8 * q), ag[s], cg);
                const f32x4 w0v = *(const f32x4*)(w0 + n), a0v = *(const f32x4*)(a0 + n), kkv = *(const f32x4*)(k_k + n), kav = *(const f32x4*)(k_a + n);
                const f32x4 rs_ = shift4(Z, t, ZR + n, mu), ks_ = shift4(Z, t, ZK + n, mu), vs_ = shift4(Z, t, ZV + n, mu);
                f32x4 dec, a, k2;
#pragma unroll
                for (int j = 0; j < 4; ++j) { const float wl = w0v[j] + cw[j]; const float ls = fminf(wl, 0.f) - log1pf(__expf(-fabsf(wl)));
                    dec[j] = __expf(-__expf(ls - 0.5f)); a[j] = sigmoidf_(a0v[j] + ca[j]); k2[j] = ks_[j] * (1.0f + (a[j] - 1.0f) * kav[j]); }
                kraw[ct] = ks_ * kkv; av[ct] = a; ssq += (kraw[ct][0] * kraw[ct][0] + kraw[ct][1] * kraw[ct][1]) + (kraw[ct][2] * kraw[ct][2] + kraw[ct][3] * kraw[ct][3]);
                const size_t o = (size_t)t * 1024 + n;
                *(f32x4*)(R + o) = rs_; *(f32x4*)(W + o) = dec; *(f32x4*)(K2 + o) = k2; *(f32x4*)(V + o) = vs_; *(f32x4*)(G + o) = cg;
            }
            ssq += __shfl_xor(ssq, 16); ssq += __shfl_xor(ssq, 32);
            const float inv = 1.0f / fmaxf(sqrtf(ssq), 1e-12f);
#pragma unroll
            for (int ct = 0; ct < 4; ++ct) { const size_t o = (size_t)t * 1024 + F.wave * 128 + hh * 64 + ct * 16 + 4 * q; const f32x4 kk = kraw[ct] * inv;
                *(f32x4*)(AA + o) = -kk; *(f32x4*)(BB + o) = kk * av[ct]; }
        }
        __syncthreads();
    }
}
DI void phase_rw_scan_naive(const Ctx& F) {
    if (F.wave != 0 || F.bid >= 16) return;
    const int h = F.bid, lane = F.lane;
    const float* AA = rwbuf(F, RW_AA); const float* W = rwbuf(F, RW_W); const float* BB = rwbuf(F, RW_BB); const float* K2 = rwbuf(F, RW_K); const float* R = rwbuf(F, RW_R); const float* V = rwbuf(F, RW_V);
    float* Y = rwbuf(F, RW_Y);
    LAS float* buf = (LAS float*)F.lds;
    float S[64];
#pragma unroll
    for (int k = 0; k < 64; ++k) S[k] = 0.f;
    for (int t0 = 0; t0 < T; t0 += 8) {
#pragma unroll
        for (int s = 0; s < 8; ++s) { const size_t o = (size_t)(t0 + s) * 1024 + h * 64 + lane;
            buf[(s * 5 + 0) * 64 + lane] = AA[o]; buf[(s * 5 + 1) * 64 + lane] = W[o]; buf[(s * 5 + 2) * 64 + lane] = BB[o]; buf[(s * 5 + 3) * 64 + lane] = K2[o]; buf[(s * 5 + 4) * 64 + lane] = R[o]; }
        LDS_WAIT(); asm volatile("" ::: "memory");
#pragma unroll 1
        for (int s = 0; s < 8; ++s) {
            const float v = V[(size_t)(t0 + s) * 1024 + h * 64 + lane];
            const LAS f32x4* pa = (const LAS f32x4*)(buf + (s * 5 + 0) * 64); const LAS f32x4* pw = (const LAS f32x4*)(buf + (s * 5 + 1) * 64);
            const LAS f32x4* pb = (const LAS f32x4*)(buf + (s * 5 + 2) * 64); const LAS f32x4* pk = (const LAS f32x4*)(buf + (s * 5 + 3) * 64); const LAS f32x4* pr = (const LAS f32x4*)(buf + (s * 5 + 4) * 64);
            float sa = 0.f;
#pragma unroll
            for (int k4 = 0; k4 < 16; ++k4) { const f32x4 a4 = pa[k4];
#pragma unroll
                for (int j = 0; j < 4; ++j) sa += S[4 * k4 + j] * a4[j]; }
            float y = 0.f;
#pragma unroll
            for (int k4 = 0; k4 < 16; ++k4) { const f32x4 w4 = pw[k4], b4 = pb[k4], kk4 = pk[k4], r4 = pr[k4];
#pragma unroll
                for (int j = 0; j < 4; ++j) { float x = S[4 * k4 + j] * w4[j]; x = fmaf(sa, b4[j], x); x = fmaf(v, kk4[j], x); S[4 * k4 + j] = x; y = fmaf(x, r4[j], y); } }
            Y[(size_t)(t0 + s) * 1024 + h * 64 + lane] = y;
        }
        asm volatile("" ::: "memory");
    }
}
DI void phase_rw_out(const Ctx& F, const float* const* in, int l) {
    const float* Y = rwbuf(F, RW_Y); const float* R = rwbuf(F, RW_R); const float* K2 = rwbuf(F, RW_K); const float* V = rwbuf(F, RW_V); const float* G = rwbuf(F, RW_G);
    const float* r_k = in[15] + (size_t)l * 1024; const float* lg = in[16] + (size_t)l * 1024; const float* lb = in[17] + (size_t)l * 1024;
    bf16* YO = (bf16*)(F.ws + WS_Y);
    const int c0 = 16 * F.lane;
    for (int t = F.gw; t < T; t += F.NGW) {
        const size_t o = (size_t)t * 1024 + c0;
        f32x4 y[4], rr[4], kk[4], vv[4], gg[4];
#pragma unroll
        for (int j = 0; j < 4; ++j) { y[j] = *(const f32x4*)(Y + o + 4 * j); rr[j] = *(const f32x4*)(R + o + 4 * j); kk[j] = *(const f32x4*)(K2 + o + 4 * j); vv[j] = *(const f32x4*)(V + o + 4 * j); gg[j] = *(const f32x4*)(G + o + 4 * j); }
        float s = 0.f, bs = 0.f;
#pragma unroll
        for (int j = 0; j < 4; ++j) { const f32x4 rk = *(const f32x4*)(r_k + c0 + 4 * j);
#pragma unroll
            for (int e = 0; e < 4; ++e) { s += y[j][e]; bs += rr[j][e] * kk[j][e] * rk[e]; } }
        s += __shfl_xor(s, 1); s += __shfl_xor(s, 2); bs += __shfl_xor(bs, 1); bs += __shfl_xor(bs, 2);
        const float mean = s * (1.0f / 64.0f); float q2 = 0.f;
#pragma unroll
        for (int j = 0; j < 4; ++j)
#pragma unroll
            for (int e = 0; e < 4; ++e) { const float d = y[j][e] - mean; q2 += d * d; }
        q2 += __shfl_xor(q2, 1); q2 += __shfl_xor(q2, 2);
        const float rstd = __builtin_amdgcn_rsqf(q2 * (1.0f / 64.0f) + 64e-5f);
        unsigned w[8];
#pragma unroll
        for (int j = 0; j < 4; ++j) { const f32x4 g4 = *(const f32x4*)(lg + c0 + 4 * j), b4 = *(const f32x4*)(lb + c0 + 4 * j); float ov[4];
#pragma unroll
            for (int e = 0; e < 4; ++e) ov[e] = (((y[j][e] - mean) * rstd) * g4[e] + b4[e] + bs * vv[j][e]) * gg[j][e];
            w[2 * j] = pk2(ov[0], ov[1]); w[2 * j + 1] = pk2(ov[2], ov[3]); }
        v4u* op = (v4u*)(YO + (size_t)t * 1024 + c0); op[0] = (v4u){w[0], w[1], w[2], w[3]}; op[1] = (v4u){w[4], w[5], w[6], w[7]};
    }
}
DI void phase_dsa_prep(const Ctx& F, const float* const* in, int l) {
    const bf16* Z = (const bf16*)(F.ws + WS_Z); bf16* DC = (bf16*)(F.ws + WS_DC); bf16* DKI = (bf16*)(F.ws + WS_DKI); float* DWI = (float*)(F.ws + WS_DWI);
    const float* cg = in[18] + (size_t)l * 256; const float* kg = in[19] + (size_t)l * 64;
    const f32x4 cg4 = *(const f32x4*)(cg + 4 * F.lane); const float kg1 = kg[F.lane];
    for (int t = F.gw; t < T; t += F.NGW) {
        const v2u c = *(const v2u*)(Z + (size_t)t * NZ + ZCKV + 4 * F.lane);
        f32x4 cv = (f32x4){bflo(c.x), bfhi(c.x), bflo(c.y), bfhi(c.y)};
        const float ss = wave_sum((cv[0] * cv[0] + cv[1] * cv[1]) + (cv[2] * cv[2] + cv[3] * cv[3]));
        cv = cv * __builtin_amdgcn_rsqf(ss * (1.0f / 256.0f) + EPS) * cg4;
        v2u o; o.x = pk2(cv[0], cv[1]); o.y = pk2(cv[2], cv[3]); *(v2u*)(DC + (size_t)t * 256 + 4 * F.lane) = o;
        const float kv = bf2f(Z[(size_t)t * NZ + ZKI + F.lane]);
        const float ks = wave_sum(kv * kv);
        DKI[(size_t)t * 64 + F.lane] = (bf16)f2bf(kv * __builtin_amdgcn_rsqf(ks * (1.0f / 64.0f) + EPS) * kg1);
        if (F.lane < 16) DWI[(size_t)t * 16 + F.lane] = bf2f(Z[(size_t)t * NZ + ZWI + F.lane]) * (1.0f / 32.0f);
    }
    const bf16* WUK = (const bf16*)(F.ws + WS_WUK); bf16* DQL = (bf16*)(F.ws + WS_DQL);
    for (int it = F.gw; it < 256 * 8; it += F.NGW) { const int mt = it >> 3, h = it & 7;
#pragma unroll 1
        for (int nt = 0; nt < 8; ++nt)
            wave_gemm32_bf16(Z + (size_t)(mt * 32) * NZ + ZDQ + h * 128, NZ, WUK + (size_t)h * 256 * 128 + (size_t)(nt * 32) * 128, 128, 128, DQL + (size_t)(mt * 32) * 2048 + h * 256 + nt * 32, 2048, F.lane); }
}
DI void phase_dsa_index(const Ctx& F) {
    const bf16* Z = (const bf16*)(F.ws + WS_Z); const bf16* DKI = (const bf16*)(F.ws + WS_DKI); const float* DWI = (const float*)(F.ws + WS_DWI); float* DSC = (float*)(F.ws + WS_DSC);
    const int r = F.lane & 31, hh = F.lane >> 5;
    for (int task = F.gw; task < 4608; task += F.NGW) {
        int c = 0, rem = task; while (rem >= 1024 - 128 * c) { rem -= 1024 - 128 * c; ++c; }
        const int g = 128 * c + rem, t0 = 8 * g, kstart = 1024 * c; int kend = kstart + 1024; if (kend > t0 + 8) kend = t0 + 8;
        const int nblk = (kend - kstart + 31) >> 5;
        bf16x8 A[4][4]; float wv[4][2][8];
#pragma unroll
        for (int rb = 0; rb < 4; ++rb) { const int tok = t0 + 2 * rb + (r >> 4), head = r & 15;
#pragma unroll
            for (int s = 0; s < 4; ++s) A[rb][s] = *(const bf16x8*)(Z + (size_t)tok * NZ + ZQI + head * 64 + 16 * s + 8 * hh);
#pragma unroll
            for (int tk = 0; tk < 2; ++tk)
#pragma unroll
                for (int i = 0; i < 8; ++i) wv[rb][tk][i] = DWI[(size_t)(t0 + 2 * rb + tk) * 16 + (i & 3) + 8 * (i >> 2) + 4 * hh]; }
#pragma unroll 1
        for (int kb = 0; kb < nblk; ++kb) {
            const int s0 = kstart + 32 * kb;
            bf16x8 B[4];
#pragma unroll
            for (int s = 0; s < 4; ++s) B[s] = *(const bf16x8*)(DKI + (size_t)(s0 + r) * 64 + 16 * s + 8 * hh);
#pragma unroll
            for (int rb = 0; rb < 4; ++rb) {
                f32x16 x;
#pragma unroll
                for (int i = 0; i < 16; ++i) x[i] = 0.f;
#pragma unroll
                for (int s = 0; s < 4; ++s) x = MFMA32(A[rb][s], B[s], x);
                float p0 = 0.f, p1 = 0.f;
#pragma unroll
                for (int i = 0; i < 8; ++i) { p0 = fmaf(wv[rb][0][i], fmaxf(x[i], 0.f), p0); p1 = fmaf(wv[rb][1][i], fmaxf(x[8 + i], 0.f), p1); }
                p0 += __shfl_xor(p0, 32); p1 += __shfl_xor(p1, 32);
                DSC[(size_t)(t0 + 2 * rb + hh) * T + s0 + r] = hh ? p1 : p0;
            }
        }
    }
}
DI unsigned fkey(float f) { const unsigned u = __float_as_uint(f); return (u & 0x80000000u) ? ~u : (u | 0x80000000u); }
DI void phase_dsa_topk(const Ctx& F) {
    const float* DSC = (const float*)(F.ws + WS_DSC); int* IDX = (int*)(F.ws + WS_DIDX);
    LAS unsigned* hist = (LAS unsigned*)(F.lds + F.wave * 1024);
    const int lane = F.lane;
    for (int t = F.gw; t < T; t += F.NGW) {
        const int n = t + 1; int* out = IDX + (size_t)t * 256; const float* row = DSC + (size_t)t * T;
        if (n <= 256) { for (int i = lane; i < 256; i += 64) out[i] = i < n ? i : -1; continue; }
        unsigned prefix = 0u, mask = 0u; int need = 256;
#pragma unroll 1
        for (int pass = 0; pass < 4; ++pass) {
            const int shift = 24 - 8 * pass;
#pragma unroll
            for (int j = 0; j < 4; ++j) hist[4 * lane + j] = 0u;
            LDS_WAIT(); asm volatile("" ::: "memory");
            for (int i = lane; i < n; i += 64) { const unsigned u = fkey(row[i]); if ((u & mask) == prefix) __hip_atomic_fetch_add(hist + ((u >> shift) & 255u), 1u, __ATOMIC_RELAXED, __HIP_MEMORY_SCOPE_WORKGROUP); }
            LDS_WAIT(); asm volatile("" ::: "memory");
            const unsigned c0 = hist[4 * lane], c1 = hist[4 * lane + 1], c2 = hist[4 * lane + 2], c3 = hist[4 * lane + 3];
            LDS_WAIT(); asm volatile("" ::: "memory");
            const int ct = (int)(c0 + c1 + c2 + c3); int incl = ct;
#pragma unroll
            for (int o = 1; o < 64; o <<= 1) { const int v = __shfl_down(incl, o); if (lane + o < 64) incl += v; }
            const int above = incl - ct;
            const bool target = (above < need) && (incl >= need);
            int bin_l = 0, cab_l = 0;
            if (target) { int cum = above;
                if (cum + (int)c3 >= need) { bin_l = 4 * lane + 3; cab_l = cum; }
                else { cum += (int)c3; if (cum + (int)c2 >= need) { bin_l = 4 * lane + 2; cab_l = cum; }
                else { cum += (int)c2; if (cum + (int)c1 >= need) { bin_l = 4 * lane + 1; cab_l = cum; }
                else { cum += (int)c1; bin_l = 4 * lane; cab_l = cum; } } } }
            const unsigned long long bal = __ballot(target); const int src = bal ? (__ffsll((long long)bal) - 1) : 0;
            const int bin = __shfl(bin_l, src), cab = __shfl(cab_l, src);
            need -= cab; prefix |= ((unsigned)bin) << shift; mask |= 255u << shift;
        }
        const int ngt = 256 - need; int cgt = 0, ceq = 0;
        for (int base = 0; base < n; base += 64) { const int i = base + lane; const unsigned u = i < n ? fkey(row[i]) : 0u;
            const bool gt = (i < n) && (u > prefix), eq = (i < n) && (u == prefix);
            const unsigned long long bg = __ballot(gt), be = __ballot(eq); const unsigned long long lt = (1ull << lane) - 1ull;
            if (gt) { const int pos = cgt + __popcll(bg & lt); if (pos < 256) out[pos] = i; }
            if (eq) { const int pe = ceq + __popcll(be & lt); if (pe < need) out[ngt + pe] = i; }
            cgt += __popcll(bg); ceq += __popcll(be); }
    }
}
constexpr int ATT_RS = 544;
DI void phase_dsa_attn(const Ctx& F, const float* const* in) {
    const bf16* DC = (const bf16*)(F.ws + WS_DC); const bf16* DQL = (const bf16*)(F.ws + WS_DQL); const int* IDX = (const int*)(F.ws + WS_DIDX); bf16* DOL = (bf16*)(F.ws + WS_DOL);
    LAS int* tab = (LAS int*)(F.lds + 139264); LAS float* rbs = (LAS float*)(F.lds + 139264 + 512);
    if (F.tid < 128) { const int nn = F.tid; int b;
        if (nn < 16) b = nn; else { b = 16 + (int)(logf((float)nn / 16.0f) / 2.0794415416798357f * 16.0f); if (b > 31) b = 31; }
        tab[nn] = b; }
    if (F.tid < 256) rbs[F.tid] = in[22][F.tid];
    __syncthreads();
    LAS unsigned char* tile = F.lds + F.wave * (32 * ATT_RS);
    const unsigned tile_a = (unsigned)(size_t)tile;
    const int lane = F.lane, r = lane & 15, q = lane >> 4, head = r & 7;
    for (int t = F.gw; t < T; t += F.NGW) {
        const int cnt = t + 1 < 256 ? t + 1 : 256, nch = (cnt + 31) >> 5;
        bf16x8 Qf[8];
#pragma unroll
        for (int s = 0; s < 8; ++s) Qf[s] = *(const bf16x8*)(DQL + (size_t)t * 2048 + head * 256 + 32 * s + 8 * q);
        f32x4 OT[16];
#pragma unroll
        for (int d = 0; d < 16; ++d) OT[d] = (f32x4){0.f, 0.f, 0.f, 0.f};
        float mrun = -INFINITY, lrun = 0.f;
#pragma unroll 1
        for (int ch = 0; ch < nch; ++ch) {
            const int slot_l = 32 * ch + (lane & 31);
            int idxv = slot_l < cnt ? IDX[(size_t)t * 256 + slot_l] : 0;
#pragma unroll
            for (int i = 0; i < 16; ++i) { const int row = 2 * i + (lane >> 5); const int src = __shfl(idxv, row);
                const v4u v = *(const v4u*)(DC + (size_t)src * 256 + 8 * (lane & 31)); *(LAS v4u*)(tile + row * ATT_RS + 16 * (lane & 31)) = v; }
            LDS_WAIT(); asm volatile("" ::: "memory");
            f32x4 st[2];
#pragma unroll
            for (int rt = 0; rt < 2; ++rt) { st[rt] = (f32x4){0.f, 0.f, 0.f, 0.f};
#pragma unroll
                for (int s = 0; s < 8; ++s) { const bf16x8 cf = *(const LAS bf16x8*)(tile + (16 * rt + r) * ATT_RS + (32 * s + 8 * q) * 2); st[rt] = MFMA16(cf, Qf[s], st[rt]); } }
            float p[2][4]; float cmax = -INFINITY;
#pragma unroll
            for (int rt = 0; rt < 2; ++rt)
#pragma unroll
                for (int e = 0; e < 4; ++e) { const int kl = 16 * rt + 4 * q + e; const int kidx = __shfl(idxv, kl); const int dist = t - kidx;
                    const int bkt = dist < 128 ? tab[dist < 0 ? 0 : dist] : 31; const float lg = (32 * ch + kl < cnt) ? st[rt][e] + rbs[bkt * 8 + head] : -INFINITY;
                    p[rt][e] = lg; cmax = fmaxf(cmax, lg); }
            cmax = fmaxf(cmax, __shfl_xor(cmax, 16)); cmax = fmaxf(cmax, __shfl_xor(cmax, 32));
            const float mnew = fmaxf(mrun, cmax); const float alpha = __expf(mrun - mnew); float psum = 0.f;
#pragma unroll
            for (int rt = 0; rt < 2; ++rt)
#pragma unroll
                for (int e = 0; e < 4; ++e) { p[rt][e] = __expf(p[rt][e] - mnew); psum += p[rt][e]; }
            psum += __shfl_xor(psum, 16); psum += __shfl_xor(psum, 32);
            lrun = lrun * alpha + psum; mrun = mnew;
            v4u pbw; pbw.x = pk2(p[0][0], p[0][1]); pbw.y = pk2(p[0][2], p[0][3]); pbw.z = pk2(p[1][0], p[1][1]); pbw.w = pk2(p[1][2], p[1][3]);
            const bf16x8 pb = __builtin_bit_cast(bf16x8, pbw);
            const unsigned ra = tile_a + (unsigned)((4 * q + (r >> 2)) * ATT_RS + 8 * (r & 3));
#pragma unroll
            for (int d = 0; d < 16; ++d) { OT[d] = OT[d] * alpha;
                const bf16x4 lo = tr_read(ra + 32 * d), hi = tr_read(ra + 16 * ATT_RS + 32 * d);
                OT[d] = MFMA16(cat8(lo, hi), pb, OT[d]); }
        }
        const float inv = 1.0f / lrun;
        if (r < 8) {
#pragma unroll
            for (int d = 0; d < 16; ++d) { v2u w; w.x = pk2(OT[d][0] * inv, OT[d][1] * inv); w.y = pk2(OT[d][2] * inv, OT[d][3] * inv);
                *(v2u*)(DOL + (size_t)t * 2048 + head * 256 + 16 * d + 4 * q) = w; }
        }
    }
}
DI void phase_dsa_uv(const Ctx& F) {
    const bf16* DOL = (const bf16*)(F.ws + WS_DOL); const bf16* WUV = (const bf16*)(F.ws + WS_WUV); bf16* YO = (bf16*)(F.ws + WS_Y) + (size_t)T * 1024;
    for (int it = F.gw; it < 256 * 8; it += F.NGW) { const int mt = it >> 3, h = it & 7;
#pragma unroll 1
        for (int nt = 0; nt < 4; ++nt)
            wave_gemm32_bf16(DOL + (size_t)(mt * 32) * 2048 + h * 256, 2048, WUV + (size_t)h * 128 * 256 + (size_t)(nt * 32) * 256, 256, 256, YO + (size_t)(mt * 32) * 1024 + h * 128 + nt * 32, 1024, F.lane); }
}
DI float* ml_small(const Ctx& F, int off_floats) { return (float*)(F.ws + WS_MSM) + off_floats; }
constexpr int MS_LI = 0, MS_LF = 32768, MS_GC = 65536, MS_GTOT = 98304, MS_WMAX = 98560, MS_MST = 98816, MS_NLOC = 99072, MS_NST = 99072 + 32768;
DI float log_sigmoid(float x) { return fminf(x, 0.f) - log1pf(__expf(-fabsf(x))); }
DI void phase_ml_prep(const Ctx& F, const float* const* in, int l) {
    const bf16* Z = (const bf16*)(F.ws + WS_Z); bf16* MQK = (bf16*)(F.ws + WS_MQK);
    const float* cw = in[23] + (size_t)l * 4 * 1024; const float* b_i = in[24] + (size_t)l * 4; const float* b_f = in[25] + (size_t)l * 4;
    float* LI = ml_small(F, MS_LI); float* LF = ml_small(F, MS_LF);
    const int c0 = 16 * F.lane; const float qs = c0 < 512 ? 0.08838834764831845f : 1.0f;
    for (int t = F.gw; t < T; t += F.NGW) {
        float acc[16];
#pragma unroll
        for (int e = 0; e < 16; ++e) acc[e] = 0.f;
#pragma unroll
        for (int j = 0; j < 4; ++j) { const int tt = t - 3 + j; if (tt < 0) continue;
            const v4u z0 = *(const v4u*)(Z + (size_t)tt * NZ + ZMQ + c0), z1 = *(const v4u*)(Z + (size_t)tt * NZ + ZMQ + c0 + 8);
            const unsigned zw[8] = {z0.x, z0.y, z0.z, z0.w, z1.x, z1.y, z1.z, z1.w};
#pragma unroll
            for (int e = 0; e < 8; ++e) { const f32x2 w2 = *(const f32x2*)(cw + (size_t)j * 1024 + c0 + 2 * e); acc[2 * e] = fmaf(w2[0], bflo(zw[e]), acc[2 * e]); acc[2 * e + 1] = fmaf(w2[1], bfhi(zw[e]), acc[2 * e + 1]); } }
        unsigned w[8];
#pragma unroll
        for (int e = 0; e < 8; ++e) { const float a = acc[2 * e], b = acc[2 * e + 1]; w[e] = pk2(a * sigmoidf_(a) * qs, b * sigmoidf_(b) * qs); }
        v4u* op = (v4u*)(MQK + (size_t)t * 1024 + c0); op[0] = (v4u){w[0], w[1], w[2], w[3]}; op[1] = (v4u){w[4], w[5], w[6], w[7]};
        if (F.lane < 4) LI[t * 4 + F.lane] = bf2f(Z[(size_t)t * NZ + ZMI + F.lane]) + b_i[F.lane];
        else if (F.lane < 8) LF[t * 4 + F.lane - 4] = log_sigmoid(bf2f(Z[(size_t)t * NZ + ZMF + F.lane - 4]) + b_f[F.lane - 4]);
    }
}
constexpr int ML_KRS = 288, ML_VRS = 544;
DI void phase_ml_local(const Ctx& F) {
    const bf16* Z = (const bf16*)(F.ws + WS_Z); const bf16* MQK = (const bf16*)(F.ws + WS_MQK); float* MKL = (float*)(F.ws + WS_MKL);
    float* LI = ml_small(F, MS_LI); float* LF = ml_small(F, MS_LF); float* GC = ml_small(F, MS_GC); float* GTOT = ml_small(F, MS_GTOT); float* WMAX = ml_small(F, MS_WMAX); float* NLOC = ml_small(F, MS_NLOC);
    LAS unsigned char* vt = F.lds; LAS unsigned char* kt = F.lds + 128 * ML_VRS; LAS float* wgt = (LAS float*)(F.lds + 128 * ML_VRS + 128 * ML_KRS);
    const int lane = F.lane, r = lane & 15, q = lane >> 4;
    for (int unit = F.bid; unit < 256; unit += F.G) {
        const int c = unit >> 2, h = unit & 3, t0 = c * 128;
        if (F.wave == 0) {
            float f0 = LF[(t0 + 2 * lane) * 4 + h], f1 = LF[(t0 + 2 * lane + 1) * 4 + h];
            float s = f0 + f1;
#pragma unroll
            for (int o = 1; o < 64; o <<= 1) { const float v = __shfl_up(s, o); if (lane >= o) s += v; }
            const float g1 = s, g0 = s - f1;
            const float gtot = __shfl(g1, 63);
            GC[(t0 + 2 * lane) * 4 + h] = g0; GC[(t0 + 2 * lane + 1) * 4 + h] = g1;
            const float w0 = gtot - g0 + LI[(t0 + 2 * lane) * 4 + h], w1 = gtot - g1 + LI[(t0 + 2 * lane + 1) * 4 + h];
            const float wm = wave_max(fmaxf(w0, w1));
            wgt[2 * lane] = __expf(w0 - wm); wgt[2 * lane + 1] = __expf(w1 - wm);
            if (lane == 0) { GTOT[unit] = gtot; WMAX[unit] = wm; }
        }
        __syncthreads();
        for (int i = F.tid; i < 128 * 16; i += NTHR) { const int s = i >> 4, ch = i & 15;
            const v4u kv = *(const v4u*)(MQK + (size_t)(t0 + s) * 1024 + 512 + h * 128 + 8 * ch); const float wg = wgt[s];
            v4u o; o.x = pk2(bflo(kv.x) * wg, bfhi(kv.x) * wg); o.y = pk2(bflo(kv.y) * wg, bfhi(kv.y) * wg); o.z = pk2(bflo(kv.z) * wg, bfhi(kv.z) * wg); o.w = pk2(bflo(kv.w) * wg, bfhi(kv.w) * wg);
            *(LAS v4u*)(kt + s * ML_KRS + 16 * ch) = o; }
        for (int i = F.tid; i < 128 * 32; i += NTHR) { const int s = i >> 5, ch = i & 31;
            *(LAS v4u*)(vt + s * ML_VRS + 16 * ch) = *(const v4u*)(Z + (size_t)(t0 + s) * NZ + ZMV + h * 256 + 8 * ch); }
        __syncthreads();
        f32x4 acc[2][8];
#pragma unroll
        for (int i = 0; i < 2; ++i)
#pragma unroll
            for (int j = 0; j < 8; ++j) acc[i][j] = (f32x4){0.f, 0.f, 0.f, 0.f};
        const unsigned va = (unsigned)(size_t)vt + (unsigned)((r >> 2) * ML_VRS + 8 * (r & 3)), ka = (unsigned)(size_t)kt + (unsigned)((r >> 2) * ML_KRS + 8 * (r & 3));
#pragma unroll 1
        for (int ks = 0; ks < 4; ++ks) {
            bf16x8 af[2], bfr[8];
#pragma unroll
            for (int i = 0; i < 2; ++i) { const unsigned a0 = va + (unsigned)((32 * ks + 8 * q) * ML_VRS + 32 * (2 * F.wave + i)); af[i] = cat8(tr_read(a0), tr_read(a0 + 4 * ML_VRS)); }
#pragma unroll
            for (int j = 0; j < 8; ++j) { const unsigned b0 = ka + (unsigned)((32 * ks + 8 * q) * ML_KRS + 32 * j); bfr[j] = cat8(tr_read(b0), tr_read(b0 + 4 * ML_KRS)); }
#pragma unroll
            for (int i = 0; i < 2; ++i)
#pragma unroll
                for (int j = 0; j < 8; ++j) acc[i][j] = MFMA16(af[i], bfr[j], acc[i][j]);
        }
#pragma unroll
        for (int i = 0; i < 2; ++i)
#pragma unroll
            for (int j = 0; j < 8; ++j)
#pragma unroll
                for (int e = 0; e < 4; ++e) MKL[((size_t)unit * 256 + 16 * (2 * F.wave + i) + 4 * q + e) * 128 + 16 * j + r] = acc[i][j][e];
        if (F.tid < 128) { float s = 0.f; for (int ss = 0; ss < 128; ++ss) s += bf2f(*(const LAS bf16*)(kt + ss * ML_KRS + 2 * F.tid)); NLOC[unit * 128 + F.tid] = s; }
        __syncthreads();
    }
}
DI void phase_ml_scan(const Ctx& F) {
    const float* MKL = (const float*)(F.ws + WS_MKL); bf16* MCS = (bf16*)(F.ws + WS_MCS);
    const float* GTOT = ml_small(F, MS_GTOT); const float* WMAX = ml_small(F, MS_WMAX); float* MST = ml_small(F, MS_MST); const float* NLOC = ml_small(F, MS_NLOC); float* NST = ml_small(F, MS_NST);
    for (int idx = F.bid * NTHR + F.tid; idx < 4 * 256 * 128; idx += F.G * NTHR) {
        const int h = idx >> 15, e = (idx >> 7) & 255, d = idx & 127;
        float m = 0.f, cur = 0.f, ncur = 0.f;
        for (int c = 0; c < 64; ++c) { const int unit = c * 4 + h;
            MCS[((size_t)unit * 256 + e) * 128 + d] = (bf16)f2bf(cur);
            if (e == 0) { NST[unit * 128 + d] = ncur; if (d == 0) MST[unit] = m; }
            const float gt = GTOT[unit], wm = WMAX[unit]; const float mn = fmaxf(gt + m, wm); const float cd = __expf(gt + m - mn), cl = __expf(wm - mn);
            cur = cd * cur + cl * MKL[((size_t)unit * 256 + e) * 128 + d];
            if (e == 0) ncur = cd * ncur + cl * NLOC[unit * 128 + d];
            m = mn; }
    }
}
DI void phase_ml_out(const Ctx& F, const float* const* in, int l) {
    const bf16* Z = (const bf16*)(F.ws + WS_Z); const bf16* MQK = (const bf16*)(F.ws + WS_MQK); const bf16* MCS = (const bf16*)(F.ws + WS_MCS);
    const float* LI = ml_small(F, MS_LI); const float* GC = ml_small(F, MS_GC); const float* MST = ml_small(F, MS_MST); const float* NST = ml_small(F, MS_NST);
    const float* hn = in[26] + (size_t)l * 1024; bf16* YO = (bf16*)(F.ws + WS_Y) + (size_t)2 * T * 1024;
    LAS unsigned char* vt = F.lds; LAS float* gcs = (LAS float*)(F.lds + 128 * ML_VRS); LAS float* lgs = gcs + 128; LAS float* pms = gcs + 256; LAS float* nsts = gcs + 384;
    const int lane = F.lane, r = lane & 15, q = lane >> 4, w = F.wave;
    for (int unit = F.bid; unit < 256; unit += F.G) {
        const int c = unit >> 2, h = unit & 3, t0 = c * 128;
        for (int i = F.tid; i < 128 * 32; i += NTHR) { const int s = i >> 5, ch = i & 31;
            *(LAS v4u*)(vt + s * ML_VRS + 16 * ch) = *(const v4u*)(Z + (size_t)(t0 + s) * NZ + ZMV + h * 256 + 8 * ch); }
        if (w == 0) {
            const float g0 = GC[(t0 + 2 * lane) * 4 + h], g1 = GC[(t0 + 2 * lane + 1) * 4 + h];
            const float l0 = LI[(t0 + 2 * lane) * 4 + h] - g0, l1 = LI[(t0 + 2 * lane + 1) * 4 + h] - g1;
            float pm = fmaxf(l0, l1);
#pragma unroll
            for (int o = 1; o < 64; o <<= 1) { const float v = __shfl_up(pm, o); if (lane >= o) pm = fmaxf(pm, v); }
            float pprev = __shfl_up(pm, 1); if (lane == 0) pprev = -INFINITY;
            gcs[2 * lane] = g0; gcs[2 * lane + 1] = g1; lgs[2 * lane] = l0; lgs[2 * lane + 1] = l1; pms[2 * lane] = fmaxf(pprev, l0); pms[2 * lane + 1] = pm;
        }
        if (w == 1) { nsts[lane] = NST[unit * 128 + lane]; nsts[64 + lane] = NST[unit * 128 + 64 + lane]; }
        __syncthreads();
        const int j = 16 * w + r; const float mst = MST[unit];
        const float gcj = gcs[j], alog = gcj + mst, mq = fmaxf(alog, gcj + pms[j]), inter = __expf(alog - mq), gm = gcj - mq;
        bf16x8 qf[4], qi[4];
#pragma unroll
        for (int ks = 0; ks < 4; ++ks) { const v4u qv = *(const v4u*)(MQK + (size_t)(t0 + j) * 1024 + h * 128 + 32 * ks + 8 * q); qf[ks] = __builtin_bit_cast(bf16x8, qv);
            v4u o; o.x = pk2(bflo(qv.x) * inter, bfhi(qv.x) * inter); o.y = pk2(bflo(qv.y) * inter, bfhi(qv.y) * inter); o.z = pk2(bflo(qv.z) * inter, bfhi(qv.z) * inter); o.w = pk2(bflo(qv.w) * inter, bfhi(qv.w) * inter);
            qi[ks] = __builtin_bit_cast(bf16x8, o); }
        const int nkp = (w >> 1) + 1;
        LAS v4u* pls = (LAS v4u*)(F.lds + 73728) + w * 256;
#pragma unroll 1
        for (int kp = 0; kp < nkp; ++kp) {
            float pv[8];
#pragma unroll
            for (int hf = 0; hf < 2; ++hf) { const int st = 2 * kp + hf;
                f32x4 sacc = (f32x4){0.f, 0.f, 0.f, 0.f};
                if (st <= w) {
                    const bf16* kr = MQK + (size_t)(t0 + 16 * st + r) * 1024 + 512 + h * 128 + 8 * q;
#pragma unroll
                    for (int ks = 0; ks < 4; ++ks) { const bf16x8 kf = *(const bf16x8*)(kr + 32 * ks); sacc = MFMA16(kf, qf[ks], sacc); }
                }
#pragma unroll
                for (int e = 0; e < 4; ++e) { const int s = 16 * st + 4 * q + e; pv[4 * hf + e] = (st <= w && s <= j) ? sacc[e] * __expf(gm + lgs[s]) : 0.f; } }
            v4u o; o.x = pk2(pv[0], pv[1]); o.y = pk2(pv[2], pv[3]); o.z = pk2(pv[4], pv[5]); o.w = pk2(pv[6], pv[7]); pls[kp * 64 + lane] = o;
        }
        LDS_WAIT(); asm volatile("" ::: "memory");
        const unsigned va = (unsigned)(size_t)vt + (unsigned)((r >> 2) * ML_VRS + 8 * (r & 3)) + (unsigned)(4 * q * ML_VRS);
        const bf16* crow = MCS + ((size_t)unit * 256 + r) * 128 + 8 * q;
        f32x4 dacc = (f32x4){0.f, 0.f, 0.f, 0.f};
#pragma unroll
        for (int ks = 0; ks < 4; ++ks) { v4u o = (v4u){0u, 0u, 0u, 0u};
            if (r == 0) { const LAS float* np = nsts + 32 * ks + 8 * q; o.x = pk2(np[0], np[1]); o.y = pk2(np[2], np[3]); o.z = pk2(np[4], np[5]); o.w = pk2(np[6], np[7]); }
            dacc = MFMA16(__builtin_bit_cast(bf16x8, o), qi[ks], dacc); }
#pragma unroll
        for (int kp = 0; kp < 4; ++kp) if (kp < nkp) { const unsigned one2 = r == 0 ? 0x3f803f80u : 0u; const v4u o = (v4u){one2, one2, one2, one2}; dacc = MFMA16(__builtin_bit_cast(bf16x8, o), __builtin_bit_cast(bf16x8, pls[kp * 64 + lane]), dacc); }
        const float den = __shfl(dacc[0], r);
        const float dinv = 1.0f / fmaxf(fabsf(den), __expf(-mq));
        float ss = 0.f;
#pragma unroll 1
        for (int et = 0; et < 16; ++et) {
            f32x4 a = (f32x4){0.f, 0.f, 0.f, 0.f};
#pragma unroll
            for (int ks = 0; ks < 4; ++ks) { const bf16x8 cf = *(const bf16x8*)(crow + (size_t)(16 * et) * 128 + 32 * ks); a = MFMA16(cf, qi[ks], a); }
#pragma unroll
            for (int kp = 0; kp < 4; ++kp) if (kp < nkp) { const unsigned a0 = va + (unsigned)((32 * kp) * ML_VRS + 32 * et); a = MFMA16(cat8(tr_read(a0), tr_read(a0 + 16 * ML_VRS)), __builtin_bit_cast(bf16x8, pls[kp * 64 + lane]), a); }
            a = a * dinv; ss += (a[0] * a[0] + a[1] * a[1]) + (a[2] * a[2] + a[3] * a[3]);
        }
        ss += __shfl_xor(ss, 16); ss += __shfl_xor(ss, 32);
        const float rinv = __builtin_amdgcn_rsqf(ss * (1.0f / 256.0f) + EPS) * dinv;
        const int t = t0 + j;
#pragma unroll 1
        for (int et = 0; et < 16; ++et) {
            f32x4 a = (f32x4){0.f, 0.f, 0.f, 0.f};
#pragma unroll
            for (int ks = 0; ks < 4; ++ks) { const bf16x8 cf = *(const bf16x8*)(crow + (size_t)(16 * et) * 128 + 32 * ks); a = MFMA16(cf, qi[ks], a); }
#pragma unroll
            for (int kp = 0; kp < 4; ++kp) if (kp < nkp) { const unsigned a0 = va + (unsigned)((32 * kp) * ML_VRS + 32 * et); a = MFMA16(cat8(tr_read(a0), tr_read(a0 + 16 * ML_VRS)), __builtin_bit_cast(bf16x8, pls[kp * 64 + lane]), a); }
            const int e0 = 16 * et + 4 * q; const v2u ov = *(const v2u*)(Z + (size_t)t * NZ + ZMO + h * 256 + e0); const f32x4 g4 = *(const f32x4*)(hn + h * 256 + e0);
            const float o0 = sigmoidf_(bflo(ov.x)) * a[0] * rinv * g4[0], o1 = sigmoidf_(bfhi(ov.x)) * a[1] * rinv * g4[1], o2 = sigmoidf_(bflo(ov.y)) * a[2] * rinv * g4[2], o3 = sigmoidf_(bfhi(ov.y)) * a[3] * rinv * g4[3];
            v2u wv; wv.x = pk2(o0, o1); wv.y = pk2(o2, o3); *(v2u*)(YO + (size_t)t * 1024 + h * 256 + e0) = wv;
        }
        __syncthreads();
    }
}
constexpr int NPH = 20;
struct Args { const float* in[34]; float* out; unsigned char* ws; int ph_lo, ph_hi; };
#ifndef MK_PER_PHASE
#define MK_PER_PHASE 1
#endif

template <int PH> __global__ void __launch_bounds__(NTHR, 2) mega(Args args) {
    extern __shared__ __attribute__((aligned(16))) unsigned char lds_raw[];
    Ctx F;
    F.lds = (LAS unsigned char*)lds_raw; F.ws = args.ws;
    F.tid = threadIdx.x; F.lane = F.tid & 63; F.wave = __builtin_amdgcn_readfirstlane(F.tid >> 6);
    F.G = gridDim.x; F.bid = blockIdx.x; F.gw = F.bid * NWAVES + F.wave; F.NGW = F.G * NWAVES;
    for (int u = F.tid; u < (LDS_BYTES - LDSCTL_OFF) / 4; u += NTHR) ((LAS unsigned*)(F.lds + LDSCTL_OFF))[u] = 0u;
    __syncthreads();
    const int lo = args.ph_lo, hi = args.ph_hi;
    XcdBarrier bar; bar.bar = (unsigned*)(args.ws + WS_CTL) + CW_BAR; bar.x = 0; bar.st = nullptr;
    if (hi - lo > 1) bar = xcd_barrier_post((unsigned*)(args.ws + WS_CTL) + CW_BAR, (volatile LAS unsigned*)(F.lds + MISC_OFF));
    const float* const* in = args.in;
    unsigned char* ws = args.ws;
    bf16* HB = (bf16*)(ws + WS_HB); bf16* ACT = (bf16*)(ws + WS_ACT); float* FB = (float*)(ws + WS_F); bf16* Zb = (bf16*)(ws + WS_Z);
    float* RS = (float*)(ws + WS_RS); float* FSS = (float*)(ws + WS_FSS);
    LAS unsigned char* glds = (LAS unsigned char*)lds_raw;
#pragma unroll 1
    for (int l = 0; l < NL; ++l) {
        const int pb = l * NPH;
        const float* ng = in[2] + (size_t)l * 8 * D;
#define IN(k) ((PH < 0 || PH == (k)) && lo <= pb + (k) && pb + (k) < hi)
#define SEAM(k) do { if (IN(k) && pb + (k) + 1 < hi) xcd_barrier(bar); } while (0)
        if (IN(0)) { phase_conv(F, in, l); if (l == 0) phase_resid<true>(F, in[0], nullptr, 0.f, args.out); }
        SEAM(0);
        if (IN(1)) { pg8::Gemm g{HB, (const bf16*)(ws + WS_WGU1), T, 2 * FF, D}; pg8::StaticOrder S; S.init(T, 2 * FF, F.G, F.bid);
            pg8::EpiSwiglu E{ACT, FF, RS, 1.0f / D, EPS}; pg8::gemm_phase<pg8::EpiSwiglu, pg8::StaticOrder, true, true>(glds, g, S, E); }
        SEAM(1);
        if (IN(2)) { pg8::Gemm g{ACT, (const bf16*)(ws + WS_WD1), T, D, FF}; pg8::StaticOrder S; S.init(T, D, F.G, F.bid);
            pg8::EpiF32SS E{FB, D, FSS}; pg8::gemm_phase<pg8::EpiF32SS, pg8::StaticOrder, true, true>(glds, g, S, E); }
        SEAM(2);
        if (IN(3)) phase_resid<false>(F, FB, ng + 1 * D, 0.5f, args.out);
        SEAM(3);
        if (IN(4)) { pg8::Gemm g{HB, (const bf16*)(ws + WS_WIN), T, NZ, D}; pg8::StaticOrder S; S.init(T, NZ, F.G, F.bid);
            pg8::EpiScaleBf16 E{Zb, NZ, RS, 1.0f / D, EPS}; pg8::gemm_phase<pg8::EpiScaleBf16, pg8::StaticOrder, true, true>(glds, g, S, E); }
        SEAM(4);
        if (IN(5)) { phase_rw_prep(F, in, l); phase_dsa_prep(F, in, l); phase_ml_prep(F, in, l); }
        SEAM(5);
        if (IN(6)) phase_rw_scan_naive(F);
        SEAM(6);
        if (IN(7)) { phase_dsa_index(F); phase_ml_local(F); }
        SEAM(7);
        if (IN(8)) { phase_dsa_topk(F); phase_ml_scan(F); phase_rw_out(F, in, l); }
        SEAM(8);
        if (IN(9)) {
            __syncthreads(); phase_dsa_attn(F, in);
            __syncthreads(); phase_ml_out(F, in, l);
        }
        SEAM(9);
        if (IN(10)) phase_dsa_uv(F);
        SEAM(10);
        if (IN(11)) { pg8::Gemm g{(const bf16*)(ws + WS_Y), (const bf16*)(ws + WS_WBR), 3 * T, 3 * D, 1024}; pg8::BranchOrder S{F.G, F.bid};
            pg8::EpiBranch E{FB, (bf16*)(ws + WS_MIXG), Zb, NZ, ZG}; pg8::gemm_phase<pg8::EpiBranch, pg8::BranchOrder, true, true>(glds, g, S, E); }
        SEAM(11);
        if (IN(12)) { pg8::Gemm g{(const bf16*)(ws + WS_MIXG), (const bf16*)(ws + WS_WOUT), T, D, D}; pg8::StaticOrder S; S.init(T, D, F.G, F.bid);
            pg8::EpiF32SS E{FB, D, FSS}; pg8::gemm_phase<pg8::EpiF32SS, pg8::StaticOrder, true, true>(glds, g, S, E); }
        SEAM(12);
        if (IN(13)) phase_resid<false>(F, FB, ng + 3 * D, 1.0f, args.out);
        SEAM(13);
        if (IN(14)) { pg8::Gemm g{HB, (const bf16*)(ws + WS_WGU2), T, 2 * FF, D}; pg8::StaticOrder S; S.init(T, 2 * FF, F.G, F.bid);
            pg8::EpiSwiglu E{ACT, FF, RS, 1.0f / D, EPS}; pg8::gemm_phase<pg8::EpiSwiglu, pg8::StaticOrder, true, true>(glds, g, S, E); }
        SEAM(14);
        if (IN(15)) { pg8::Gemm g{ACT, (const bf16*)(ws + WS_WD2), T, D, FF}; pg8::StaticOrder S; S.init(T, D, F.G, F.bid);
            pg8::EpiF32SS E{FB, D, FSS}; pg8::gemm_phase<pg8::EpiF32SS, pg8::StaticOrder, true, true>(glds, g, S, E); }
        SEAM(15);
        if (IN(16)) phase_resid<false>(F, FB, ng + 5 * D, 0.5f, args.out);
        SEAM(16);
        if (IN(17)) { int kple = PLE; asm volatile("" : "+s"(kple)); pg8::Gemm g{(const bf16*)(ws + WS_PB), (const bf16*)(ws + WS_WPP), T, D, kple}; pg8::StaticOrder S; S.init(T, D, F.G, F.bid);
            pg8::EpiScaleBf16 E{(bf16*)(ws + WS_E), D, nullptr, 0.f, 0.f}; pg8::gemm_phase<pg8::EpiScaleBf16, pg8::StaticOrder, true, true>(glds, g, S, E); }
        SEAM(17);
        if (IN(18)) { pg8::Gemm g{HB, (const bf16*)(ws + WS_WPG), T, D, D}; pg8::StaticOrder S; S.init(T, D, F.G, F.bid);
            pg8::EpiPleGate E{FB, D, FSS, RS, (const bf16*)(ws + WS_E), 1.0f / D, EPS}; pg8::gemm_phase<pg8::EpiPleGate, pg8::StaticOrder, true, true>(glds, g, S, E); }
        SEAM(18);
        if (IN(19)) phase_resid<false>(F, FB, ng + 7 * D, 1.0f, args.out);
        SEAM(19);
#undef IN
#undef SEAM
    }
}

extern "C" void kernel_launch(void* const* d_in, const int* in_sizes, int n_in, void* d_out, int out_size, void* d_ws, size_t ws_size, hipStream_t stream) {
    static int grid = 0;
    if (grid == 0) {
        if (n_in != 34 || in_sizes[0] != T * D || out_size != T * D || ws_size < WS_END) { fprintf(stderr, "kernel_launch: unexpected problem (n_in %d, in0 %d, out %d, ws %zu < %zu); nothing launched\n", n_in, n_in > 0 ? in_sizes[0] : -1, out_size, ws_size, (size_t)WS_END); grid = -1; return; }
        int dev = 0, cus = 0;
        if (hipGetDevice(&dev) != hipSuccess || hipDeviceGetAttribute(&cus, hipDeviceAttributeMultiprocessorCount, dev) != hipSuccess) { grid = -1; return; }
        grid = cus;
    }
    if (grid < 0) return;
    (void)hipMemsetAsync((char*)d_ws + WS_CTL, 0, CTL_ZERO_BYTES, stream);
    Args a{};
    for (int i = 0; i < 34; ++i) a.in[i] = (const float*)d_in[i];
    a.out = (float*)d_out; a.ws = (unsigned char*)d_ws;
#if MK_PER_PHASE
    typedef void (*kfn)(Args);
    static const kfn tab[NPH] = { mega<0>, mega<1>, mega<2>, mega<3>, mega<4>, mega<5>, mega<6>, mega<7>, mega<8>, mega<9>, mega<10>, mega<11>, mega<12>, mega<13>, mega<14>, mega<15>, mega<16>, mega<17>, mega<18>, mega<19> };
    static bool attr = false;
    if (!attr) { for (int k = 0; k < NPH; ++k) if (hipFuncSetAttribute((const void*)tab[k], hipFuncAttributeMaxDynamicSharedMemorySize, LDS_BYTES) != hipSuccess) fprintf(stderr, "kernel_launch: hipFuncSetAttribute failed (phase %d)\n", k); attr = true; }
    for (int p = 0; p < NL * NPH; ++p) { a.ph_lo = p; a.ph_hi = p + 1; hipLaunchKernelGGL(tab[p % NPH], dim3(grid), dim3(NTHR), LDS_BYTES, stream, a); }
#else
    static bool attr = false;
    if (!attr) { if (hipFuncSetAttribute((const void*)mega<-1>, hipFuncAttributeMaxDynamicSharedMemorySize, LDS_BYTES) != hipSuccess) fprintf(stderr, "kernel_launch: hipFuncSetAttribute failed\n"); attr = true; }
    a.ph_lo = 0; a.ph_hi = NL * NPH; hipLaunchKernelGGL(mega<-1>, dim3(grid), dim3(NTHR), LDS_BYTES, stream, a);
#endif
}
```

```cpp
#include <hip/hip_runtime.h>
#include <cstdio>
#include <cstdint>
namespace pg8 {
#define PG8_LAS __attribute__((address_space(3)))
typedef unsigned short bf16_t;
typedef short bf16x8 __attribute__((ext_vector_type(8)));
typedef float f32x4 __attribute__((ext_vector_type(4)));
typedef unsigned u32x4 __attribute__((ext_vector_type(4)));
constexpr int BM = 256, BK = 64, HALF = 128, HTB = HALF * BK * 2  , STAGE_BYTES = 8 * HTB, NXCD = 8, WGM = 8;

__host__ __device__ __forceinline__ int lds_byte(int r, int c) { const int st = (r >> 4) * 2 + (c >> 5), rr = r & 15, cc = c & 31, ob = rr * 64 + cc * 2; return st * 1024 + (ob ^ (((ob >> 9) & 1) << 5)); }
__host__ __device__ __forceinline__ void stage_rc(int b, int& R, int& C) { const int st = b / 1024, sb = b % 1024, swz = sb ^ (((sb >> 9) & 1) << 5); R = (st >> 1) * 16 + swz / 64; C = (st & 1) * 32 + (swz % 64) / 2; }
__host__ __device__ __forceinline__ int perm32(int rho) { const int n = rho >> 4, i = rho & 15; return 8 * (i >> 2) + 4 * n + (i & 3); }

struct Unit { int pm, pn; };
struct Gemm { const bf16_t* A; const bf16_t* Bt; int M, N, K; };

struct StaticOrder {
    int nM, nN, nwg, G, c;
    __host__ __device__ void init(int M, int N, int G_, int c_) { nM = M / BM; nN = N / BM; nwg = nM * nN; G = G_; c = c_; }
    __host__ __device__ bool next(int i, Unit& u) const {
        const long L = (long)i * G + c; if (L >= nwg) return false;
        int wgid = (int)L; { const int q = nwg / NXCD, r = nwg % NXCD, xcd = wgid % NXCD, off = wgid / NXCD; wgid = (xcd < r ? xcd * (q + 1) : r * (q + 1) + (xcd - r) * q) + off; }
        const int nig = WGM * nN, gid = wgid / nig, fm = gid * WGM, gsz = (nM - fm) < WGM ? (nM - fm) : WGM;
        u.pm = fm + ((wgid % nig) % gsz); u.pn = (wgid % nig) / gsz; return true;
    }
    __device__ __forceinline__ void a_ready(const Unit&) const {}
    __device__ __forceinline__ void done(const Unit&) const {}
};
__device__ __forceinline__ unsigned cvt_pk_bf16(float lo, float hi) { unsigned r; asm volatile("v_cvt_pk_bf16_f32 %0, %1, %2" : "=v"(r) : "v"(lo), "v"(hi)); return r; }
typedef float f32x2 __attribute__((ext_vector_type(2)));
__device__ __forceinline__ float fast_sigmoid(float x) { return __builtin_amdgcn_rcpf(1.0f + __builtin_amdgcn_exp2f(-1.44269504089f * x)); }
typedef unsigned u32x2 __attribute__((ext_vector_type(2)));
struct EpiSwiglu {
    static constexpr bool PERM = true, AFTER_DRAIN = false;
    bf16_t* O; int ldo; const float* rs; float inv_d, eps;
    __device__ __forceinline__ void operator()(const f32x4 (&acc)[2][2][4][2], const Unit& u, int wr, int wc, int fr, int fq) const {
        const int row0 = u.pm * BM + wr * 64 + fr, col0 = u.pn * HALF + wc * 32 + 8 * fq;
#pragma unroll
        for (int ai = 0; ai < 2; ++ai)
#pragma unroll
            for (int m = 0; m < 4; ++m) { const int row = row0 + ai * HALF + m * 16; const float rinv = __builtin_amdgcn_rsqf(rs[row] * inv_d + eps);
                float o[8];
#pragma unroll
                for (int n = 0; n < 2; ++n)
#pragma unroll
                    for (int j = 0; j < 4; ++j) { const float g = acc[ai][0][m][n][j] * rinv, up = acc[ai][1][m][n][j] * rinv; o[4 * n + j] = g * fast_sigmoid(g) * up; }
                u32x4 w; w.x = cvt_pk_bf16(o[0], o[1]); w.y = cvt_pk_bf16(o[2], o[3]); w.z = cvt_pk_bf16(o[4], o[5]); w.w = cvt_pk_bf16(o[6], o[7]);
                *(u32x4*)(O + (size_t)row * ldo + col0) = w; }
    }
};
struct EpiScaleBf16 {
    static constexpr bool PERM = true, AFTER_DRAIN = false;
    bf16_t* O; int ldo; const float* rs; float inv_d, eps;
    __device__ __forceinline__ void operator()(const f32x4 (&acc)[2][2][4][2], const Unit& u, int wr, int wc, int fr, int fq) const {
        const int row0 = u.pm * BM + wr * 64 + fr, col0 = u.pn * BM + wc * 32 + 8 * fq;
#pragma unroll
        for (int ai = 0; ai < 2; ++ai)
#pragma unroll
            for (int m = 0; m < 4; ++m) { const int row = row0 + ai * HALF + m * 16; const float rinv = rs ? __builtin_amdgcn_rsqf(rs[row] * inv_d + eps) : 1.0f;
                bf16_t* rowp = O + (size_t)row * ldo + col0;
#pragma unroll
                for (int bj = 0; bj < 2; ++bj) { const f32x4 v0 = acc[ai][bj][m][0] * rinv, v1 = acc[ai][bj][m][1] * rinv;
                    u32x4 w; w.x = cvt_pk_bf16(v0[0], v0[1]); w.y = cvt_pk_bf16(v0[2], v0[3]); w.z = cvt_pk_bf16(v1[0], v1[1]); w.w = cvt_pk_bf16(v1[2], v1[3]);
                    *(u32x4*)(rowp + bj * HALF) = w; } }
    }
};
struct EpiF32SS {
    static constexpr bool PERM = false, AFTER_DRAIN = false;
    float* C; int ldc; float* ss;
    __device__ __forceinline__ void operator()(const f32x4 (&acc)[2][2][4][2], const Unit& u, int wr, int wc, int fr, int fq) const {
        const int row0 = u.pm * BM + wr * 64 + fr, col0 = u.pn * BM + wc * 32 + 4 * fq;
#pragma unroll
        for (int ai = 0; ai < 2; ++ai)
#pragma unroll
            for (int m = 0; m < 4; ++m) { const int row = row0 + ai * HALF + m * 16; float* rowp = C + (size_t)row * ldc + col0; float s = 0.f;
#pragma unroll
                for (int bj = 0; bj < 2; ++bj)
#pragma unroll
                    for (int n = 0; n < 2; ++n) { const f32x4 v = acc[ai][bj][m][n]; *(f32x4*)(rowp + bj * HALF + n * 16) = v; s += (v[0] * v[0] + v[1] * v[1]) + (v[2] * v[2] + v[3] * v[3]); }
                (void)s; }
    }
};
struct EpiBranch {
    static constexpr bool PERM = false, AFTER_DRAIN = false;
    float* MIX; bf16_t* MIXG; const bf16_t* Z; int ldz, zg0;
    __device__ __forceinline__ void operator()(const f32x4 (&acc)[2][2][4][2], const Unit& u, int wr, int wc, int fr, int fq) const {
        const int b = u.pm >> 5, pm = u.pm & 31, pn = u.pn & 7;
        const int row0 = pm * BM + wr * 64 + fr, col0 = pn * BM + wc * 32 + 4 * fq;
#pragma unroll
        for (int ai = 0; ai < 2; ++ai)
#pragma unroll
            for (int m = 0; m < 4; ++m) { const int row = row0 + ai * HALF + m * 16; const bf16_t* zp = Z + (size_t)row * ldz + zg0 + b * 2048 + col0; float* mp = MIX + (size_t)row * 2048 + col0; bf16_t* op = MIXG + (size_t)row * 2048 + col0;
#pragma unroll
                for (int bj = 0; bj < 2; ++bj)
#pragma unroll
                    for (int n = 0; n < 2; ++n) { const int co = bj * HALF + n * 16; const u32x2 gz = *(const u32x2*)(zp + co);
                        f32x4 g; g[0] = fast_sigmoid(__uint_as_float(gz.x << 16)); g[1] = fast_sigmoid(__uint_as_float(gz.x & 0xffff0000u)); g[2] = fast_sigmoid(__uint_as_float(gz.y << 16)); g[3] = fast_sigmoid(__uint_as_float(gz.y & 0xffff0000u));
                        f32x4 v = acc[ai][bj][m][n] * g;
                        if (b > 0) { f32x4 o; o[0] = __hip_atomic_load(mp + co + 0, __ATOMIC_RELAXED, __HIP_MEMORY_SCOPE_AGENT); o[1] = __hip_atomic_load(mp + co + 1, __ATOMIC_RELAXED, __HIP_MEMORY_SCOPE_AGENT);
                            o[2] = __hip_atomic_load(mp + co + 2, __ATOMIC_RELAXED, __HIP_MEMORY_SCOPE_AGENT); o[3] = __hip_atomic_load(mp + co + 3, __ATOMIC_RELAXED, __HIP_MEMORY_SCOPE_AGENT); v += o; }
                        if (b < 2) *(f32x4*)(mp + co) = v;
                        else { u32x2 w; w.x = cvt_pk_bf16(v[0], v[1]); w.y = cvt_pk_bf16(v[2], v[3]); *(u32x2*)(op + co) = w; } } }
    }
};
struct EpiPleGate {
    static constexpr bool PERM = false, AFTER_DRAIN = false;
    float* C; int ldc; float* ss; const float* rs; const bf16_t* E; float inv_d, eps;
    __device__ __forceinline__ void operator()(const f32x4 (&acc)[2][2][4][2], const Unit& u, int wr, int wc, int fr, int fq) const {
        const int row0 = u.pm * BM + wr * 64 + fr, col0 = u.pn * BM + wc * 32 + 4 * fq;
#pragma unroll
        for (int ai = 0; ai < 2; ++ai)
#pragma unroll
            for (int m = 0; m < 4; ++m) { const int row = row0 + ai * HALF + m * 16; float* rowp = C + (size_t)row * ldc + col0; const bf16_t* ep = E + (size_t)row * ldc + col0; float s = 0.f;
                const float rinv = __builtin_amdgcn_rsqf(rs[row] * inv_d + eps);
#pragma unroll
                for (int bj = 0; bj < 2; ++bj)
#pragma unroll
                    for (int n = 0; n < 2; ++n) { const int co = bj * HALF + n * 16; const u32x2 ez = *(const u32x2*)(ep + co); f32x4 v = acc[ai][bj][m][n] * rinv;
                        v[0] = fast_sigmoid(v[0]) * __uint_as_float(ez.x << 16); v[1] = fast_sigmoid(v[1]) * __uint_as_float(ez.x & 0xffff0000u);
                        v[2] = fast_sigmoid(v[2]) * __uint_as_float(ez.y << 16); v[3] = fast_sigmoid(v[3]) * __uint_as_float(ez.y & 0xffff0000u);
                        *(f32x4*)(rowp + co) = v; s += (v[0] * v[0] + v[1] * v[1]) + (v[2] * v[2] + v[3] * v[3]); }
                (void)s; }
    }
};
struct BranchOrder {
    int G, c;
    __device__ __forceinline__ bool next(int i, Unit& u) const { const int tile = c + (i / 3) * G, b = i % 3; if (tile >= 256) return false; u.pm = b * 32 + (tile & 31); u.pn = b * 8 + (tile >> 5); return true; }
    __device__ __forceinline__ void a_ready(const Unit&) const {}
    __device__ __forceinline__ void done(const Unit&) const {}
};
template <class Epi, class Sched, bool ALIGN_EPI = false, bool SP2 = false>
__device__ __forceinline__ void gemm_phase(PG8_LAS unsigned char* lds, const Gemm g, const Sched& S, const Epi& E, const int tid_in) {
    const int tid = tid_in, wid = __builtin_amdgcn_readfirstlane(tid >> 6), lane = tid & 63, wr = wid >> 2, wc = wid & 3, fr = lane & 15, fq = lane >> 4;
    const int K = g.K, nt = K / BK;
    unsigned voffA[2], voffB[2];
#pragma unroll
    for (int i = 0; i < 2; ++i) { int R, C; stage_rc(tid * 16 + i * 8192, R, C); const int Rb = Epi::PERM ? ((R & ~31) + perm32(R & 31)) : R;
        voffA[i] = (unsigned)(R * K + C) * 2u; voffB[i] = (unsigned)(Rb * K + C) * 2u; }
    const size_t kstep = (size_t)(BK * 2);
    const size_t hstep = (size_t)HALF * K * 2;
    const size_t tstep = 2 * hstep;
    const unsigned ldsw = (unsigned)wid * 1024u;
    const int aoff = lds_byte(wr * 64 + fr, fq * 8), boff = lds_byte(wc * 32 + fr, fq * 8);
#define PG8_SA(b, h) (((b) * 2 + (h)) * HTB)
#define PG8_SB(b, h) ((4 + (b) * 2 + (h)) * HTB)
#define PG8_STAGE(bufoff, gbase, voff) do { _Pragma("unroll") for (int _i = 0; _i < 2; ++_i) \
        __builtin_amdgcn_global_load_lds((const unsigned*)((const char*)(gbase) + (voff)[_i]), (PG8_LAS unsigned*)(lds + (bufoff) + ldsw + _i * 8192), 16, 0, 0); } while (0)
#define PG8_LDA(dst, b, h) do { _Pragma("unroll") for (int m = 0; m < 4; ++m) _Pragma("unroll") for (int k = 0; k < 2; ++k) dst[m][k] = *(const PG8_LAS bf16x8*)(lds + PG8_SA(b, h) + aoff + m * 2048 + k * 1024); } while (0)
#define PG8_LDB(dst, b, h) do { _Pragma("unroll") for (int n = 0; n < 2; ++n) _Pragma("unroll") for (int k = 0; k < 2; ++k) dst[n][k] = *(const PG8_LAS bf16x8*)(lds + PG8_SB(b, h) + boff + n * 2048 + k * 1024); } while (0)
#define PG8_MMA(ai, bj, At, Bt) do { __builtin_amdgcn_s_setprio(1); _Pragma("unroll") for (int m = 0; m < 4; ++m) _Pragma("unroll") for (int n = 0; n < 2; ++n) _Pragma("unroll") for (int k = 0; k < 2; ++k) \
        acc[ai][bj][m][n] = __builtin_amdgcn_mfma_f32_16x16x32_bf16(Bt[n][k], At[m][k], acc[ai][bj][m][n], 0, 0, 0); __builtin_amdgcn_s_setprio(0); } while (0)
#define PG8_WAIT_V(n) asm volatile("s_waitcnt vmcnt(" #n ")" ::: "memory")
#define PG8_WAIT_L(n) asm volatile("s_waitcnt lgkmcnt(" #n ")" ::: "memory")
#define PG8_BAR __builtin_amdgcn_s_barrier()
#define PG8_SCHED __builtin_amdgcn_sched_barrier(0)
    Unit cur, nxt; int ui = 0;
    if (!S.next(0, cur)) return;
    f32x4 acc[2][2][4][2];
#pragma unroll
    for (int a = 0; a < 2; ++a)
#pragma unroll
        for (int b = 0; b < 2; ++b)
#pragma unroll
            for (int m = 0; m < 4; ++m)
#pragma unroll
                for (int n = 0; n < 2; ++n) acc[a][b][m][n] = (f32x4){0.f, 0.f, 0.f, 0.f};
    bf16x8 At[4][2], B0[2][2], B1[2][2];
    const char* cA = (const char*)g.A + (size_t)cur.pm * tstep; const char* cB = (const char*)g.Bt + (size_t)cur.pn * tstep;
    S.a_ready(cur);
    if constexpr (SP2) {
        PG8_STAGE(PG8_SB(0, 0), cB, voffB); PG8_STAGE(PG8_SB(0, 1), cB + hstep, voffB); PG8_STAGE(PG8_SA(0, 0), cA, voffA); PG8_STAGE(PG8_SA(0, 1), cA + hstep, voffA);
        if (wr == 1) PG8_BAR;
        PG8_WAIT_V(2); PG8_BAR;
        PG8_STAGE(PG8_SB(1, 0), cB + kstep, voffB); PG8_STAGE(PG8_SA(1, 0), cA + kstep, voffA); PG8_STAGE(PG8_SB(1, 1), cB + hstep + kstep, voffB);
        PG8_WAIT_V(6); PG8_BAR;
    } else {
        PG8_STAGE(PG8_SB(0, 0), cB, voffB); PG8_STAGE(PG8_SA(0, 0), cA, voffA); PG8_STAGE(PG8_SB(0, 1), cB + hstep, voffB); PG8_STAGE(PG8_SA(0, 1), cA + hstep, voffA);
        if (wr == 1) PG8_BAR;
        PG8_WAIT_V(4); PG8_BAR;
        PG8_STAGE(PG8_SB(1, 0), cB + kstep, voffB); PG8_STAGE(PG8_SA(1, 0), cA + kstep, voffA); PG8_STAGE(PG8_SB(1, 1), cB + hstep + kstep, voffB);
        PG8_WAIT_V(6); PG8_BAR;
    }
    for (;;) {
        const bool has_next = S.next(ui + 1, nxt);
        const char* nA = has_next ? (const char*)g.A + (size_t)nxt.pm * tstep : cA; const char* nB = has_next ? (const char*)g.Bt + (size_t)nxt.pn * tstep : cB;
        for (int t = 0; t < nt; t += 2) {
            const bool last = (t == nt - 2);
            const char* a1 = cA + (size_t)(t + 1) * kstep;
            const char* a2 = last ? nA : cA + (size_t)(t + 2) * kstep; const char* b2 = last ? nB : cB + (size_t)(t + 2) * kstep;
            const char* a3 = a2 + kstep; const char* b3 = b2 + kstep;
            if (last && has_next) S.a_ready(nxt);
            if constexpr (SP2) {
            PG8_LDB(B0, 0, 0); PG8_LDB(B1, 0, 1); PG8_SCHED; PG8_LDA(At, 0, 0); PG8_STAGE(PG8_SA(1, 1), a1 + hstep, voffA);
            PG8_WAIT_V(8); PG8_WAIT_L(0); PG8_BAR; PG8_MMA(0, 0, At, B0); PG8_MMA(0, 1, At, B1); PG8_BAR; PG8_SCHED;
            PG8_LDA(At, 0, 1); PG8_STAGE(PG8_SB(0, 0), b2, voffB); PG8_STAGE(PG8_SB(0, 1), b2 + hstep, voffB); PG8_STAGE(PG8_SA(0, 0), a2, voffA);
            PG8_WAIT_V(8); PG8_WAIT_L(0); PG8_BAR; PG8_MMA(1, 0, At, B0); PG8_MMA(1, 1, At, B1); PG8_BAR; PG8_SCHED;
            PG8_LDB(B0, 1, 0); PG8_LDB(B1, 1, 1); PG8_SCHED; PG8_LDA(At, 1, 0); PG8_STAGE(PG8_SA(0, 1), a2 + hstep, voffA);
            PG8_WAIT_V(8); PG8_WAIT_L(0); PG8_BAR; PG8_MMA(0, 0, At, B0); PG8_MMA(0, 1, At, B1); PG8_BAR; PG8_SCHED;
            PG8_LDA(At, 1, 1); PG8_STAGE(PG8_SB(1, 0), b3, voffB); PG8_STAGE(PG8_SB(1, 1), b3 + hstep, voffB); PG8_STAGE(PG8_SA(1, 0), a3, voffA);
            PG8_WAIT_V(8); PG8_WAIT_L(0); PG8_BAR; PG8_MMA(1, 0, At, B0); PG8_MMA(1, 1, At, B1); PG8_BAR; PG8_SCHED;
            } else {
            PG8_LDB(B0, 0, 0); PG8_SCHED; PG8_LDA(At, 0, 0); PG8_STAGE(PG8_SA(1, 1), a1 + hstep, voffA);
            PG8_WAIT_L(8); PG8_BAR; PG8_WAIT_L(0); PG8_MMA(0, 0, At, B0); PG8_BAR; PG8_SCHED;
            PG8_LDB(B1, 0, 1); PG8_STAGE(PG8_SB(0, 0), b2, voffB);
            PG8_BAR; PG8_WAIT_L(0); PG8_MMA(0, 1, At, B1); PG8_BAR;
            PG8_LDA(At, 0, 1); PG8_STAGE(PG8_SA(0, 0), a2, voffA);
            PG8_BAR; PG8_WAIT_L(0); PG8_MMA(1, 0, At, B0); PG8_BAR; PG8_SCHED;
            PG8_STAGE(PG8_SB(0, 1), b2 + hstep, voffB);
            PG8_WAIT_V(6); PG8_BAR; PG8_MMA(1, 1, At, B1); PG8_BAR;
            PG8_LDB(B0, 1, 0); PG8_SCHED; PG8_LDA(At, 1, 0); PG8_STAGE(PG8_SA(0, 1), a2 + hstep, voffA);
            PG8_WAIT_L(8); PG8_BAR; PG8_WAIT_L(0); PG8_MMA(0, 0, At, B0); PG8_BAR; PG8_SCHED;
            PG8_LDB(B1, 1, 1); PG8_STAGE(PG8_SB(1, 0), b3, voffB);
            PG8_BAR; PG8_WAIT_L(0); PG8_MMA(0, 1, At, B1); PG8_BAR;
            PG8_LDA(At, 1, 1); PG8_STAGE(PG8_SA(1, 0), a3, voffA);
            PG8_BAR; PG8_WAIT_L(0); PG8_MMA(1, 0, At, B0); PG8_BAR; PG8_SCHED;
            PG8_STAGE(PG8_SB(1, 1), b3 + hstep, voffB);
            PG8_WAIT_V(6); PG8_BAR; PG8_MMA(1, 1, At, B1); PG8_BAR;
            }
        }
        if constexpr (ALIGN_EPI) { if (wr == 0) PG8_BAR; }
        if constexpr (!Epi::AFTER_DRAIN) { E(acc, cur, wr, wc, fr, fq); S.done(cur); }
        if (!has_next) break;
#pragma unroll
        for (int a = 0; a < 2; ++a)
#pragma unroll
            for (int b = 0; b < 2; ++b)
#pragma unroll
                for (int m = 0; m < 4; ++m)
#pragma unroll
                    for (int n = 0; n < 2; ++n) acc[a][b][m][n] = (f32x4){0.f, 0.f, 0.f, 0.f};
        cur = nxt; cA = nA; cB = nB; ++ui;
        if constexpr (ALIGN_EPI) { if (wr == 1) PG8_BAR; }
    }
    PG8_WAIT_V(0);
    if constexpr (!ALIGN_EPI) { if (wr == 0) PG8_BAR; }
    PG8_BAR;
    if constexpr (Epi::AFTER_DRAIN) { E.fused(acc, cur, wr, wc, fr, fq, lds, wid, lane); S.done(cur); }
#undef PG8_SA
#undef PG8_SB
#undef PG8_STAGE
#undef PG8_LDA
#undef PG8_LDB
#undef PG8_MMA
#undef PG8_WAIT_V
#undef PG8_WAIT_L
#undef PG8_BAR
#undef PG8_SCHED
}
}
constexpr int T = 8192, D = 2048, FF = 5632, NL = 4, PLE = 256, NIN = 14968;
constexpr int NZ = 15104;
constexpr int ZR = 0, ZK = 1024, ZV = 2048, ZWD = 3072, ZAD = 3136, ZGD = 3200;
constexpr int ZDQ = 3360, ZCKV = 4384, ZQI = 4640, ZKI = 5664, ZWI = 5728;
constexpr int ZMQ = 5760, ZMK = 6272, ZMV = 6784, ZMO = 7808, ZMI = 8832, ZMF = 8836;
constexpr int ZG = 8864;
constexpr float EPS = 1e-6f;
constexpr int NWAVES = 8, NTHR = 512;

constexpr size_t MiB = 1u << 20;
constexpr size_t WS_CTL = 0, CTL_ZERO_BYTES = 1 * MiB;
constexpr size_t WS_WGU1 = 1 * MiB;
constexpr size_t WS_WD1 = WS_WGU1 + 44 * MiB;
constexpr size_t WS_WIN = WS_WD1 + 22 * MiB;
constexpr size_t WS_WBR = WS_WIN + 59 * MiB;
constexpr size_t WS_WOUT = WS_WBR + 12 * MiB;
constexpr size_t WS_WGU2 = WS_WOUT + 8 * MiB;
constexpr size_t WS_WD2 = WS_WGU2 + 44 * MiB;
constexpr size_t WS_WPG = WS_WD2 + 22 * MiB;
constexpr size_t WS_WPP = WS_WPG + 8 * MiB;
constexpr size_t WS_WLW = WS_WPP + 1 * MiB;
constexpr size_t WS_WLA = WS_WLW + 128 * 1024;
constexpr size_t WS_WLG = WS_WLA + 128 * 1024;
constexpr size_t WS_WUK = WS_WLG + 512 * 1024;
constexpr size_t WS_WUV = WS_WUK + 512 * 1024;
constexpr size_t WS_ACT0 = 224 * MiB;
static_assert(WS_WUV + 512 * 1024 <= WS_ACT0, "weights region");
constexpr size_t WS_HB = WS_ACT0;
constexpr size_t WS_ACT = WS_HB + 32 * MiB;
constexpr size_t WS_F = WS_ACT + 88 * MiB;
constexpr size_t WS_Z = WS_F + 64 * MiB;
constexpr size_t WS_RS = WS_Z + 236 * MiB;
constexpr size_t WS_FSS = WS_RS + 64 * 1024;
constexpr size_t WS_MISC = WS_FSS + 64 * 1024;
constexpr size_t WS_RW = WS_MISC + 896 * 1024;
constexpr size_t RW_STRIDE = 32 * MiB;
constexpr size_t WS_DSA = WS_RW + 9 * RW_STRIDE;
constexpr size_t WS_DC = WS_DSA;
constexpr size_t WS_DKI = WS_DC + 4 * MiB;
constexpr size_t WS_DWI = WS_DKI + 1 * MiB;
constexpr size_t WS_DIDX = WS_DWI + 1 * MiB;
constexpr size_t WS_DQL = WS_DIDX + 8 * MiB;
constexpr size_t WS_DOL = WS_DQL + 32 * MiB;
constexpr size_t WS_DSC = WS_DOL + 32 * MiB;
constexpr size_t WS_ML = WS_DSC + 256 * MiB;
constexpr size_t WS_MQK = WS_ML;
constexpr size_t WS_MKL = WS_MQK + 16 * MiB;
constexpr size_t WS_MCS = WS_MKL + 32 * MiB;
constexpr size_t WS_MSM = WS_MCS + 16 * MiB;
constexpr size_t WS_Y = WS_MSM + 2 * MiB;
constexpr size_t WS_MIXG = WS_Y + 48 * MiB;
constexpr size_t WS_E = WS_MIXG + 32 * MiB;
constexpr size_t WS_PB = WS_E + 32 * MiB;
constexpr size_t WS_END = WS_PB + 4 * MiB;
static_assert(WS_END <= (size_t)1800 * MiB, "workspace budget");
constexpr int CW_TMO = 0, CW_BAR = 4096;

constexpr int LDS_BYTES = 147456;
constexpr int LDSCTL_OFF = 146432, MISC_OFF = LDSCTL_OFF + 256;

#define GAS __attribute__((address_space(1)))
#define LAS __attribute__((address_space(3)))
#define DI __device__ __forceinline__
typedef unsigned short bf16;
typedef unsigned v4u __attribute__((ext_vector_type(4)));
typedef unsigned v2u __attribute__((ext_vector_type(2)));
typedef float f32x4 __attribute__((ext_vector_type(4)));
typedef float f32x2 __attribute__((ext_vector_type(2)));
typedef short bf16x8 __attribute__((ext_vector_type(8)));
typedef short bf16x4 __attribute__((ext_vector_type(4)));
typedef GAS unsigned gu32;
#define RLX_AGENT __ATOMIC_RELAXED, __HIP_MEMORY_SCOPE_AGENT
#define LDS_WAIT() asm volatile("s_waitcnt lgkmcnt(0)" ::: "memory")
#define VM_WAIT() asm volatile("s_waitcnt vmcnt(0)" ::: "memory")
DI unsigned f2bf(float f) { unsigned u = __builtin_bit_cast(unsigned, f); return (u + 0x7fffu + ((u >> 16) & 1u)) >> 16; }
DI unsigned pk2(float lo, float hi) { return f2bf(lo) | (f2bf(hi) << 16); }
DI float bf2f(unsigned short b) { return __uint_as_float(((unsigned)b) << 16); }
DI float bflo(unsigned w) { return __uint_as_float(w << 16); }
DI float bfhi(unsigned w) { return __uint_as_float(w & 0xffff0000u); }
DI float sigmoidf_(float x) { return 1.0f / (1.0f + __expf(-x)); }
DI float wave_sum(float v) {
#pragma unroll
    for (int o = 1; o < 64; o <<= 1) v += __shfl_xor(v, o);
    return v;
}
DI float wave_max(float v) {
#pragma unroll
    for (int o = 1; o < 64; o <<= 1) v = fmaxf(v, __shfl_xor(v, o));
    return v;
}
#define MFMA16(a, b, c) __builtin_amdgcn_mfma_f32_16x16x32_bf16((a), (b), (c), 0, 0, 0)
#define MFMA32(a, b, c) __builtin_amdgcn_mfma_f32_32x32x16_bf16((a), (b), (c), 0, 0, 0)
typedef float f32x16 __attribute__((ext_vector_type(16)));
DI bf16x4 tr_read(unsigned lds_addr) { bf16x4 r; asm volatile("ds_read_b64_tr_b16 %0, %1\n\ts_waitcnt lgkmcnt(0)" : "=&v"(r) : "v"(lds_addr) : "memory"); return r; }
DI bf16x8 cat8(bf16x4 lo, bf16x4 hi) { return __builtin_shufflevector(lo, hi, 0, 1, 2, 3, 4, 5, 6, 7); }
#define XB_TMO      128
#define XB_XCNT(j)  (256  + 64 * (j))
#define XB_XSUB(j)  (1280 + 64 * (j))
#define XB_XGEN(j)  (2304 + 64 * (j))
#define XB_TOP      3328
#define XB_TOPGEN   3392
#define XCD_BAR_WORDS 3456
#define XB_SPIN_CAP (1u << 18)

__device__ __forceinline__ unsigned xb_ld(unsigned* p)              { return __hip_atomic_load(p, __ATOMIC_RELAXED, __HIP_MEMORY_SCOPE_AGENT); }
__device__ __forceinline__ unsigned xb_add(unsigned* p, unsigned v) { return __hip_atomic_fetch_add(p, v, __ATOMIC_RELAXED, __HIP_MEMORY_SCOPE_AGENT); }
__device__ __forceinline__ unsigned xb_xcc_id() { return (unsigned)__builtin_amdgcn_s_getreg((3 << 11) | 20) & 0xFu; }
#define XB_SPIN(cond, bar) do { unsigned _sp = 0; while (cond) { __builtin_amdgcn_s_sleep(1); \
    if ((++_sp & 255u) == 0u) { if (xb_ld(&(bar)[XB_TMO])) break; if (_sp > XB_SPIN_CAP) { atomicAdd(&(bar)[XB_TMO], 1u); break; } } } } while (0)

struct XcdBarrier {
    unsigned* bar; unsigned x; bool t0;
    volatile LAS unsigned* st;
};

__device__ __forceinline__ XcdBarrier xcd_barrier_post(unsigned* bar, volatile LAS unsigned* st) {
    XcdBarrier b; b.bar = bar; b.x = xb_xcc_id(); b.st = st;
    if (threadIdx.x == 0) (void)xb_add(&bar[XB_XCNT(b.x)], 1u);
    return b;
}
__device__ __forceinline__ void xcd_barrier_complete(unsigned* bar, unsigned x, unsigned& nloc, unsigned& nx) {
    const unsigned G = gridDim.x * gridDim.y * gridDim.z;
    unsigned sum, cnt, mine, sp = 0u;
    for (;;) {
        sum = 0u; cnt = 0u; mine = 0u;
#pragma unroll
        for (unsigned j = 0; j < 16; ++j) { const unsigned c = xb_ld(&bar[XB_XCNT(j)]); sum += c; cnt += (c > 0u) ? 1u : 0u; mine = (j == x) ? c : mine; }
        if (sum == G) break;
        __builtin_amdgcn_s_sleep(1);
        if ((++sp & 255u) == 0u) { if (xb_ld(&bar[XB_TMO])) break; if (sp > XB_SPIN_CAP) { atomicAdd(&bar[XB_TMO], 1u); break; } }
    }
    nloc = mine > 0u ? mine : 1u; nx = cnt > 0u ? cnt : 1u;
}

__device__ __forceinline__ void xcd_barrier(const XcdBarrier& b) {
    asm volatile("s_waitcnt vmcnt(0)" ::: "memory");
    __syncthreads();
    if (b.t0) {
        unsigned* bar = b.bar;
        __builtin_amdgcn_s_waitcnt(0);
        unsigned nloc = b.st[0], nx = b.st[1];
        if (nloc == 0u) { xcd_barrier_complete(bar, b.x, nloc, nx); b.st[0] = nloc; b.st[1] = nx; }
        const unsigned old = xb_add(&bar[XB_XSUB(b.x)], 1u);
        const unsigned gen = old / nloc;
        if (old + 1u == (gen + 1u) * nloc) {
            __builtin_amdgcn_fence(__ATOMIC_RELEASE, "agent");
            asm volatile("s_waitcnt vmcnt(0)" ::: "memory");
            const unsigned og = xb_add(&bar[XB_TOP], 1u);
            const unsigned tg = og / nx;
            if (og + 1u == (tg + 1u) * nx) xb_add(&bar[XB_TOPGEN], 1u);
            else XB_SPIN(xb_ld(&bar[XB_TOPGEN]) == tg, bar);
            __builtin_amdgcn_fence(__ATOMIC_ACQUIRE, "agent");
            xb_add(&bar[XB_XGEN(b.x)], 1u);
            asm volatile("s_waitcnt vmcnt(0)" ::: "memory");
        } else {
            XB_SPIN(xb_ld(&bar[XB_XGEN(b.x)]) == gen, bar);
            __builtin_amdgcn_fence(__ATOMIC_ACQUIRE, "agent");
            asm volatile("s_waitcnt vmcnt(0)" ::: "memory");
        }
    }
    __syncthreads();
}
struct Ctx { LAS unsigned char* lds; unsigned char* ws; int tid, lane, wave, gw, NGW, G, bid; };
struct Args { const float* in[34]; float* out; unsigned char* ws; int ph_lo, ph_hi; };
struct InTab { const Args* a; DI const float* operator[](int i) const { asm volatile("" : "+s"(i)); return (const float*)(const GAS float*)a->in[i]; } };
DI unsigned char* opaque_ws(const Args& args) { const unsigned long long w0_ = (unsigned long long)args.ws; unsigned wl_ = __builtin_amdgcn_readfirstlane((unsigned)w0_), wh_ = __builtin_amdgcn_readfirstlane((unsigned)(w0_ >> 32)); asm volatile("" : "+s"(wl_), "+s"(wh_)); return (unsigned char*)(GAS unsigned char*)(((unsigned long long)wh_ << 32) | wl_); }
DI int lane_id() { int l; asm volatile("v_mbcnt_lo_u32_b32 %0, -1, 0\n\tv_mbcnt_hi_u32_b32 %0, -1, %0" : "=v"(l)); return l; }
DI Ctx make_ctx(const Args& args, LAS unsigned char* lds, int wave_s) {
    Ctx F; int tid = wave_s * 64 + lane_id(); asm volatile("" : "+v"(tid));
    const unsigned long long w0_ = (unsigned long long)args.ws; unsigned wl_ = __builtin_amdgcn_readfirstlane((unsigned)w0_), wh_ = __builtin_amdgcn_readfirstlane((unsigned)(w0_ >> 32)); asm volatile("" : "+s"(wl_), "+s"(wh_)); const unsigned long long w = ((unsigned long long)wh_ << 32) | wl_;
    int bid = __builtin_amdgcn_readfirstlane((int)blockIdx.x), G = __builtin_amdgcn_readfirstlane((int)gridDim.x); asm volatile("" : "+s"(bid), "+s"(G));
    F.lds = lds; F.ws = (unsigned char*)(GAS unsigned char*)w; F.tid = tid; F.lane = tid & 63; F.wave = __builtin_amdgcn_readfirstlane(tid >> 6);
    F.G = G; F.bid = bid; F.gw = bid * NWAVES + F.wave; F.NGW = G * NWAVES; return F;
}

DI void tr_item(const float* W, int ldn, int K, const float* gain, float scale, bf16* WT, int drow, int nvalid, int k0, LAS float* scr, int lane) {
#pragma unroll 8
    for (int i = 0; i < 32; ++i) { const int kk = 2 * i + (lane >> 5), c = lane & 31; float v = 0.f;
        if (c < nvalid) { v = W[(size_t)(k0 + kk) * ldn + c]; if (gain) v *= gain[k0 + kk]; v *= scale; }
        scr[kk * 33 + c] = v; }
    LDS_WAIT(); asm volatile("" ::: "memory");
    const int c8 = lane & 7;
#pragma unroll
    for (int j = 0; j < 4; ++j) { const int n = (lane >> 3) + 8 * j; const LAS float* s = scr + (8 * c8) * 33 + n;
        v4u o; o.x = pk2(s[0 * 33], s[1 * 33]); o.y = pk2(s[2 * 33], s[3 * 33]); o.z = pk2(s[4 * 33], s[5 * 33]); o.w = pk2(s[6 * 33], s[7 * 33]);
        *(v4u*)(WT + (size_t)(drow + n) * K + k0 + 8 * c8) = o; }
    LDS_WAIT(); asm volatile("" ::: "memory");
}
DI void conv_seg(const Ctx& F, const float* W, int ldn, int K, int ncols, int nsrc, const float* gain, float scale, bf16* WT, int dst0, int kind, int& base, LAS float* scr) {
    const int nblk = (ncols + 31) / 32, nitems = (K / 64) * nblk;
    const int start = (F.gw - base % F.NGW + F.NGW) % F.NGW;
    for (int it = start; it < nitems; it += F.NGW) {
        const int kb = it / nblk, nb = it - kb * nblk, n0 = nb * 32; int nvalid = nsrc - n0; nvalid = nvalid < 0 ? 0 : (nvalid > 32 ? 32 : nvalid);
        const int drow = kind ? (256 * (n0 >> 7) + dst0 + (n0 & 127)) : (dst0 + n0);
        tr_item(W + n0, ldn, K, gain, scale, WT, drow, nvalid, kb * 64, scr, F.lane);
    }
    base += nitems;
}
DI void phase_conv(const Ctx& F, const InTab in, int l) {
    LAS float* scr = (LAS float*)(F.lds + F.wave * 16384);
    unsigned char* ws = F.ws; int base = 0;
    const float* ng = in[2] + (size_t)l * 8 * D;
    conv_seg(F, in[3] + (size_t)l * D * FF, FF, D, FF, FF, ng + 0 * D, 1.f, (bf16*)(ws + WS_WGU1), 0, 1, base, scr);
    conv_seg(F, in[4] + (size_t)l * D * FF, FF, D, FF, FF, ng + 0 * D, 1.f, (bf16*)(ws + WS_WGU1), 128, 1, base, scr);
    conv_seg(F, in[5] + (size_t)l * FF * D, D, FF, D, D, nullptr, 1.f, (bf16*)(ws + WS_WD1), 0, 0, base, scr);
    { const float* W = in[6] + (size_t)l * D * NIN; bf16* WT = (bf16*)(ws + WS_WIN); const float* g2 = ng + 2 * D;
      conv_seg(F, W + 0, NIN, D, 3360, 3360, g2, 1.f, WT, 0, 0, base, scr);
      conv_seg(F, W + 3360, NIN, D, 2400, 2384, g2, 1.f, WT, ZDQ, 0, base, scr);
      conv_seg(F, W + 5744, NIN, D, 3104, 3080, g2, 1.f, WT, ZMQ, 0, base, scr);
      conv_seg(F, W + 8824, NIN, D, 6144, 6144, g2, 1.f, WT, ZG, 0, base, scr);
      conv_seg(F, W, NIN, D, 96, 0, g2, 1.f, WT, 15008, 0, base, scr); }
    for (int b = 0; b < 3; ++b) conv_seg(F, in[27] + ((size_t)l * 3 + b) * 1024 * D, D, 1024, D, D, nullptr, 1.f, (bf16*)(ws + WS_WBR) + (size_t)b * D * 1024, 0, 0, base, scr);
    conv_seg(F, in[28] + (size_t)l * D * D, D, D, D, D, nullptr, 1.f, (bf16*)(ws + WS_WOUT), 0, 0, base, scr);
    conv_seg(F, in[29] + (size_t)l * D * FF, FF, D, FF, FF, ng + 4 * D, 1.f, (bf16*)(ws + WS_WGU2), 0, 1, base, scr);
    conv_seg(F, in[30] + (size_t)l * D * FF, FF, D, FF, FF, ng + 4 * D, 1.f, (bf16*)(ws + WS_WGU2), 128, 1, base, scr);
    conv_seg(F, in[31] + (size_t)l * FF * D, D, FF, D, D, nullptr, 1.f, (bf16*)(ws + WS_WD2), 0, 0, base, scr);
    conv_seg(F, in[33] + (size_t)l * D * D, D, D, D, D, ng + 6 * D, 1.f, (bf16*)(ws + WS_WPG), 0, 0, base, scr);
    conv_seg(F, in[32] + (size_t)l * PLE * D, D, PLE, D, D, nullptr, 1.f, (bf16*)(ws + WS_WPP), 0, 0, base, scr);
    conv_seg(F, in[9] + (size_t)l * 64 * 1024, 1024, 64, 1024, 1024, nullptr, 1.f, (bf16*)(ws + WS_WLW), 0, 0, base, scr);
    conv_seg(F, in[11] + (size_t)l * 64 * 1024, 1024, 64, 1024, 1024, nullptr, 1.f, (bf16*)(ws + WS_WLA), 0, 0, base, scr);
    for (int h = 0; h < 8; ++h) conv_seg(F, in[20] + ((size_t)l * 8 + h) * 128 * 256, 256, 128, 256, 256, nullptr, 0.08838834764831845f, (bf16*)(ws + WS_WUK) + (size_t)h * 256 * 128, 0, 0, base, scr);
    for (int h = 0; h < 8; ++h) conv_seg(F, in[21] + ((size_t)l * 8 + h) * 256 * 128, 128, 256, 128, 128, nullptr, 1.f, (bf16*)(ws + WS_WUV) + (size_t)h * 128 * 256, 0, 0, base, scr);
    { const float* W = in[12] + (size_t)l * 160 * 1024; bf16* WT = (bf16*)(ws + WS_WLG);
      for (int i = F.bid * NTHR + F.tid; i < 1024 * 160; i += F.G * NTHR) { const int n = i / 160, k = i - n * 160; WT[i] = (bf16)f2bf(W[(size_t)k * 1024 + n]); } }
    { const f32x4* P = (const f32x4*)(in[1] + (size_t)l * T * PLE); v2u* PB = (v2u*)(ws + WS_PB);
      for (int i = F.bid * NTHR + F.tid; i < T * PLE / 4; i += F.G * NTHR) { const f32x4 v = P[i]; v2u o; o.x = pk2(v[0], v[1]); o.y = pk2(v[2], v[3]); PB[i] = o; } }
}

template <bool INIT>
DI void phase_resid(const Ctx& F, const float* src, const float* gain, float alpha, float* h) {
    bf16* hb = (bf16*)(F.ws + WS_HB); float* rs = (float*)(F.ws + WS_RS);
    f32x4 g[8];
    if (!INIT) {
#pragma unroll
        for (int j = 0; j < 8; ++j) g[j] = *(const f32x4*)(gain + 4 * F.lane + 256 * j);
    }
    for (int m = F.gw; m < T; m += F.NGW) {
        const f32x4* sr = (const f32x4*)(src + (size_t)m * D) + F.lane; f32x4* hr = (f32x4*)(h + (size_t)m * D) + F.lane;
        v2u* ob = (v2u*)(hb + (size_t)m * D) + F.lane;
        f32x4 v[8]; float fs = 0.f;
#pragma unroll
        for (int j = 0; j < 8; ++j) { v[j] = sr[64 * j]; fs += (v[j][0] * v[j][0] + v[j][1] * v[j][1]) + (v[j][2] * v[j][2] + v[j][3] * v[j][3]); }
        float rinv = 0.f; if (!INIT) rinv = alpha * __builtin_amdgcn_rsqf(wave_sum(fs) * (1.0f / D) + EPS);
        float s2 = 0.f;
#pragma unroll
        for (int j = 0; j < 8; ++j) {
            f32x4 x = v[j];
            if (!INIT) x = hr[64 * j] + x * rinv * g[j];
            hr[64 * j] = x; v2u o; o.x = pk2(x[0], x[1]); o.y = pk2(x[2], x[3]); ob[64 * j] = o;
            s2 += (x[0] * x[0] + x[1] * x[1]) + (x[2] * x[2] + x[3] * x[3]);
        }
        s2 = wave_sum(s2);
        if (F.lane == 0) rs[m] = s2;
    }
}

DI void wave_gemm32_bf16(const bf16* A, int lda, const bf16* Bt, int ldb, int K, bf16* O, int ldo, int lane) {
    const int r = lane & 15, q = lane >> 4;
    f32x4 acc[2][2];
#pragma unroll
    for (int i = 0; i < 2; ++i)
#pragma unroll
        for (int j = 0; j < 2; ++j) acc[i][j] = (f32x4){0.f, 0.f, 0.f, 0.f};
    for (int k0 = 0; k0 < K; k0 += 32) {
        bf16x8 a[2], b[2];
#pragma unroll
        for (int i = 0; i < 2; ++i) { a[i] = *(const bf16x8*)(A + (size_t)(16 * i + r) * lda + k0 + 8 * q); b[i] = *(const bf16x8*)(Bt + (size_t)(16 * i + r) * ldb + k0 + 8 * q); }
#pragma unroll
        for (int i = 0; i < 2; ++i)
#pragma unroll
            for (int j = 0; j < 2; ++j) acc[i][j] = MFMA16(b[j], a[i], acc[i][j]);
    }
#pragma unroll
    for (int i = 0; i < 2; ++i)
#pragma unroll
        for (int j = 0; j < 2; ++j) { v2u w; w.x = pk2(acc[i][j][0], acc[i][j][1]); w.y = pk2(acc[i][j][2], acc[i][j][3]); *(v2u*)(O + (size_t)(16 * i + r) * ldo + 16 * j + 4 * q) = w; }
}
DI float* rwbuf(const Ctx& F, int i) { return (float*)(F.ws + WS_RW + (size_t)i * RW_STRIDE); }
enum { RW_R = 0, RW_W = 1, RW_K = 2, RW_V = 3, RW_AA = 4, RW_BB = 5, RW_G = 6, RW_Y = 7 };
DI f32x4 shift4(const bf16* Z, int t, int col, const float* mu) {
    const v2u c = *(const v2u*)(Z + (size_t)t * NZ + col); v2u p = (v2u){0u, 0u}; if (t > 0) p = *(const v2u*)(Z + (size_t)(t - 1) * NZ + col);
    const f32x4 m = *(const f32x4*)(mu + col);
    f32x4 cv = (f32x4){bflo(c.x), bfhi(c.x), bflo(c.y), bfhi(c.y)}, pv = (f32x4){bflo(p.x), bfhi(p.x), bflo(p.y), bfhi(p.y)};
    return cv + (pv - cv) * m;
}
DI void phase_rw_prep(const Ctx& F, const InTab in, int l) {
    const bf16* Z = (const bf16*)(F.ws + WS_Z);
    const float* mu = in[7] + (size_t)l * 3360; const float* w0 = in[8] + (size_t)l * 1024; const float* a0 = in[10] + (size_t)l * 1024;
    const float* k_k = in[13] + (size_t)l * 1024; const float* k_a = in[14] + (size_t)l * 1024;
    const bf16* WLW = (const bf16*)(F.ws + WS_WLW); const bf16* WLA = (const bf16*)(F.ws + WS_WLA); const bf16* WLG = (const bf16*)(F.ws + WS_WLG);
    float* R = rwbuf(F, RW_R); float* W = rwbuf(F, RW_W); float* K2 = rwbuf(F, RW_K); float* V = rwbuf(F, RW_V); float* AA = rwbuf(F, RW_AA); float* BB = rwbuf(F, RW_BB); float* G = rwbuf(F, RW_G);
    LAS bf16* As = (LAS bf16*)F.lds;
    const int r = F.lane & 15, q = F.lane >> 4;
    for (int tile = F.bid; tile < T / 16; tile += F.G) {
        const int t0 = tile * 16;
        for (int i = F.tid; i < 16 * 288; i += NTHR) { const int row = i / 288, c = i - row * 288, t = t0 + row, zc = ZWD + c;
            const float cur = bf2f(Z[(size_t)t * NZ + zc]); const float prev = t > 0 ? bf2f(Z[(size_t)(t - 1) * NZ + zc]) : 0.f;
            const float zs = cur + (prev - cur) * mu[zc];
            const float val = c < 64 ? tanhf(zs) : (c < 128 ? zs : sigmoidf_(zs));
            As[row * 296 + c] = (bf16)f2bf(val); }
        __syncthreads();
        bf16x8 aw[2], aa[2], ag[5];
#pragma unroll
        for (int s = 0; s < 2; ++s) { aw[s] = *(const LAS bf16x8*)(As + r * 296 + 32 * s + 8 * q); aa[s] = *(const LAS bf16x8*)(As + r * 296 + 64 + 32 * s + 8 * q); }
#pragma unroll
        for (int s = 0; s < 5; ++s) ag[s] = *(const LAS bf16x8*)(As + r * 296 + 128 + 32 * s + 8 * q);
        const int t = t0 + r;
#pragma unroll 1
        for (int hh = 0; hh < 2; ++hh) {
            f32x4 kraw[4], av[4]; float ssq = 0.f;
#pragma unroll
            for (int ct = 0; ct < 4; ++ct) {
                const int n0 = F.wave * 128 + hh * 64 + ct * 16, n = n0 + 4 * q;
                f32x4 cw = (f32x4){0.f, 0.f, 0.f, 0.f}, ca = cw, cg = cw;
#pragma unroll
                for (int s = 0; s < 2; ++s) { cw = MFMA16(*(const bf16x8*)(WLW + (size_t)(n0 + r) * 64 + 32 * s + 8 * q), aw[s], cw); ca = MFMA16(*(const bf16x8*)(WLA + (size_t)(n0 + r) * 64 + 32 * s + 8 * q), aa[s], ca); }
#pragma unroll
                for (int s = 0; s < 5; ++s) cg = MFMA16(*(const bf16x8*)(WLG + (size_t)(n0 + r) * 160 + 32 * s + 8 * q), ag[s], cg);
                const f32x4 w0v = *(const f32x4*)(w0 + n), a0v = *(const f32x4*)(a0 + n), kkv = *(const f32x4*)(k_k + n), kav = *(const f32x4*)(k_a + n);
                const f32x4 rs_ = shift4(Z, t, ZR + n, mu), ks_ = shift4(Z, t, ZK + n, mu), vs_ = shift4(Z, t, ZV + n, mu);
                f32x4 dec, a, k2;
#pragma unroll
                for (int j = 0; j < 4; ++j) { const float wl = w0v[j] + cw[j]; const float ls = fminf(wl, 0.f) - log1pf(__expf(-fabsf(wl)));
                    dec[j] = __expf(-__expf(ls - 0.5f)); a[j] = sigmoidf_(a0v[j] + ca[j]); k2[j] = ks_[j] * (1.0f + (a[j] - 1.0f) * kav[j]); }
                kraw[ct] = ks_ * kkv; av[ct] = a; ssq += (kraw[ct][0] * kraw[ct][0] + kraw[ct][1] * kraw[ct][1]) + (kraw[ct][2] * kraw[ct][2] + kraw[ct][3] * kraw[ct][3]);
                const size_t o = (size_t)t * 1024 + n;
                *(f32x4*)(R + o) = rs_; *(f32x4*)(W + o) = dec; *(f32x4*)(K2 + o) = k2; *(f32x4*)(V + o) = vs_; *(f32x4*)(G + o) = cg;
            }
            ssq += __shfl_xor(ssq, 16); ssq += __shfl_xor(ssq, 32);
            const float inv = 1.0f / fmaxf(sqrtf(ssq), 1e-12f);
#pragma unroll
            for (int ct = 0; ct < 4; ++ct) { const size_t o = (size_t)t * 1024 + F.wave * 128 + hh * 64 + ct * 16 + 4 * q; const f32x4 kk = kraw[ct] * inv;
                *(f32x4*)(AA + o) = -kk; *(f32x4*)(BB + o) = kk * av[ct]; }
        }
        __syncthreads();
    }
}
DI void lds_read8(unsigned addr, f32x4 (&d)[8]) {
    asm volatile("ds_read_b128 %0, %8\n\tds_read_b128 %1, %8 offset:16\n\tds_read_b128 %2, %8 offset:32\n\tds_read_b128 %3, %8 offset:48\n\t"
                 "ds_read_b128 %4, %8 offset:64\n\tds_read_b128 %5, %8 offset:80\n\tds_read_b128 %6, %8 offset:96\n\tds_read_b128 %7, %8 offset:112\n\ts_waitcnt lgkmcnt(0)"
                 : "=&v"(d[0]), "=&v"(d[1]), "=&v"(d[2]), "=&v"(d[3]), "=&v"(d[4]), "=&v"(d[5]), "=&v"(d[6]), "=&v"(d[7]) : "v"(addr) : "memory");
}
DI void lds_read4x1(unsigned addr, f32x4& w, f32x4& b, f32x4& k, f32x4& r) {
    asm volatile("ds_read_b128 %0, %4\n\tds_read_b128 %1, %4 offset:256\n\tds_read_b128 %2, %4 offset:512\n\tds_read_b128 %3, %4 offset:768\n\ts_waitcnt lgkmcnt(0)"
                 : "=&v"(w), "=&v"(b), "=&v"(k), "=&v"(r) : "v"(addr) : "memory");
}
DI void phase_rw_local(const Ctx& F) {
    const float* AA = rwbuf(F, RW_AA); const float* W = rwbuf(F, RW_W); const float* BB = rwbuf(F, RW_BB); const float* K2 = rwbuf(F, RW_K); const float* R = rwbuf(F, RW_R); const float* V = rwbuf(F, RW_V);
    float* YL = rwbuf(F, RW_Y); float* QT = rwbuf(F, 8);
    bf16* MTb = (bf16*)(F.ws + WS_ACT); float* GTt = (float*)(F.ws + WS_ACT + 32 * MiB);
    LAS unsigned char* buf = F.lds + F.wave * 12288;
    const unsigned bufa = (unsigned)(size_t)buf;
    const int lane = F.lane;
    for (int unit = F.gw; unit < 2048; unit += F.NGW) {
        const int c = unit >> 4, h = unit & 15; const unsigned ob0 = (unsigned)(((c * 64) * 1024 + h * 64 + lane) * 4);
        float Sr[64], Si[64];
#pragma unroll
        for (int k = 0; k < 64; ++k) { Sr[k] = 0.f; Si[k] = (k == lane) ? 1.f : 0.f; }
#define RW_DMA(sub_, pb_) do { _Pragma("unroll") for (int s_ = 0; s_ < 4; ++s_) { const unsigned o_ = ob0 + (unsigned)((4 * (sub_) + s_) * 4096); LAS unsigned* lp_ = (LAS unsigned*)(buf + (pb_) * 6144 + s_ * 1536); \
            __builtin_amdgcn_global_load_lds((const unsigned*)((const char*)AA + o_), lp_, 4, 0, 0); __builtin_amdgcn_global_load_lds((const unsigned*)((const char*)W + o_), lp_ + 64, 4, 0, 0); __builtin_amdgcn_global_load_lds((const unsigned*)((const char*)BB + o_), lp_ + 128, 4, 0, 0); \
            __builtin_amdgcn_global_load_lds((const unsigned*)((const char*)K2 + o_), lp_ + 192, 4, 0, 0); __builtin_amdgcn_global_load_lds((const unsigned*)((const char*)R + o_), lp_ + 256, 4, 0, 0); __builtin_amdgcn_global_load_lds((const unsigned*)((const char*)V + o_), lp_ + 320, 4, 0, 0); } } while (0)
        RW_DMA(0, 0);
#pragma unroll 1
        for (int sub = 0; sub < 16; ++sub) {
            const int pb = sub & 1;
            asm volatile("s_waitcnt vmcnt(0)" ::: "memory");
            if (sub < 15) RW_DMA(sub + 1, pb ^ 1);
#pragma unroll 1
            for (int s = 0; s < 4; ++s) {
                const unsigned sa_ = bufa + (unsigned)(pb * 6144 + s * 1536);
                const float v = *(const LAS float*)(buf + pb * 6144 + s * 1536 + 1280 + 4 * lane);
                float sar0 = 0.f, sar1 = 0.f, sai0 = 0.f, sai1 = 0.f;
#pragma unroll
                for (int qd = 0; qd < 4; ++qd) { f32x4 d[4];
                    asm volatile("ds_read_b128 %0, %4\n\tds_read_b128 %1, %4 offset:16\n\tds_read_b128 %2, %4 offset:32\n\tds_read_b128 %3, %4 offset:48\n\ts_waitcnt lgkmcnt(0)"
                                 : "=&v"(d[0]), "=&v"(d[1]), "=&v"(d[2]), "=&v"(d[3]) : "v"(sa_ + (unsigned)(qd * 64)) : "memory");
#pragma unroll
                    for (int k4 = 0; k4 < 4; ++k4) { const int k = 16 * qd + 4 * k4; sar0 = fmaf(Sr[k], d[k4][0], sar0); sar1 = fmaf(Sr[k + 1], d[k4][1], sar1); sar0 = fmaf(Sr[k + 2], d[k4][2], sar0); sar1 = fmaf(Sr[k + 3], d[k4][3], sar1);
                        sai0 = fmaf(Si[k], d[k4][0], sai0); sai1 = fmaf(Si[k + 1], d[k4][1], sai1); sai0 = fmaf(Si[k + 2], d[k4][2], sai0); sai1 = fmaf(Si[k + 3], d[k4][3], sai1); } }
                const float sar = sar0 + sar1, sai = sai0 + sai1;
                float yr0 = 0.f, yi0 = 0.f;
#pragma unroll
                for (int g = 0; g < 16; ++g) {
                    f32x4 w4, b4, k4_, r4; lds_read4x1(sa_ + 256u + (unsigned)(g * 16), w4, b4, k4_, r4);
#pragma unroll
                    for (int j = 0; j < 4; ++j) { const int k = 4 * g + j;
                        float x = Sr[k] * w4[j]; x = fmaf(sar, b4[j], x); x = fmaf(v, k4_[j], x); Sr[k] = x;
                        float z = Si[k] * w4[j]; z = fmaf(sai, b4[j], z); Si[k] = z;
                        yr0 = fmaf(x, r4[j], yr0); yi0 = fmaf(z, r4[j], yi0); }
                }
                const unsigned o = ob0 + (unsigned)((4 * sub + s) * 4096);
                *(float*)((char*)YL + o) = yr0; *(float*)((char*)QT + o) = yi0;
            }
        }
#undef RW_DMA
        int lane2 = lane; asm volatile("" : "+v"(lane2));
        bf16* mp = MTb + (size_t)unit * 4096 + lane2; float* gp = GTt + (size_t)unit * 4096 + lane2;
#pragma unroll
        for (int k = 0; k < 64; ++k) { mp[k * 64] = (bf16)f2bf(Si[k]); gp[k * 64] = Sr[k]; }
        asm volatile("s_waitcnt vmcnt(0)" ::: "memory");
    }
}
DI void phase_rw_combine(const Ctx& F, int cw) {
    const bf16* MTb = (const bf16*)(F.ws + WS_ACT); const float* GTt = (const float*)(F.ws + WS_ACT + 32 * MiB); bf16* SCb = (bf16*)(F.ws + WS_F);
    const int h = cw >> 2, i0 = (cw & 3) * 16, lane = F.lane, r = lane & 15, q = lane >> 4;
    f32x4 X[4];
#pragma unroll
    for (int kt = 0; kt < 4; ++kt) X[kt] = (f32x4){0.f, 0.f, 0.f, 0.f};
#pragma unroll 1
    for (int c = 0; c < 128; ++c) {
        const int unit = c * 16 + h;
        bf16* sp = SCb + (size_t)unit * 4096 + (size_t)(i0 + r) * 64 + 4 * q;
        bf16x8 Bf[2];
        { v4u b0, b1;
          b0.x = pk2(X[0][0], X[0][1]); b0.y = pk2(X[0][2], X[0][3]); b0.z = pk2(X[1][0], X[1][1]); b0.w = pk2(X[1][2], X[1][3]);
          b1.x = pk2(X[2][0], X[2][1]); b1.y = pk2(X[2][2], X[2][3]); b1.z = pk2(X[3][0], X[3][1]); b1.w = pk2(X[3][2], X[3][3]);
          *(v2u*)(sp + 0) = (v2u){b0.x, b0.y}; *(v2u*)(sp + 16) = (v2u){b0.z, b0.w}; *(v2u*)(sp + 32) = (v2u){b1.x, b1.y}; *(v2u*)(sp + 48) = (v2u){b1.z, b1.w};
          Bf[0] = __builtin_bit_cast(bf16x8, b0); Bf[1] = __builtin_bit_cast(bf16x8, b1); }
        if (c == 127) break;
        const bf16* mrow = MTb + (size_t)unit * 4096 + 4 * q; const float* gcol = GTt + (size_t)unit * 4096 + i0 + r;
#pragma unroll
        for (int kt = 0; kt < 4; ++kt) {
            f32x4 acc;
#pragma unroll
            for (int e = 0; e < 4; ++e) acc[e] = gcol[(size_t)(16 * kt + 4 * q + e) * 64];
#pragma unroll
            for (int ks = 0; ks < 2; ++ks) { const bf16* ap = mrow + (size_t)(16 * kt + r) * 64 + 32 * ks; const v2u lo = *(const v2u*)ap, hi = *(const v2u*)(ap + 16);
                const v4u af = (v4u){lo.x, lo.y, hi.x, hi.y}; acc = MFMA16(__builtin_bit_cast(bf16x8, af), Bf[ks], acc); }
            X[kt] = acc;
        }
    }
}
DI void phase_rw_out(const Ctx& F, const InTab in, int l) {
    const float* YL = rwbuf(F, RW_Y); const float* QT = rwbuf(F, 8); const float* R = rwbuf(F, RW_R); const float* K2 = rwbuf(F, RW_K); const float* V = rwbuf(F, RW_V); const float* G = rwbuf(F, RW_G);
    const bf16* SCb = (const bf16*)(F.ws + WS_F);
    const float* r_k = in[15] + (size_t)l * 1024; const float* lg = in[16] + (size_t)l * 1024; const float* lb = in[17] + (size_t)l * 1024;
    bf16* YO = (bf16*)(F.ws + WS_Y);
    const int lane = F.lane, r = lane & 15, q = lane >> 4;
    for (int unit = F.gw; unit < 2048; unit += F.NGW) {
        const int c = unit >> 4, h = unit & 15, t0 = c * 64;
        bf16x8 Sf[4][2];
#pragma unroll
        for (int it = 0; it < 4; ++it)
#pragma unroll
            for (int ks = 0; ks < 2; ++ks) Sf[it][ks] = *(const bf16x8*)(SCb + (size_t)unit * 4096 + (size_t)(16 * it + r) * 64 + 32 * ks + 8 * q);
#pragma unroll 1
        for (int tt = 0; tt < 4; ++tt) {
            const int t = t0 + 16 * tt + r; const size_t ob = (size_t)t * 1024 + h * 64;
            bf16x8 Af[2];
#pragma unroll
            for (int ks = 0; ks < 2; ++ks) { const f32x4 x0 = *(const f32x4*)(QT + ob + 32 * ks + 8 * q), x1 = *(const f32x4*)(QT + ob + 32 * ks + 8 * q + 4);
                v4u o; o.x = pk2(x0[0], x0[1]); o.y = pk2(x0[2], x0[3]); o.z = pk2(x1[0], x1[1]); o.w = pk2(x1[2], x1[3]); Af[ks] = __builtin_bit_cast(bf16x8, o); }
            f32x4 y[4], rr[4], kk[4], vv[4]; float s = 0.f, bs = 0.f;
#pragma unroll
            for (int it = 0; it < 4; ++it) { const size_t o = ob + 16 * it + 4 * q;
                f32x4 acc = *(const f32x4*)(YL + o);
#pragma unroll
                for (int ks = 0; ks < 2; ++ks) acc = MFMA16(Sf[it][ks], Af[ks], acc);
                y[it] = acc; rr[it] = *(const f32x4*)(R + o); kk[it] = *(const f32x4*)(K2 + o); vv[it] = *(const f32x4*)(V + o);
                const f32x4 rk = *(const f32x4*)(r_k + h * 64 + 16 * it + 4 * q);
#pragma unroll
                for (int e = 0; e < 4; ++e) { s += acc[e]; bs += rr[it][e] * kk[it][e] * rk[e]; } }
            s += __shfl_xor(s, 16); s += __shfl_xor(s, 32); bs += __shfl_xor(bs, 16); bs += __shfl_xor(bs, 32);
            const float mean = s * (1.0f / 64.0f); float q2 = 0.f;
#pragma unroll
            for (int it = 0; it < 4; ++it)
#pragma unroll
                for (int e = 0; e < 4; ++e) { const float d = y[it][e] - mean; q2 += d * d; }
            q2 += __shfl_xor(q2, 16); q2 += __shfl_xor(q2, 32);
            const float rstd = __builtin_amdgcn_rsqf(q2 * (1.0f / 64.0f) + 64e-5f);
#pragma unroll
            for (int it = 0; it < 4; ++it) { const int ch = h * 64 + 16 * it + 4 * q; const f32x4 g4 = *(const f32x4*)(lg + ch), b4 = *(const f32x4*)(lb + ch), gg = *(const f32x4*)(G + (size_t)t * 1024 + ch); float ov[4];
#pragma unroll
                for (int e = 0; e < 4; ++e) ov[e] = (((y[it][e] - mean) * rstd) * g4[e] + b4[e] + bs * vv[it][e]) * gg[e];
                v2u w; w.x = pk2(ov[0], ov[1]); w.y = pk2(ov[2], ov[3]); *(v2u*)(YO + (size_t)t * 1024 + ch) = w; }
        }
    }
}
DI void phase_dsa_prep(const Ctx& F, const InTab in, int l) {
    const bf16* Z = (const bf16*)(F.ws + WS_Z); bf16* DC = (bf16*)(F.ws + WS_DC); bf16* DKI = (bf16*)(F.ws + WS_DKI); float* DWI = (float*)(F.ws + WS_DWI);
    const float* cg = in[18] + (size_t)l * 256; const float* kg = in[19] + (size_t)l * 64;
    const f32x4 cg4 = *(const f32x4*)(cg + 4 * F.lane); const float kg1 = kg[F.lane];
    for (int t = F.gw; t < T; t += F.NGW) {
        const v2u c = *(const v2u*)(Z + (size_t)t * NZ + ZCKV + 4 * F.lane);
        f32x4 cv = (f32x4){bflo(c.x), bfhi(c.x), bflo(c.y), bfhi(c.y)};
        const float ss = wave_sum((cv[0] * cv[0] + cv[1] * cv[1]) + (cv[2] * cv[2] + cv[3] * cv[3]));
        cv = cv * __builtin_amdgcn_rsqf(ss * (1.0f / 256.0f) + EPS) * cg4;
        v2u o; o.x = pk2(cv[0], cv[1]); o.y = pk2(cv[2], cv[3]); *(v2u*)(DC + (size_t)t * 256 + 4 * F.lane) = o;
        const float kv = bf2f(Z[(size_t)t * NZ + ZKI + F.lane]);
        const float ks = wave_sum(kv * kv);
        DKI[(size_t)t * 64 + F.lane] = (bf16)f2bf(kv * __builtin_amdgcn_rsqf(ks * (1.0f / 64.0f) + EPS) * kg1);
        if (F.lane < 16) DWI[(size_t)t * 16 + F.lane] = bf2f(Z[(size_t)t * NZ + ZWI + F.lane]) * (1.0f / 32.0f);
    }
    const bf16* WUK = (const bf16*)(F.ws + WS_WUK); bf16* DQL = (bf16*)(F.ws + WS_DQL);
    for (int it = F.gw; it < 256 * 8; it += F.NGW) { const int mt = it >> 3, h = it & 7;
#pragma unroll 1
        for (int nt = 0; nt < 8; ++nt)
            wave_gemm32_bf16(Z + (size_t)(mt * 32) * NZ + ZDQ + h * 128, NZ, WUK + (size_t)h * 256 * 128 + (size_t)(nt * 32) * 128, 128, 128, DQL + (size_t)(mt * 32) * 2048 + h * 256 + nt * 32, 2048, F.lane); }
}
DI void phase_dsa_index(const Ctx& F, int wi, int nw) {
    const bf16* Z = (const bf16*)(F.ws + WS_Z); const bf16* DKI = (const bf16*)(F.ws + WS_DKI); const float* DWI = (const float*)(F.ws + WS_DWI); float* DSC = (float*)(F.ws + WS_DSC);
    const int r = F.lane & 31, hh = F.lane >> 5;
    for (int task = wi; task < 4608; task += nw) {
        int c = 0, rem = task; while (rem >= 1024 - 128 * c) { rem -= 1024 - 128 * c; ++c; }
        const int g = 128 * c + rem, t0 = 8 * g, kstart = 1024 * c; int kend = kstart + 1024; if (kend > t0 + 8) kend = t0 + 8;
        const int nblk = (kend - kstart + 31) >> 5;
        bf16x8 A[4][4]; float wv[4][2][8];
#pragma unroll
        for (int rb = 0; rb < 4; ++rb) { const int tok = t0 + 2 * rb + (r >> 4), head = r & 15;
#pragma unroll
            for (int s = 0; s < 4; ++s) A[rb][s] = *(const bf16x8*)(Z + (size_t)tok * NZ + ZQI + head * 64 + 16 * s + 8 * hh);
#pragma unroll
            for (int tk = 0; tk < 2; ++tk)
#pragma unroll
                for (int i = 0; i < 8; ++i) wv[rb][tk][i] = DWI[(size_t)(t0 + 2 * rb + tk) * 16 + (i & 3) + 8 * (i >> 2) + 4 * hh]; }
#pragma unroll 1
        for (int kb = 0; kb < nblk; ++kb) {
            const int s0 = kstart + 32 * kb;
            bf16x8 B[4];
#pragma unroll
            for (int s = 0; s < 4; ++s) B[s] = *(const bf16x8*)(DKI + (size_t)(s0 + r) * 64 + 16 * s + 8 * hh);
#pragma unroll
            for (int rb = 0; rb < 4; ++rb) {
                f32x16 x;
#pragma unroll
                for (int i = 0; i < 16; ++i) x[i] = 0.f;
#pragma unroll
                for (int s = 0; s < 4; ++s) x = MFMA32(A[rb][s], B[s], x);
                float p0 = 0.f, p1 = 0.f;
#pragma unroll
                for (int i = 0; i < 8; ++i) { p0 = fmaf(wv[rb][0][i], fmaxf(x[i], 0.f), p0); p1 = fmaf(wv[rb][1][i], fmaxf(x[8 + i], 0.f), p1); }
                p0 += __shfl_xor(p0, 32); p1 += __shfl_xor(p1, 32);
                DSC[(size_t)(t0 + 2 * rb + hh) * T + s0 + r] = hh ? p1 : p0;
            }
        }
    }
}
DI unsigned fkey(float f) { const unsigned u = __float_as_uint(f); return (u & 0x80000000u) ? ~u : (u | 0x80000000u); }
DI void phase_dsa_topk(const Ctx& F) {
    const float* DSC = (const float*)(F.ws + WS_DSC); int* IDX = (int*)(F.ws + WS_DIDX);
    LAS unsigned* hist = (LAS unsigned*)(F.lds + F.wave * 1024);
    const int lane = F.lane;
    for (int t = F.gw; t < T; t += F.NGW) {
        const int n = t + 1; int* out = IDX + (size_t)t * 256; const float* row = DSC + (size_t)t * T;
        if (n <= 256) { for (int i = lane; i < 256; i += 64) out[i] = i < n ? i : -1; continue; }
        unsigned prefix = 0u, mask = 0u; int need = 256;
#pragma unroll 1
        for (int pass = 0; pass < 4; ++pass) {
            const int shift = 24 - 8 * pass;
#pragma unroll
            for (int j = 0; j < 4; ++j) hist[4 * lane + j] = 0u;
            LDS_WAIT(); asm volatile("" ::: "memory");
            for (int i = lane; i < n; i += 64) { const unsigned u = fkey(row[i]); if ((u & mask) == prefix) __hip_atomic_fetch_add(hist + ((u >> shift) & 255u), 1u, __ATOMIC_RELAXED, __HIP_MEMORY_SCOPE_WORKGROUP); }
            LDS_WAIT(); asm volatile("" ::: "memory");
            const unsigned c0 = hist[4 * lane], c1 = hist[4 * lane + 1], c2 = hist[4 * lane + 2], c3 = hist[4 * lane + 3];
            LDS_WAIT(); asm volatile("" ::: "memory");
            const int ct = (int)(c0 + c1 + c2 + c3); int incl = ct;
#pragma unroll
            for (int o = 1; o < 64; o <<= 1) { const int v = __shfl_down(incl, o); if (lane + o < 64) incl += v; }
            const int above = incl - ct;
            const bool target = (above < need) && (incl >= need);
            int bin_l = 0, cab_l = 0;
            if (target) { int cum = above;
                if (cum + (int)c3 >= need) { bin_l = 4 * lane + 3; cab_l = cum; }
                else { cum += (int)c3; if (cum + (int)c2 >= need) { bin_l = 4 * lane + 2; cab_l = cum; }
                else { cum += (int)c2; if (cum + (int)c1 >= need) { bin_l = 4 * lane + 1; cab_l = cum; }
                else { cum += (int)c1; bin_l = 4 * lane; cab_l = cum; } } } }
            const unsigned long long bal = __ballot(target); const int src = bal ? (__ffsll((long long)bal) - 1) : 0;
            const int bin = __shfl(bin_l, src), cab = __shfl(cab_l, src);
            need -= cab; prefix |= ((unsigned)bin) << shift; mask |= 255u << shift;
        }
        const int ngt = 256 - need; int cgt = 0, ceq = 0;
        for (int base = 0; base < n; base += 64) { const int i = base + lane; const unsigned u = i < n ? fkey(row[i]) : 0u;
            const bool gt = (i < n) && (u > prefix), eq = (i < n) && (u == prefix);
            const unsigned long long bg = __ballot(gt), be = __ballot(eq); const unsigned long long lt = (1ull << lane) - 1ull;
            if (gt) { const int pos = cgt + __popcll(bg & lt); if (pos < 256) out[pos] = i; }
            if (eq) { const int pe = ceq + __popcll(be & lt); if (pe < need) out[ngt + pe] = i; }
            cgt += __popcll(bg); ceq += __popcll(be); }
    }
}
constexpr int ATT_RS = 544;
DI void phase_dsa_attn(const Ctx& F, const InTab in) {
    const bf16* DC = (const bf16*)(F.ws + WS_DC); const bf16* DQL = (const bf16*)(F.ws + WS_DQL); const int* IDX = (const int*)(F.ws + WS_DIDX); bf16* DOL = (bf16*)(F.ws + WS_DOL);
    LAS int* tab = (LAS int*)(F.lds + 139264); LAS float* rbs = (LAS float*)(F.lds + 139264 + 512);
    if (F.tid < 128) { const int nn = F.tid; int b;
        if (nn < 16) b = nn; else { b = 16 + (int)(logf((float)nn / 16.0f) / 2.0794415416798357f * 16.0f); if (b > 31) b = 31; }
        tab[nn] = b; }
    if (F.tid < 256) rbs[F.tid] = in[22][F.tid];
    __syncthreads();
    LAS unsigned char* tile = F.lds + F.wave * (32 * ATT_RS);
    const unsigned tile_a = (unsigned)(size_t)tile;
    const int lane = F.lane, r = lane & 15, q = lane >> 4, head = r & 7;
    for (int t = F.gw; t < T; t += F.NGW) {
        const int cnt = t + 1 < 256 ? t + 1 : 256, nch = (cnt + 31) >> 5;
        bf16x8 Qf[8];
#pragma unroll
        for (int s = 0; s < 8; ++s) Qf[s] = *(const bf16x8*)(DQL + (size_t)t * 2048 + head * 256 + 32 * s + 8 * q);
        f32x4 OT[16];
#pragma unroll
        for (int d = 0; d < 16; ++d) OT[d] = (f32x4){0.f, 0.f, 0.f, 0.f};
        float mrun = -INFINITY, lrun = 0.f;
#pragma unroll 1
        for (int ch = 0; ch < nch; ++ch) {
            const int slot_l = 32 * ch + (lane & 31);
            int idxv = slot_l < cnt ? IDX[(size_t)t * 256 + slot_l] : 0;
#pragma unroll
            for (int i = 0; i < 16; ++i) { const int row = 2 * i + (lane >> 5); const int src = __shfl(idxv, row);
                const v4u v = *(const v4u*)(DC + (size_t)src * 256 + 8 * (lane & 31)); *(LAS v4u*)(tile + row * ATT_RS + 16 * (lane & 31)) = v; }
            LDS_WAIT(); asm volatile("" ::: "memory");
            f32x4 st[2];
#pragma unroll
            for (int rt = 0; rt < 2; ++rt) { st[rt] = (f32x4){0.f, 0.f, 0.f, 0.f};
#pragma unroll
                for (int s = 0; s < 8; ++s) { const bf16x8 cf = *(const LAS bf16x8*)(tile + (16 * rt + r) * ATT_RS + (32 * s + 8 * q) * 2); st[rt] = MFMA16(cf, Qf[s], st[rt]); } }
            float p[2][4]; float cmax = -INFINITY;
#pragma unroll
            for (int rt = 0; rt < 2; ++rt)
#pragma unroll
                for (int e = 0; e < 4; ++e) { const int kl = 16 * rt + 4 * q + e; const int kidx = __shfl(idxv, kl); const int dist = t - kidx;
                    const int bkt = dist < 128 ? tab[dist < 0 ? 0 : dist] : 31; const float lg = (32 * ch + kl < cnt) ? st[rt][e] + rbs[bkt * 8 + head] : -INFINITY;
                    p[rt][e] = lg; cmax = fmaxf(cmax, lg); }
            cmax = fmaxf(cmax, __shfl_xor(cmax, 16)); cmax = fmaxf(cmax, __shfl_xor(cmax, 32));
            const float mnew = fmaxf(mrun, cmax); const float alpha = __expf(mrun - mnew); float psum = 0.f;
#pragma unroll
            for (int rt = 0; rt < 2; ++rt)
#pragma unroll
                for (int e = 0; e < 4; ++e) { p[rt][e] = __expf(p[rt][e] - mnew); psum += p[rt][e]; }
            psum += __shfl_xor(psum, 16); psum += __shfl_xor(psum, 32);
            lrun = lrun * alpha + psum; mrun = mnew;
            v4u pbw; pbw.x = pk2(p[0][0], p[0][1]); pbw.y = pk2(p[0][2], p[0][3]); pbw.z = pk2(p[1][0], p[1][1]); pbw.w = pk2(p[1][2], p[1][3]);
            const bf16x8 pb = __builtin_bit_cast(bf16x8, pbw);
            const unsigned ra = tile_a + (unsigned)((4 * q + (r >> 2)) * ATT_RS + 8 * (r & 3));
#pragma unroll
            for (int d = 0; d < 16; ++d) { OT[d] = OT[d] * alpha;
                const bf16x4 lo = tr_read(ra + 32 * d), hi = tr_read(ra + 16 * ATT_RS + 32 * d);
                OT[d] = MFMA16(cat8(lo, hi), pb, OT[d]); }
        }
        const float inv = 1.0f / lrun;
        if (r < 8) {
#pragma unroll
            for (int d = 0; d < 16; ++d) { v2u w; w.x = pk2(OT[d][0] * inv, OT[d][1] * inv); w.y = pk2(OT[d][2] * inv, OT[d][3] * inv);
                *(v2u*)(DOL + (size_t)t * 2048 + head * 256 + 16 * d + 4 * q) = w; }
        }
    }
}
DI void phase_dsa_uv(const Ctx& F) {
    const bf16* DOL = (const bf16*)(F.ws + WS_DOL); const bf16* WUV = (const bf16*)(F.ws + WS_WUV); bf16* YO = (bf16*)(F.ws + WS_Y) + (size_t)T * 1024;
    for (int it = F.gw; it < 256 * 8; it += F.NGW) { const int mt = it >> 3, h = it & 7;
#pragma unroll 1
        for (int nt = 0; nt < 4; ++nt)
            wave_gemm32_bf16(DOL + (size_t)(mt * 32) * 2048 + h * 256, 2048, WUV + (size_t)h * 128 * 256 + (size_t)(nt * 32) * 256, 256, 256, YO + (size_t)(mt * 32) * 1024 + h * 128 + nt * 32, 1024, F.lane); }
}
DI float* ml_small(const Ctx& F, int off_floats) { return (float*)(F.ws + WS_MSM) + off_floats; }
constexpr int MS_LI = 0, MS_LF = 32768, MS_GC = 65536, MS_GTOT = 98304, MS_WMAX = 98560, MS_MST = 98816, MS_NLOC = 99072, MS_NST = 99072 + 32768;
DI float log_sigmoid(float x) { return fminf(x, 0.f) - log1pf(__expf(-fabsf(x))); }
DI void phase_ml_prep(const Ctx& F, const InTab in, int l) {
    const bf16* Z = (const bf16*)(F.ws + WS_Z); bf16* MQK = (bf16*)(F.ws + WS_MQK);
    const float* cw = in[23] + (size_t)l * 4 * 1024; const float* b_i = in[24] + (size_t)l * 4; const float* b_f = in[25] + (size_t)l * 4;
    float* LI = ml_small(F, MS_LI); float* LF = ml_small(F, MS_LF);
    const int c0 = 16 * F.lane; const float qs = c0 < 512 ? 0.08838834764831845f : 1.0f;
    for (int t = F.gw; t < T; t += F.NGW) {
        float acc[16];
#pragma unroll
        for (int e = 0; e < 16; ++e) acc[e] = 0.f;
#pragma unroll
        for (int j = 0; j < 4; ++j) { const int tt = t - 3 + j; if (tt < 0) continue;
            const v4u z0 = *(const v4u*)(Z + (size_t)tt * NZ + ZMQ + c0), z1 = *(const v4u*)(Z + (size_t)tt * NZ + ZMQ + c0 + 8);
            const unsigned zw[8] = {z0.x, z0.y, z0.z, z0.w, z1.x, z1.y, z1.z, z1.w};
#pragma unroll
            for (int e = 0; e < 8; ++e) { const f32x2 w2 = *(const f32x2*)(cw + (size_t)j * 1024 + c0 + 2 * e); acc[2 * e] = fmaf(w2[0], bflo(zw[e]), acc[2 * e]); acc[2 * e + 1] = fmaf(w2[1], bfhi(zw[e]), acc[2 * e + 1]); } }
        unsigned w[8];
#pragma unroll
        for (int e = 0; e < 8; ++e) { const float a = acc[2 * e], b = acc[2 * e + 1]; w[e] = pk2(a * sigmoidf_(a) * qs, b * sigmoidf_(b) * qs); }
        v4u* op = (v4u*)(MQK + (size_t)t * 1024 + c0); op[0] = (v4u){w[0], w[1], w[2], w[3]}; op[1] = (v4u){w[4], w[5], w[6], w[7]};
        if (F.lane < 4) LI[t * 4 + F.lane] = bf2f(Z[(size_t)t * NZ + ZMI + F.lane]) + b_i[F.lane];
        else if (F.lane < 8) LF[t * 4 + F.lane - 4] = log_sigmoid(bf2f(Z[(size_t)t * NZ + ZMF + F.lane - 4]) + b_f[F.lane - 4]);
    }
}
constexpr int ML_KRS = 288, ML_VRS = 544;
DI void phase_ml_local(const Ctx& F) {
    const bf16* Z = (const bf16*)(F.ws + WS_Z); const bf16* MQK = (const bf16*)(F.ws + WS_MQK); float* MKL = (float*)(F.ws + WS_MKL);
    float* LI = ml_small(F, MS_LI); float* LF = ml_small(F, MS_LF); float* GC = ml_small(F, MS_GC); float* GTOT = ml_small(F, MS_GTOT); float* WMAX = ml_small(F, MS_WMAX); float* NLOC = ml_small(F, MS_NLOC);
    LAS unsigned char* vt = F.lds; LAS unsigned char* kt = F.lds + 128 * ML_VRS; LAS float* wgt = (LAS float*)(F.lds + 128 * ML_VRS + 128 * ML_KRS);
    const int lane = F.lane, r = lane & 15, q = lane >> 4;
    for (int unit = F.bid; unit < 256; unit += F.G) {
        const int c = unit >> 2, h = unit & 3, t0 = c * 128;
        if (F.wave == 0) {
            float f0 = LF[(t0 + 2 * lane) * 4 + h], f1 = LF[(t0 + 2 * lane + 1) * 4 + h];
            float s = f0 + f1;
#pragma unroll
            for (int o = 1; o < 64; o <<= 1) { const float v = __shfl_up(s, o); if (lane >= o) s += v; }
            const float g1 = s, g0 = s - f1;
            const float gtot = __shfl(g1, 63);
            GC[(t0 + 2 * lane) * 4 + h] = g0; GC[(t0 + 2 * lane + 1) * 4 + h] = g1;
            const float w0 = gtot - g0 + LI[(t0 + 2 * lane) * 4 + h], w1 = gtot - g1 + LI[(t0 + 2 * lane + 1) * 4 + h];
            const float wm = wave_max(fmaxf(w0, w1));
            wgt[2 * lane] = __expf(w0 - wm); wgt[2 * lane + 1] = __expf(w1 - wm);
            if (lane == 0) { GTOT[unit] = gtot; WMAX[unit] = wm; }
        }
        __syncthreads();
        for (int i = F.tid; i < 128 * 16; i += NTHR) { const int s = i >> 4, ch = i & 15;
            const v4u kv = *(const v4u*)(MQK + (size_t)(t0 + s) * 1024 + 512 + h * 128 + 8 * ch); const float wg = wgt[s];
            v4u o; o.x = pk2(bflo(kv.x) * wg, bfhi(kv.x) * wg); o.y = pk2(bflo(kv.y) * wg, bfhi(kv.y) * wg); o.z = pk2(bflo(kv.z) * wg, bfhi(kv.z) * wg); o.w = pk2(bflo(kv.w) * wg, bfhi(kv.w) * wg);
            *(LAS v4u*)(kt + s * ML_KRS + 16 * ch) = o; }
        for (int i = F.tid; i < 128 * 32; i += NTHR) { const int s = i >> 5, ch = i & 31;
            *(LAS v4u*)(vt + s * ML_VRS + 16 * ch) = *(const v4u*)(Z + (size_t)(t0 + s) * NZ + ZMV + h * 256 + 8 * ch); }
        __syncthreads();
        f32x4 acc[2][8];
#pragma unroll
        for (int i = 0; i < 2; ++i)
#pragma unroll
            for (int j = 0; j < 8; ++j) acc[i][j] = (f32x4){0.f, 0.f, 0.f, 0.f};
        const unsigned va = (unsigned)(size_t)vt + (unsigned)((r >> 2) * ML_VRS + 8 * (r & 3)), ka = (unsigned)(size_t)kt + (unsigned)((r >> 2) * ML_KRS + 8 * (r & 3));
#pragma unroll 1
        for (int ks = 0; ks < 4; ++ks) {
            bf16x8 af[2], bfr[8];
#pragma unroll
            for (int i = 0; i < 2; ++i) { const unsigned a0 = va + (unsigned)((32 * ks + 8 * q) * ML_VRS + 32 * (2 * F.wave + i)); af[i] = cat8(tr_read(a0), tr_read(a0 + 4 * ML_VRS)); }
#pragma unroll
            for (int j = 0; j < 8; ++j) { const unsigned b0 = ka + (unsigned)((32 * ks + 8 * q) * ML_KRS + 32 * j); bfr[j] = cat8(tr_read(b0), tr_read(b0 + 4 * ML_KRS)); }
#pragma unroll
            for (int i = 0; i < 2; ++i)
#pragma unroll
                for (int j = 0; j < 8; ++j) acc[i][j] = MFMA16(af[i], bfr[j], acc[i][j]);
        }
#pragma unroll
        for (int i = 0; i < 2; ++i)
#pragma unroll
            for (int j = 0; j < 8; ++j)
#pragma unroll
                for (int e = 0; e < 4; ++e) MKL[((size_t)unit * 256 + 16 * (2 * F.wave + i) + 4 * q + e) * 128 + 16 * j + r] = acc[i][j][e];
        if (F.tid < 128) { float s = 0.f; for (int ss = 0; ss < 128; ++ss) s += bf2f(*(const LAS bf16*)(kt + ss * ML_KRS + 2 * F.tid)); NLOC[unit * 128 + F.tid] = s; }
        __syncthreads();
    }
}
DI void phase_ml_scan(const Ctx& F) {
    const float* MKL = (const float*)(F.ws + WS_MKL); bf16* MCS = (bf16*)(F.ws + WS_MCS);
    const float* GTOT = ml_small(F, MS_GTOT); const float* WMAX = ml_small(F, MS_WMAX); float* MST = ml_small(F, MS_MST); const float* NLOC = ml_small(F, MS_NLOC); float* NST = ml_small(F, MS_NST);
    for (int idx = F.bid * NTHR + F.tid; idx < 4 * 256 * 128; idx += F.G * NTHR) {
        const int h = idx >> 15, e = (idx >> 7) & 255, d = idx & 127;
        float m = 0.f, cur = 0.f, ncur = 0.f;
        for (int c = 0; c < 64; ++c) { const int unit = c * 4 + h;
            MCS[((size_t)unit * 256 + e) * 128 + d] = (bf16)f2bf(cur);
            if (e == 0) { NST[unit * 128 + d] = ncur; if (d == 0) MST[unit] = m; }
            const float gt = GTOT[unit], wm = WMAX[unit]; const float mn = fmaxf(gt + m, wm); const float cd = __expf(gt + m - mn), cl = __expf(wm - mn);
            cur = cd * cur + cl * MKL[((size_t)unit * 256 + e) * 128 + d];
            if (e == 0) ncur = cd * ncur + cl * NLOC[unit * 128 + d];
            m = mn; }
    }
}
DI void phase_ml_out(const Ctx& F, const InTab in, int l) {
    const bf16* Z = (const bf16*)(F.ws + WS_Z); const bf16* MQK = (const bf16*)(F.ws + WS_MQK); const bf16* MCS = (const bf16*)(F.ws + WS_MCS);
    const float* LI = ml_small(F, MS_LI); const float* GC = ml_small(F, MS_GC); const float* MST = ml_small(F, MS_MST); const float* NST = ml_small(F, MS_NST);
    const float* hn = in[26] + (size_t)l * 1024; bf16* YO = (bf16*)(F.ws + WS_Y) + (size_t)2 * T * 1024;
    LAS unsigned char* vt = F.lds; LAS float* gcs = (LAS float*)(F.lds + 128 * ML_VRS); LAS float* lgs = gcs + 128; LAS float* pms = gcs + 256; LAS float* nsts = gcs + 384;
    const int lane = F.lane, r = lane & 15, q = lane >> 4, w = F.wave;
    for (int unit = F.bid; unit < 256; unit += F.G) {
        const int c = unit >> 2, h = unit & 3, t0 = c * 128;
        for (int i = F.tid; i < 128 * 32; i += NTHR) { const int s = i >> 5, ch = i & 31;
            *(LAS v4u*)(vt + s * ML_VRS + 16 * ch) = *(const v4u*)(Z + (size_t)(t0 + s) * NZ + ZMV + h * 256 + 8 * ch); }
        if (w == 0) {
            const float g0 = GC[(t0 + 2 * lane) * 4 + h], g1 = GC[(t0 + 2 * lane + 1) * 4 + h];
            const float l0 = LI[(t0 + 2 * lane) * 4 + h] - g0, l1 = LI[(t0 + 2 * lane + 1) * 4 + h] - g1;
            float pm = fmaxf(l0, l1);
#pragma unroll
            for (int o = 1; o < 64; o <<= 1) { const float v = __shfl_up(pm, o); if (lane >= o) pm = fmaxf(pm, v); }
            float pprev = __shfl_up(pm, 1); if (lane == 0) pprev = -INFINITY;
            gcs[2 * lane] = g0; gcs[2 * lane + 1] = g1; lgs[2 * lane] = l0; lgs[2 * lane + 1] = l1; pms[2 * lane] = fmaxf(pprev, l0); pms[2 * lane + 1] = pm;
        }
        if (w == 1) { nsts[lane] = NST[unit * 128 + lane]; nsts[64 + lane] = NST[unit * 128 + 64 + lane]; }
        __syncthreads();
        const int j = 16 * w + r; const float mst = MST[unit];
        const float gcj = gcs[j], alog = gcj + mst, mq = fmaxf(alog, gcj + pms[j]), inter = __expf(alog - mq), gm = gcj - mq;
        bf16x8 qf[4], qi[4];
#pragma unroll
        for (int ks = 0; ks < 4; ++ks) { const v4u qv = *(const v4u*)(MQK + (size_t)(t0 + j) * 1024 + h * 128 + 32 * ks + 8 * q); qf[ks] = __builtin_bit_cast(bf16x8, qv);
            v4u o; o.x = pk2(bflo(qv.x) * inter, bfhi(qv.x) * inter); o.y = pk2(bflo(qv.y) * inter, bfhi(qv.y) * inter); o.z = pk2(bflo(qv.z) * inter, bfhi(qv.z) * inter); o.w = pk2(bflo(qv.w) * inter, bfhi(qv.w) * inter);
            qi[ks] = __builtin_bit_cast(bf16x8, o); }
        const int nkp = (w >> 1) + 1;
        LAS v4u* pls = (LAS v4u*)(F.lds + 73728) + w * 256;
#pragma unroll 1
        for (int kp = 0; kp < nkp; ++kp) {
            float pv[8];
#pragma unroll
            for (int hf = 0; hf < 2; ++hf) { const int st = 2 * kp + hf;
                f32x4 sacc = (f32x4){0.f, 0.f, 0.f, 0.f};
                if (st <= w) {
                    const bf16* kr = MQK + (size_t)(t0 + 16 * st + r) * 1024 + 512 + h * 128 + 8 * q;
#pragma unroll
                    for (int ks = 0; ks < 4; ++ks) { const bf16x8 kf = *(const bf16x8*)(kr + 32 * ks); sacc = MFMA16(kf, qf[ks], sacc); }
                }
#pragma unroll
                for (int e = 0; e < 4; ++e) { const int s = 16 * st + 4 * q + e; pv[4 * hf + e] = (st <= w && s <= j) ? sacc[e] * __expf(gm + lgs[s]) : 0.f; } }
            v4u o; o.x = pk2(pv[0], pv[1]); o.y = pk2(pv[2], pv[3]); o.z = pk2(pv[4], pv[5]); o.w = pk2(pv[6], pv[7]); pls[kp * 64 + lane] = o;
        }
        LDS_WAIT(); asm volatile("" ::: "memory");
        const unsigned va = (unsigned)(size_t)vt + (unsigned)((r >> 2) * ML_VRS + 8 * (r & 3)) + (unsigned)(4 * q * ML_VRS);
        const bf16* crow = MCS + ((size_t)unit * 256 + r) * 128 + 8 * q;
        f32x4 dacc = (f32x4){0.f, 0.f, 0.f, 0.f};
#pragma unroll
        for (int ks = 0; ks < 4; ++ks) { v4u o = (v4u){0u, 0u, 0u, 0u};
            if (r == 0) { const LAS float* np = nsts + 32 * ks + 8 * q; o.x = pk2(np[0], np[1]); o.y = pk2(np[2], np[3]); o.z = pk2(np[4], np[5]); o.w = pk2(np[6], np[7]); }
            dacc = MFMA16(__builtin_bit_cast(bf16x8, o), qi[ks], dacc); }
#pragma unroll
        for (int kp = 0; kp < 4; ++kp) if (kp < nkp) { const unsigned one2 = r == 0 ? 0x3f803f80u : 0u; const v4u o = (v4u){one2, one2, one2, one2}; dacc = MFMA16(__builtin_bit_cast(bf16x8, o), __builtin_bit_cast(bf16x8, pls[kp * 64 + lane]), dacc); }
        const float den = __shfl(dacc[0], r);
        const float dinv = 1.0f / fmaxf(fabsf(den), __expf(-mq));
        float ss = 0.f;
#pragma unroll 1
        for (int et = 0; et < 16; ++et) {
            f32x4 a = (f32x4){0.f, 0.f, 0.f, 0.f};
#pragma unroll
            for (int ks = 0; ks < 4; ++ks) { const bf16x8 cf = *(const bf16x8*)(crow + (size_t)(16 * et) * 128 + 32 * ks); a = MFMA16(cf, qi[ks], a); }
#pragma unroll
            for (int kp = 0; kp < 4; ++kp) if (kp < nkp) { const unsigned a0 = va + (unsigned)((32 * kp) * ML_VRS + 32 * et); a = MFMA16(cat8(tr_read(a0), tr_read(a0 + 16 * ML_VRS)), __builtin_bit_cast(bf16x8, pls[kp * 64 + lane]), a); }
            a = a * dinv; ss += (a[0] * a[0] + a[1] * a[1]) + (a[2] * a[2] + a[3] * a[3]);
        }
        ss += __shfl_xor(ss, 16); ss += __shfl_xor(ss, 32);
        const float rinv = __builtin_amdgcn_rsqf(ss * (1.0f / 256.0f) + EPS) * dinv;
        const int t = t0 + j;
#pragma unroll 1
        for (int et = 0; et < 16; ++et) {
            f32x4 a = (f32x4){0.f, 0.f, 0.f, 0.f};
#pragma unroll
            for (int ks = 0; ks < 4; ++ks) { const bf16x8 cf = *(const bf16x8*)(crow + (size_t)(16 * et) * 128 + 32 * ks); a = MFMA16(cf, qi[ks], a); }
#pragma unroll
            for (int kp = 0; kp < 4; ++kp) if (kp < nkp) { const unsigned a0 = va + (unsigned)((32 * kp) * ML_VRS + 32 * et); a = MFMA16(cat8(tr_read(a0), tr_read(a0 + 16 * ML_VRS)), __builtin_bit_cast(bf16x8, pls[kp * 64 + lane]), a); }
            const int e0 = 16 * et + 4 * q; const v2u ov = *(const v2u*)(Z + (size_t)t * NZ + ZMO + h * 256 + e0); const f32x4 g4 = *(const f32x4*)(hn + h * 256 + e0);
            const float o0 = sigmoidf_(bflo(ov.x)) * a[0] * rinv * g4[0], o1 = sigmoidf_(bfhi(ov.x)) * a[1] * rinv * g4[1], o2 = sigmoidf_(bflo(ov.y)) * a[2] * rinv * g4[2], o3 = sigmoidf_(bfhi(ov.y)) * a[3] * rinv * g4[3];
            v2u wv; wv.x = pk2(o0, o1); wv.y = pk2(o2, o3); *(v2u*)(YO + (size_t)t * 1024 + h * 256 + e0) = wv;
        }
        __syncthreads();
    }
}
constexpr int NPH = 20;
#ifndef MK_PER_PHASE
#define MK_PER_PHASE 0
#endif

template <int PH> __global__ void __launch_bounds__(NTHR, 2) mega(Args args) {
    extern __shared__ __attribute__((aligned(16))) unsigned char lds_raw[];
    LAS unsigned char* glds = (LAS unsigned char*)lds_raw;
    const int wave_s = __builtin_amdgcn_readfirstlane((int)(threadIdx.x >> 6));
    for (int u = threadIdx.x; u < (LDS_BYTES - LDSCTL_OFF) / 4; u += NTHR) ((LAS unsigned*)(glds + LDSCTL_OFF))[u] = 0u;
    __syncthreads();
    const int lo = args.ph_lo, hi = args.ph_hi;
    if (hi - lo > 1) (void)xcd_barrier_post((unsigned*)(opaque_ws(args) + WS_CTL) + CW_BAR, (volatile LAS unsigned*)(glds + MISC_OFF));
    const InTab in{&args};
#pragma unroll 1
    for (int l = 0; l < NL; ++l) {
        const int pb = l * NPH;
#define IN(k) ((PH < 0 || PH == (k)) && lo <= pb + (k) && pb + (k) < hi)
#define SEAM(k) do { if (IN(k) && pb + (k) + 1 < hi) { XcdBarrier b_; b_.bar = (unsigned*)(opaque_ws(args) + WS_CTL) + CW_BAR; b_.x = xb_xcc_id(); b_.st = (volatile LAS unsigned*)(glds + MISC_OFF); b_.t0 = (wave_s == 0) && (lane_id() == 0); xcd_barrier(b_); } } while (0)
#define PHX const Ctx F = make_ctx(args, glds, wave_s); unsigned char* ws = F.ws; bf16* HB = (bf16*)(ws + WS_HB); bf16* ACT = (bf16*)(ws + WS_ACT); float* FB = (float*)(ws + WS_F); bf16* Zb = (bf16*)(ws + WS_Z); float* RS = (float*)(ws + WS_RS); float* FSS = (float*)(ws + WS_FSS); \
        const float* ng = in[2] + (size_t)l * 8 * D; (void)HB; (void)ACT; (void)FB; (void)Zb; (void)RS; (void)FSS; (void)ng;
        if (IN(0)) { PHX phase_conv(F, in, l); if (l == 0) phase_resid<true>(F, in[0], nullptr, 0.f, args.out); }
        SEAM(0);
        if (IN(1)) { PHX pg8::Gemm g{HB, (const bf16*)(ws + WS_WGU1), T, 2 * FF, D}; pg8::StaticOrder S; S.init(T, 2 * FF, F.G, F.bid);
            pg8::EpiSwiglu E{ACT, FF, RS, 1.0f / D, EPS}; pg8::gemm_phase<pg8::EpiSwiglu, pg8::StaticOrder, true, true>(glds, g, S, E, F.tid); }
        SEAM(1);
        if (IN(2)) { PHX pg8::Gemm g{ACT, (const bf16*)(ws + WS_WD1), T, D, FF}; pg8::StaticOrder S; S.init(T, D, F.G, F.bid);
            pg8::EpiF32SS E{FB, D, FSS}; pg8::gemm_phase<pg8::EpiF32SS, pg8::StaticOrder, true, true>(glds, g, S, E, F.tid); }
        SEAM(2);
        if (IN(3)) { PHX phase_resid<false>(F, FB, ng + 1 * D, 0.5f, args.out); }
        SEAM(3);
        if (IN(4)) { PHX pg8::Gemm g{HB, (const bf16*)(ws + WS_WIN), T, NZ, D}; pg8::StaticOrder S; S.init(T, NZ, F.G, F.bid);
            pg8::EpiScaleBf16 E{Zb, NZ, RS, 1.0f / D, EPS}; pg8::gemm_phase<pg8::EpiScaleBf16, pg8::StaticOrder, true, true>(glds, g, S, E, F.tid); }
        SEAM(4);
        if (IN(5)) { PHX phase_rw_prep(F, in, l); phase_dsa_prep(F, in, l); phase_ml_prep(F, in, l); }
        SEAM(5);
        if (IN(6)) { PHX phase_rw_local(F); }
        SEAM(6);
        if (IN(7)) { PHX
            if (F.wave == 0 && F.bid < 64) phase_rw_combine(F, F.bid);
            else { const int nskip = F.bid < 64 ? F.bid + 1 : 64; phase_dsa_index(F, F.gw - nskip, F.NGW - 64); }
            __syncthreads(); phase_ml_local(F); }
        SEAM(7);
        if (IN(8)) { PHX phase_dsa_topk(F); phase_ml_scan(F); phase_rw_out(F, in, l); }
        SEAM(8);
        if (IN(9)) { PHX
            __syncthreads(); phase_dsa_attn(F, in);
            __syncthreads(); phase_ml_out(F, in, l);
        }
        SEAM(9);
        if (IN(10)) { PHX phase_dsa_uv(F); }
        SEAM(10);
        if (IN(11)) { PHX pg8::Gemm g{(const bf16*)(ws + WS_Y), (const bf16*)(ws + WS_WBR), 3 * T, 3 * D, 1024}; pg8::BranchOrder S{F.G, F.bid};
            pg8::EpiBranch E{FB, (bf16*)(ws + WS_MIXG), Zb, NZ, ZG}; pg8::gemm_phase<pg8::EpiBranch, pg8::BranchOrder, true, true>(glds, g, S, E, F.tid); }
        SEAM(11);
        if (IN(12)) { PHX pg8::Gemm g{(const bf16*)(ws + WS_MIXG), (const bf16*)(ws + WS_WOUT), T, D, D}; pg8::StaticOrder S; S.init(T, D, F.G, F.bid);
            pg8::EpiF32SS E{FB, D, FSS}; pg8::gemm_phase<pg8::EpiF32SS, pg8::StaticOrder, true, true>(glds, g, S, E, F.tid); }
        SEAM(12);
        if (IN(13)) { PHX phase_resid<false>(F, FB, ng + 3 * D, 1.0f, args.out); }
        SEAM(13);
        if (IN(14)) { PHX pg8::Gemm g{HB, (const bf16*)(ws + WS_WGU2), T, 2 * FF, D}; pg8::StaticOrder S; S.init(T, 2 * FF, F.G, F.bid);
            pg8::EpiSwiglu E{ACT, FF, RS, 1.0f / D, EPS}; pg8::gemm_phase<pg8::EpiSwiglu, pg8::StaticOrder, true, true>(glds, g, S, E, F.tid); }
        SEAM(14);
        if (IN(15)) { PHX pg8::Gemm g{ACT, (const bf16*)(ws + WS_WD2), T, D, FF}; pg8::StaticOrder S; S.init(T, D, F.G, F.bid);
            pg8::EpiF32SS E{FB, D, FSS}; pg8::gemm_phase<pg8::EpiF32SS, pg8::StaticOrder, true, true>(glds, g, S, E, F.tid); }
        SEAM(15);
        if (IN(16)) { PHX phase_resid<false>(F, FB, ng + 5 * D, 0.5f, args.out); }
        SEAM(16);
        if (IN(17)) { PHX int kple = PLE; asm volatile("" : "+s"(kple)); pg8::Gemm g{(const bf16*)(ws + WS_PB), (const bf16*)(ws + WS_WPP), T, D, kple}; pg8::StaticOrder S; S.init(T, D, F.G, F.bid);
            pg8::EpiScaleBf16 E{(bf16*)(ws + WS_E), D, nullptr, 0.f, 0.f}; pg8::gemm_phase<pg8::EpiScaleBf16, pg8::StaticOrder, true, true>(glds, g, S, E, F.tid); }
        SEAM(17);
        if (IN(18)) { PHX pg8::Gemm g{HB, (const bf16*)(ws + WS_WPG), T, D, D}; pg8::StaticOrder S; S.init(T, D, F.G, F.bid);
            pg8::EpiPleGate E{FB, D, FSS, RS, (const bf16*)(ws + WS_E), 1.0f / D, EPS}; pg8::gemm_phase<pg8::EpiPleGate, pg8::StaticOrder, true, true>(glds, g, S, E, F.tid); }
        SEAM(18);
        if (IN(19)) { PHX phase_resid<false>(F, FB, ng + 7 * D, 1.0f, args.out); }
        SEAM(19);
#undef IN
#undef SEAM
#undef PHX
    }
}

extern "C" void kernel_launch(void* const* d_in, const int* in_sizes, int n_in, void* d_out, int out_size, void* d_ws, size_t ws_size, hipStream_t stream) {
    static int grid = 0;
    if (grid == 0) {
        if (n_in != 34 || in_sizes[0] != T * D || out_size != T * D || ws_size < WS_END) { fprintf(stderr, "kernel_launch: unexpected problem (n_in %d, in0 %d, out %d, ws %zu < %zu); nothing launched\n", n_in, n_in > 0 ? in_sizes[0] : -1, out_size, ws_size, (size_t)WS_END); grid = -1; return; }
        int dev = 0, cus = 0;
        if (hipGetDevice(&dev) != hipSuccess || hipDeviceGetAttribute(&cus, hipDeviceAttributeMultiprocessorCount, dev) != hipSuccess) { grid = -1; return; }
        grid = cus;
    }
    if (grid < 0) return;
    (void)hipMemsetAsync((char*)d_ws + WS_CTL, 0, CTL_ZERO_BYTES, stream);
    Args a{};
    for (int i = 0; i < 34; ++i) a.in[i] = (const float*)d_in[i];
    a.out = (float*)d_out; a.ws = (unsigned char*)d_ws;
#if MK_PER_PHASE
    typedef void (*kfn)(Args);
    static const kfn tab[NPH] = { mega<0>, mega<1>, mega<2>, mega<3>, mega<4>, mega<5>, mega<6>, mega<7>, mega<8>, mega<9>, mega<10>, mega<11>, mega<12>, mega<13>, mega<14>, mega<15>, mega<16>, mega<17>, mega<18>, mega<19> };
    static bool attr = false;
    if (!attr) { for (int k = 0; k < NPH; ++k) if (hipFuncSetAttribute((const void*)tab[k], hipFuncAttributeMaxDynamicSharedMemorySize, LDS_BYTES) != hipSuccess) fprintf(stderr, "kernel_launch: hipFuncSetAttribute failed (phase %d)\n", k); attr = true; }
    for (int p = 0; p < NL * NPH; ++p) { a.ph_lo = p; a.ph_hi = p + 1; hipLaunchKernelGGL(tab[p % NPH], dim3(grid), dim3(NTHR), LDS_BYTES, stream, a); }
#else
    static bool attr = false;
    if (!attr) { if (hipFuncSetAttribute((const void*)mega<-1>, hipFuncAttributeMaxDynamicSharedMemorySize, LDS_BYTES) != hipSuccess) fprintf(stderr, "kernel_launch: hipFuncSetAttribute failed\n"); attr = true; }
    a.ph_lo = 0; a.ph_hi = NL * NPH; hipLaunchKernelGGL(mega<-1>, dim3(grid), dim3(NTHR), LDS_BYTES, stream, a);
#endif
}
```

```cpp
#include <hip/hip_runtime.h>
#include <cstdio>
#include <cstdint>
namespace pg8 {
#define PG8_LAS __attribute__((address_space(3)))
typedef unsigned short bf16_t;
typedef short bf16x8 __attribute__((ext_vector_type(8)));
typedef float f32x4 __attribute__((ext_vector_type(4)));
typedef unsigned u32x4 __attribute__((ext_vector_type(4)));
constexpr int BM = 256, BK = 64, HALF = 128, HTB = HALF * BK * 2  , STAGE_BYTES = 8 * HTB, NXCD = 8, WGM = 8;

__host__ __device__ __forceinline__ int lds_byte(int r, int c) { const int st = (r >> 4) * 2 + (c >> 5), rr = r & 15, cc = c & 31, ob = rr * 64 + cc * 2; return st * 1024 + (ob ^ (((ob >> 9) & 1) << 5)); }
__host__ __device__ __forceinline__ void stage_rc(int b, int& R, int& C) { const int st = b / 1024, sb = b % 1024, swz = sb ^ (((sb >> 9) & 1) << 5); R = (st >> 1) * 16 + swz / 64; C = (st & 1) * 32 + (swz % 64) / 2; }
__host__ __device__ __forceinline__ int perm32(int rho) { const int n = rho >> 4, i = rho & 15; return 8 * (i >> 2) + 4 * n + (i & 3); }

struct Unit { int pm, pn; };
struct Gemm { const bf16_t* A; const bf16_t* Bt; int M, N, K; };

struct StaticOrder {
    int nM, nN, nwg, G, c;
    __host__ __device__ void init(int M, int N, int G_, int c_) { nM = M / BM; nN = N / BM; nwg = nM * nN; G = G_; c = c_; }
    __host__ __device__ bool next(int i, Unit& u) const {
        const long L = (long)i * G + c; if (L >= nwg) return false;
        int wgid = (int)L; { const int q = nwg / NXCD, r = nwg % NXCD, xcd = wgid % NXCD, off = wgid / NXCD; wgid = (xcd < r ? xcd * (q + 1) : r * (q + 1) + (xcd - r) * q) + off; }
        const int nig = WGM * nN, gid = wgid / nig, fm = gid * WGM, gsz = (nM - fm) < WGM ? (nM - fm) : WGM;
        u.pm = fm + ((wgid % nig) % gsz); u.pn = (wgid % nig) / gsz; return true;
    }
    __device__ __forceinline__ void a_ready(const Unit&) const {}
    __device__ __forceinline__ void done(const Unit&) const {}
};
__device__ __forceinline__ unsigned cvt_pk_bf16(float lo, float hi) { unsigned r; asm volatile("v_cvt_pk_bf16_f32 %0, %1, %2" : "=v"(r) : "v"(lo), "v"(hi)); return r; }
typedef float f32x2 __attribute__((ext_vector_type(2)));
__device__ __forceinline__ float fast_sigmoid(float x) { return __builtin_amdgcn_rcpf(1.0f + __builtin_amdgcn_exp2f(-1.44269504089f * x)); }
typedef unsigned u32x2 __attribute__((ext_vector_type(2)));
struct EpiSwiglu {
    static constexpr bool PERM = true, AFTER_DRAIN = false;
    bf16_t* O; int ldo; const float* rs; float inv_d, eps;
    __device__ __forceinline__ void operator()(const f32x4 (&acc)[2][2][4][2], const Unit& u, int wr, int wc, int fr, int fq) const {
        const int row0 = u.pm * BM + wr * 64 + fr, col0 = u.pn * HALF + wc * 32 + 8 * fq;
#pragma unroll
        for (int ai = 0; ai < 2; ++ai)
#pragma unroll
            for (int m = 0; m < 4; ++m) { const int row = row0 + ai * HALF + m * 16; const float rinv = __builtin_amdgcn_rsqf(rs[row] * inv_d + eps);
                float o[8];
#pragma unroll
                for (int n = 0; n < 2; ++n)
#pragma unroll
                    for (int j = 0; j < 4; ++j) { const float g = acc[ai][0][m][n][j] * rinv, up = acc[ai][1][m][n][j] * rinv; o[4 * n + j] = g * fast_sigmoid(g) * up; }
                u32x4 w; w.x = cvt_pk_bf16(o[0], o[1]); w.y = cvt_pk_bf16(o[2], o[3]); w.z = cvt_pk_bf16(o[4], o[5]); w.w = cvt_pk_bf16(o[6], o[7]);
                *(u32x4*)(O + (size_t)row * ldo + col0) = w; }
    }
};
struct EpiScaleBf16 {
    static constexpr bool PERM = true, AFTER_DRAIN = false;
    bf16_t* O; int ldo; const float* rs; float inv_d, eps;
    __device__ __forceinline__ void operator()(const f32x4 (&acc)[2][2][4][2], const Unit& u, int wr, int wc, int fr, int fq) const {
        const int row0 = u.pm * BM + wr * 64 + fr, col0 = u.pn * BM + wc * 32 + 8 * fq;
#pragma unroll
        for (int ai = 0; ai < 2; ++ai)
#pragma unroll
            for (int m = 0; m < 4; ++m) { const int row = row0 + ai * HALF + m * 16; const float rinv = rs ? __builtin_amdgcn_rsqf(rs[row] * inv_d + eps) : 1.0f;
                bf16_t* rowp = O + (size_t)row * ldo + col0;
#pragma unroll
                for (int bj = 0; bj < 2; ++bj) { const f32x4 v0 = acc[ai][bj][m][0] * rinv, v1 = acc[ai][bj][m][1] * rinv;
                    u32x4 w; w.x = cvt_pk_bf16(v0[0], v0[1]); w.y = cvt_pk_bf16(v0[2], v0[3]); w.z = cvt_pk_bf16(v1[0], v1[1]); w.w = cvt_pk_bf16(v1[2], v1[3]);
                    *(u32x4*)(rowp + bj * HALF) = w; } }
    }
};
struct EpiF32SS {
    static constexpr bool PERM = false, AFTER_DRAIN = false;
    float* C; int ldc; float* ss;
    __device__ __forceinline__ void operator()(const f32x4 (&acc)[2][2][4][2], const Unit& u, int wr, int wc, int fr, int fq) const {
        const int row0 = u.pm * BM + wr * 64 + fr, col0 = u.pn * BM + wc * 32 + 4 * fq;
#pragma unroll
        for (int ai = 0; ai < 2; ++ai)
#pragma unroll
            for (int m = 0; m < 4; ++m) { const int row = row0 + ai * HALF + m * 16; float* rowp = C + (size_t)row * ldc + col0; float s = 0.f;
#pragma unroll
                for (int bj = 0; bj < 2; ++bj)
#pragma unroll
                    for (int n = 0; n < 2; ++n) { const f32x4 v = acc[ai][bj][m][n]; *(f32x4*)(rowp + bj * HALF + n * 16) = v; s += (v[0] * v[0] + v[1] * v[1]) + (v[2] * v[2] + v[3] * v[3]); }
                (void)s; }
    }
};
struct EpiBranch {
    static constexpr bool PERM = false, AFTER_DRAIN = false;
    float* MIX; bf16_t* MIXG; const bf16_t* Z; int ldz, zg0;
    __device__ __forceinline__ void operator()(const f32x4 (&acc)[2][2][4][2], const Unit& u, int wr, int wc, int fr, int fq) const {
        const int b = u.pm >> 5, pm = u.pm & 31, pn = u.pn & 7;
        const int row0 = pm * BM + wr * 64 + fr, col0 = pn * BM + wc * 32 + 4 * fq;
#pragma unroll
        for (int ai = 0; ai < 2; ++ai)
#pragma unroll
            for (int m = 0; m < 4; ++m) { const int row = row0 + ai * HALF + m * 16; const bf16_t* zp = Z + (size_t)row * ldz + zg0 + b * 2048 + col0; float* mp = MIX + (size_t)row * 2048 + col0; bf16_t* op = MIXG + (size_t)row * 2048 + col0;
#pragma unroll
                for (int bj = 0; bj < 2; ++bj)
#pragma unroll
                    for (int n = 0; n < 2; ++n) { const int co = bj * HALF + n * 16; const u32x2 gz = *(const u32x2*)(zp + co);
                        f32x4 g; g[0] = fast_sigmoid(__uint_as_float(gz.x << 16)); g[1] = fast_sigmoid(__uint_as_float(gz.x & 0xffff0000u)); g[2] = fast_sigmoid(__uint_as_float(gz.y << 16)); g[3] = fast_sigmoid(__uint_as_float(gz.y & 0xffff0000u));
                        f32x4 v = acc[ai][bj][m][n] * g;
                        if (b > 0) { f32x4 o; o[0] = __hip_atomic_load(mp + co + 0, __ATOMIC_RELAXED, __HIP_MEMORY_SCOPE_AGENT); o[1] = __hip_atomic_load(mp + co + 1, __ATOMIC_RELAXED, __HIP_MEMORY_SCOPE_AGENT);
                            o[2] = __hip_atomic_load(mp + co + 2, __ATOMIC_RELAXED, __HIP_MEMORY_SCOPE_AGENT); o[3] = __hip_atomic_load(mp + co + 3, __ATOMIC_RELAXED, __HIP_MEMORY_SCOPE_AGENT); v += o; }
                        if (b < 2) *(f32x4*)(mp + co) = v;
                        else { u32x2 w; w.x = cvt_pk_bf16(v[0], v[1]); w.y = cvt_pk_bf16(v[2], v[3]); *(u32x2*)(op + co) = w; } } }
    }
};
struct EpiPleGate {
    static constexpr bool PERM = false, AFTER_DRAIN = false;
    float* C; int ldc; float* ss; const float* rs; const bf16_t* E; float inv_d, eps;
    __device__ __forceinline__ void operator()(const f32x4 (&acc)[2][2][4][2], const Unit& u, int wr, int wc, int fr, int fq) const {
        const int row0 = u.pm * BM + wr * 64 + fr, col0 = u.pn * BM + wc * 32 + 4 * fq;
#pragma unroll
        for (int ai = 0; ai < 2; ++ai)
#pragma unroll
            for (int m = 0; m < 4; ++m) { const int row = row0 + ai * HALF + m * 16; float* rowp = C + (size_t)row * ldc + col0; const bf16_t* ep = E + (size_t)row * ldc + col0; float s = 0.f;
                const float rinv = __builtin_amdgcn_rsqf(rs[row] * inv_d + eps);
#pragma unroll
                for (int bj = 0; bj < 2; ++bj)
#pragma unroll
                    for (int n = 0; n < 2; ++n) { const int co = bj * HALF + n * 16; const u32x2 ez = *(const u32x2*)(ep + co); f32x4 v = acc[ai][bj][m][n] * rinv;
                        v[0] = fast_sigmoid(v[0]) * __uint_as_float(ez.x << 16); v[1] = fast_sigmoid(v[1]) * __uint_as_float(ez.x & 0xffff0000u);
                        v[2] = fast_sigmoid(v[2]) * __uint_as_float(ez.y << 16); v[3] = fast_sigmoid(v[3]) * __uint_as_float(ez.y & 0xffff0000u);
                        *(f32x4*)(rowp + co) = v; s += (v[0] * v[0] + v[1] * v[1]) + (v[2] * v[2] + v[3] * v[3]); }
                (void)s; }
    }
};
struct BranchOrder {
    int G, c;
    __device__ __forceinline__ bool next(int i, Unit& u) const { const int tile = c + (i / 3) * G, b = i % 3; if (tile >= 256) return false; u.pm = b * 32 + (tile & 31); u.pn = b * 8 + (tile >> 5); return true; }
    __device__ __forceinline__ void a_ready(const Unit&) const {}
    __device__ __forceinline__ void done(const Unit&) const {}
};
template <class Epi, class Sched, bool ALIGN_EPI = false, bool SP2 = false>
__device__ __forceinline__ void gemm_phase(PG8_LAS unsigned char* lds, const Gemm g, const Sched& S, const Epi& E, const int tid_in) {
    const int tid = tid_in, wid = __builtin_amdgcn_readfirstlane(tid >> 6), lane = tid & 63, wr = wid >> 2, wc = wid & 3, fr = lane & 15, fq = lane >> 4;
    const int K = g.K, nt = K / BK;
    unsigned voffA[2], voffB[2];
#pragma unroll
    for (int i = 0; i < 2; ++i) { int R, C; stage_rc(tid * 16 + i * 8192, R, C); const int Rb = Epi::PERM ? ((R & ~31) + perm32(R & 31)) : R;
        voffA[i] = (unsigned)(R * K + C) * 2u; voffB[i] = (unsigned)(Rb * K + C) * 2u; }
    const size_t kstep = (size_t)(BK * 2);
    const size_t hstep = (size_t)HALF * K * 2;
    const size_t tstep = 2 * hstep;
    const unsigned ldsw = (unsigned)wid * 1024u;
    const int aoff = lds_byte(wr * 64 + fr, fq * 8), boff = lds_byte(wc * 32 + fr, fq * 8);
#define PG8_SA(b, h) (((b) * 2 + (h)) * HTB)
#define PG8_SB(b, h) ((4 + (b) * 2 + (h)) * HTB)
#define PG8_STAGE(bufoff, gbase, voff) do { _Pragma("unroll") for (int _i = 0; _i < 2; ++_i) \
        __builtin_amdgcn_global_load_lds((const unsigned*)((const char*)(gbase) + (voff)[_i]), (PG8_LAS unsigned*)(lds + (bufoff) + ldsw + _i * 8192), 16, 0, 0); } while (0)
#define PG8_LDA(dst, b, h) do { _Pragma("unroll") for (int m = 0; m < 4; ++m) _Pragma("unroll") for (int k = 0; k < 2; ++k) dst[m][k] = *(const PG8_LAS bf16x8*)(lds + PG8_SA(b, h) + aoff + m * 2048 + k * 1024); } while (0)
#define PG8_LDB(dst, b, h) do { _Pragma("unroll") for (int n = 0; n < 2; ++n) _Pragma("unroll") for (int k = 0; k < 2; ++k) dst[n][k] = *(const PG8_LAS bf16x8*)(lds + PG8_SB(b, h) + boff + n * 2048 + k * 1024); } while (0)
#define PG8_MMA(ai, bj, At, Bt) do { __builtin_amdgcn_s_setprio(1); _Pragma("unroll") for (int m = 0; m < 4; ++m) _Pragma("unroll") for (int n = 0; n < 2; ++n) _Pragma("unroll") for (int k = 0; k < 2; ++k) \
        acc[ai][bj][m][n] = __builtin_amdgcn_mfma_f32_16x16x32_bf16(Bt[n][k], At[m][k], acc[ai][bj][m][n], 0, 0, 0); __builtin_amdgcn_s_setprio(0); } while (0)
#define PG8_WAIT_V(n) asm volatile("s_waitcnt vmcnt(" #n ")" ::: "memory")
#define PG8_WAIT_L(n) asm volatile("s_waitcnt lgkmcnt(" #n ")" ::: "memory")
#define PG8_BAR __builtin_amdgcn_s_barrier()
#define PG8_SCHED __builtin_amdgcn_sched_barrier(0)
    Unit cur, nxt; int ui = 0;
    if (!S.next(0, cur)) return;
    f32x4 acc[2][2][4][2];
#pragma unroll
    for (int a = 0; a < 2; ++a)
#pragma unroll
        for (int b = 0; b < 2; ++b)
#pragma unroll
            for (int m = 0; m < 4; ++m)
#pragma unroll
                for (int n = 0; n < 2; ++n) acc[a][b][m][n] = (f32x4){0.f, 0.f, 0.f, 0.f};
    bf16x8 At[4][2], B0[2][2], B1[2][2];
    const char* cA = (const char*)g.A + (size_t)cur.pm * tstep; const char* cB = (const char*)g.Bt + (size_t)cur.pn * tstep;
    S.a_ready(cur);
    if constexpr (SP2) {
        PG8_STAGE(PG8_SB(0, 0), cB, voffB); PG8_STAGE(PG8_SB(0, 1), cB + hstep, voffB); PG8_STAGE(PG8_SA(0, 0), cA, voffA); PG8_STAGE(PG8_SA(0, 1), cA + hstep, voffA);
        if (wr == 1) PG8_BAR;
        PG8_WAIT_V(2); PG8_BAR;
        PG8_STAGE(PG8_SB(1, 0), cB + kstep, voffB); PG8_STAGE(PG8_SA(1, 0), cA + kstep, voffA); PG8_STAGE(PG8_SB(1, 1), cB + hstep + kstep, voffB);
        PG8_WAIT_V(6); PG8_BAR;
    } else {
        PG8_STAGE(PG8_SB(0, 0), cB, voffB); PG8_STAGE(PG8_SA(0, 0), cA, voffA); PG8_STAGE(PG8_SB(0, 1), cB + hstep, voffB); PG8_STAGE(PG8_SA(0, 1), cA + hstep, voffA);
        if (wr == 1) PG8_BAR;
        PG8_WAIT_V(4); PG8_BAR;
        PG8_STAGE(PG8_SB(1, 0), cB + kstep, voffB); PG8_STAGE(PG8_SA(1, 0), cA + kstep, voffA); PG8_STAGE(PG8_SB(1, 1), cB + hstep + kstep, voffB);
        PG8_WAIT_V(6); PG8_BAR;
    }
    for (;;) {
        const bool has_next = S.next(ui + 1, nxt);
        const char* nA = has_next ? (const char*)g.A + (size_t)nxt.pm * tstep : cA; const char* nB = has_next ? (const char*)g.Bt + (size_t)nxt.pn * tstep : cB;
        for (int t = 0; t < nt; t += 2) {
            const bool last = (t == nt - 2);
            const char* a1 = cA + (size_t)(t + 1) * kstep;
            const char* a2 = last ? nA : cA + (size_t)(t + 2) * kstep; const char* b2 = last ? nB : cB + (size_t)(t + 2) * kstep;
            const char* a3 = a2 + kstep; const char* b3 = b2 + kstep;
            if (last && has_next) S.a_ready(nxt);
            if constexpr (SP2) {
            PG8_LDB(B0, 0, 0); PG8_LDB(B1, 0, 1); PG8_SCHED; PG8_LDA(At, 0, 0); PG8_STAGE(PG8_SA(1, 1), a1 + hstep, voffA);
            PG8_WAIT_V(8); PG8_WAIT_L(0); PG8_BAR; PG8_MMA(0, 0, At, B0); PG8_MMA(0, 1, At, B1); PG8_BAR; PG8_SCHED;
            PG8_LDA(At, 0, 1); PG8_STAGE(PG8_SB(0, 0), b2, voffB); PG8_STAGE(PG8_SB(0, 1), b2 + hstep, voffB); PG8_STAGE(PG8_SA(0, 0), a2, voffA);
            PG8_WAIT_V(8); PG8_WAIT_L(0); PG8_BAR; PG8_MMA(1, 0, At, B0); PG8_MMA(1, 1, At, B1); PG8_BAR; PG8_SCHED;
            PG8_LDB(B0, 1, 0); PG8_LDB(B1, 1, 1); PG8_SCHED; PG8_LDA(At, 1, 0); PG8_STAGE(PG8_SA(0, 1), a2 + hstep, voffA);
            PG8_WAIT_V(8); PG8_WAIT_L(0); PG8_BAR; PG8_MMA(0, 0, At, B0); PG8_MMA(0, 1, At, B1); PG8_BAR; PG8_SCHED;
            PG8_LDA(At, 1, 1); PG8_STAGE(PG8_SB(1, 0), b3, voffB); PG8_STAGE(PG8_SB(1, 1), b3 + hstep, voffB); PG8_STAGE(PG8_SA(1, 0), a3, voffA);
            PG8_WAIT_V(8); PG8_WAIT_L(0); PG8_BAR; PG8_MMA(1, 0, At, B0); PG8_MMA(1, 1, At, B1); PG8_BAR; PG8_SCHED;
            } else {
            PG8_LDB(B0, 0, 0); PG8_SCHED; PG8_LDA(At, 0, 0); PG8_STAGE(PG8_SA(1, 1), a1 + hstep, voffA);
            PG8_WAIT_L(8); PG8_BAR; PG8_WAIT_L(0); PG8_MMA(0, 0, At, B0); PG8_BAR; PG8_SCHED;
            PG8_LDB(B1, 0, 1); PG8_STAGE(PG8_SB(0, 0), b2, voffB);
            PG8_BAR; PG8_WAIT_L(0); PG8_MMA(0, 1, At, B1); PG8_BAR;
            PG8_LDA(At, 0, 1); PG8_STAGE(PG8_SA(0, 0), a2, voffA);
            PG8_BAR; PG8_WAIT_L(0); PG8_MMA(1, 0, At, B0); PG8_BAR; PG8_SCHED;
            PG8_STAGE(PG8_SB(0, 1), b2 + hstep, voffB);
            PG8_WAIT_V(6); PG8_BAR; PG8_MMA(1, 1, At, B1); PG8_BAR;
            PG8_LDB(B0, 1, 0); PG8_SCHED; PG8_LDA(At, 1, 0); PG8_STAGE(PG8_SA(0, 1), a2 + hstep, voffA);
            PG8_WAIT_L(8); PG8_BAR; PG8_WAIT_L(0); PG8_MMA(0, 0, At, B0); PG8_BAR; PG8_SCHED;
            PG8_LDB(B1, 1, 1); PG8_STAGE(PG8_SB(1, 0), b3, voffB);
            PG8_BAR; PG8_WAIT_L(0); PG8_MMA(0, 1, At, B1); PG8_BAR;
            PG8_LDA(At, 1, 1); PG8_STAGE(PG8_SA(1, 0), a3, voffA);
            PG8_BAR; PG8_WAIT_L(0); PG8_MMA(1, 0, At, B0); PG8_BAR; PG8_SCHED;
            PG8_STAGE(PG8_SB(1, 1), b3 + hstep, voffB);
            PG8_WAIT_V(6); PG8_BAR; PG8_MMA(1, 1, At, B1); PG8_BAR;
            }
        }
        if constexpr (ALIGN_EPI) { if (wr == 0) PG8_BAR; }
        if constexpr (!Epi::AFTER_DRAIN) { E(acc, cur, wr, wc, fr, fq); S.done(cur); }
        if (!has_next) break;
#pragma unroll
        for (int a = 0; a < 2; ++a)
#pragma unroll
            for (int b = 0; b < 2; ++b)
#pragma unroll
                for (int m = 0; m < 4; ++m)
#pragma unroll
                    for (int n = 0; n < 2; ++n) acc[a][b][m][n] = (f32x4){0.f, 0.f, 0.f, 0.f};
        cur = nxt; cA = nA; cB = nB; ++ui;
        if constexpr (ALIGN_EPI) { if (wr == 1) PG8_BAR; }
    }
    PG8_WAIT_V(0);
    if constexpr (!ALIGN_EPI) { if (wr == 0) PG8_BAR; }
    PG8_BAR;
    if constexpr (Epi::AFTER_DRAIN) { E.fused(acc, cur, wr, wc, fr, fq, lds, wid, lane); S.done(cur); }
#undef PG8_SA
#undef PG8_SB
#undef PG8_STAGE
#undef PG8_LDA
#undef PG8_LDB
#undef PG8_MMA
#undef PG8_WAIT_V
#undef PG8_WAIT_L
#undef PG8_BAR
#undef PG8_SCHED
}
}
constexpr int T = 8192, D = 2048, FF = 5632, NL = 4, PLE = 256, NIN = 14968;
constexpr int NZ = 15104;
constexpr int ZR = 0, ZK = 1024, ZV = 2048, ZWD = 3072, ZAD = 3136, ZGD = 3200;
constexpr int ZDQ = 3360, ZCKV = 4384, ZQI = 4640, ZKI = 5664, ZWI = 5728;
constexpr int ZMQ = 5760, ZMK = 6272, ZMV = 6784, ZMO = 7808, ZMI = 8832, ZMF = 8836;
constexpr int ZG = 8864;
constexpr float EPS = 1e-6f;
constexpr int NWAVES = 8, NTHR = 512;

constexpr size_t MiB = 1u << 20;
constexpr size_t WS_CTL = 0, CTL_ZERO_BYTES = 1 * MiB;
constexpr size_t WS_WGU1 = 1 * MiB;
constexpr size_t WS_WD1 = WS_WGU1 + 44 * MiB;
constexpr size_t WS_WIN = WS_WD1 + 22 * MiB;
constexpr size_t WS_WBR = WS_WIN + 59 * MiB;
constexpr size_t WS_WOUT = WS_WBR + 12 * MiB;
constexpr size_t WS_WGU2 = WS_WOUT + 8 * MiB;
constexpr size_t WS_WD2 = WS_WGU2 + 44 * MiB;
constexpr size_t WS_WPG = WS_WD2 + 22 * MiB;
constexpr size_t WS_WPP = WS_WPG + 8 * MiB;
constexpr size_t WS_WLW = WS_WPP + 1 * MiB;
constexpr size_t WS_WLA = WS_WLW + 128 * 1024;
constexpr size_t WS_WLG = WS_WLA + 128 * 1024;
constexpr size_t WS_WUK = WS_WLG + 512 * 1024;
constexpr size_t WS_WUV = WS_WUK + 512 * 1024;
constexpr size_t WS_ACT0 = 224 * MiB;
static_assert(WS_WUV + 512 * 1024 <= WS_ACT0, "weights region");
constexpr size_t WS_HB = WS_ACT0;
constexpr size_t WS_ACT = WS_HB + 32 * MiB;
constexpr size_t WS_F = WS_ACT + 88 * MiB;
constexpr size_t WS_Z = WS_F + 64 * MiB;
constexpr size_t WS_RS = WS_Z + 236 * MiB;
constexpr size_t WS_FSS = WS_RS + 64 * 1024;
constexpr size_t WS_MISC = WS_FSS + 64 * 1024;
constexpr size_t WS_RW = WS_MISC + 896 * 1024;
constexpr size_t RW_STRIDE = 32 * MiB;
constexpr size_t WS_DSA = WS_RW + 9 * RW_STRIDE;
constexpr size_t WS_DC = WS_DSA;
constexpr size_t WS_DKI = WS_DC + 4 * MiB;
constexpr size_t WS_DWI = WS_DKI + 1 * MiB;
constexpr size_t WS_DIDX = WS_DWI + 1 * MiB;
constexpr size_t WS_DQL = WS_DIDX + 8 * MiB;
constexpr size_t WS_DOL = WS_DQL + 32 * MiB;
constexpr size_t WS_DSC = WS_DOL + 32 * MiB;
constexpr size_t WS_ML = WS_DSC + 256 * MiB;
constexpr size_t WS_MQK = WS_ML;
constexpr size_t WS_MKL = WS_MQK + 16 * MiB;
constexpr size_t WS_MCS = WS_MKL + 32 * MiB;
constexpr size_t WS_MSM = WS_MCS + 16 * MiB;
constexpr size_t WS_Y = WS_MSM + 2 * MiB;
constexpr size_t WS_MIXG = WS_Y + 48 * MiB;
constexpr size_t WS_E = WS_MIXG + 32 * MiB;
constexpr size_t WS_PB = WS_E + 32 * MiB;
constexpr size_t WS_END = WS_PB + 4 * MiB;
static_assert(WS_END <= (size_t)1800 * MiB, "workspace budget");
constexpr int CW_TMO = 0, CW_BAR = 4096;

constexpr int LDS_BYTES = 147456;
constexpr int LDSCTL_OFF = 146432, MISC_OFF = LDSCTL_OFF + 256;

#define GAS __attribute__((address_space(1)))
#define LAS __attribute__((address_space(3)))
#define DI __device__ __forceinline__
typedef unsigned short bf16;
typedef unsigned v4u __attribute__((ext_vector_type(4)));
typedef unsigned v2u __attribute__((ext_vector_type(2)));
typedef float f32x4 __attribute__((ext_vector_type(4)));
typedef float f32x2 __attribute__((ext_vector_type(2)));
typedef short bf16x8 __attribute__((ext_vector_type(8)));
typedef short bf16x4 __attribute__((ext_vector_type(4)));
typedef GAS unsigned gu32;
#define RLX_AGENT __ATOMIC_RELAXED, __HIP_MEMORY_SCOPE_AGENT
#define LDS_WAIT() asm volatile("s_waitcnt lgkmcnt(0)" ::: "memory")
#define VM_WAIT() asm volatile("s_waitcnt vmcnt(0)" ::: "memory")
DI unsigned f2bf(float f) { unsigned u = __builtin_bit_cast(unsigned, f); return (u + 0x7fffu + ((u >> 16) & 1u)) >> 16; }
DI unsigned pk2(float lo, float hi) { return f2bf(lo) | (f2bf(hi) << 16); }
DI float bf2f(unsigned short b) { return __uint_as_float(((unsigned)b) << 16); }
DI float bflo(unsigned w) { return __uint_as_float(w << 16); }
DI float bfhi(unsigned w) { return __uint_as_float(w & 0xffff0000u); }
DI float fexp(float x) { return __builtin_amdgcn_exp2f(x * 1.44269504089f); }
DI float flog(float x) { return __builtin_amdgcn_logf(x) * 0.69314718056f; }
DI float frcp(float x) { return __builtin_amdgcn_rcpf(x); }
DI float sigmoidf_(float x) { return frcp(1.0f + fexp(-x)); }
DI float ftanh(float x) { const float e = fexp(-2.0f * fabsf(x)); const float t = (1.0f - e) * frcp(1.0f + e); return x < 0.f ? -t : t; }
DI float flog_sigmoid(float x) { return fminf(x, 0.f) - flog(1.0f + fexp(-fabsf(x))); }
DI float wave_sum(float v) {
#pragma unroll
    for (int o = 1; o < 64; o <<= 1) v += __shfl_xor(v, o);
    return v;
}
DI float wave_max(float v) {
#pragma unroll
    for (int o = 1; o < 64; o <<= 1) v = fmaxf(v, __shfl_xor(v, o));
    return v;
}
#define MFMA16(a, b, c) __builtin_amdgcn_mfma_f32_16x16x32_bf16((a), (b), (c), 0, 0, 0)
#define MFMA32(a, b, c) __builtin_amdgcn_mfma_f32_32x32x16_bf16((a), (b), (c), 0, 0, 0)
typedef float f32x16 __attribute__((ext_vector_type(16)));
DI bf16x4 tr_read(unsigned lds_addr) { bf16x4 r; asm volatile("ds_read_b64_tr_b16 %0, %1\n\ts_waitcnt lgkmcnt(0)" : "=&v"(r) : "v"(lds_addr) : "memory"); return r; }
DI bf16x8 cat8(bf16x4 lo, bf16x4 hi) { return __builtin_shufflevector(lo, hi, 0, 1, 2, 3, 4, 5, 6, 7); }
#define XB_TMO      128
#define XB_XCNT(j)  (256  + 64 * (j))
#define XB_XSUB(j)  (1280 + 64 * (j))
#define XB_XGEN(j)  (2304 + 64 * (j))
#define XB_TOP      3328
#define XB_TOPGEN   3392
#define XCD_BAR_WORDS 3456
#define XB_SPIN_CAP (1u << 18)

__device__ __forceinline__ unsigned xb_ld(unsigned* p)              { return __hip_atomic_load(p, __ATOMIC_RELAXED, __HIP_MEMORY_SCOPE_AGENT); }
__device__ __forceinline__ unsigned xb_add(unsigned* p, unsigned v) { return __hip_atomic_fetch_add(p, v, __ATOMIC_RELAXED, __HIP_MEMORY_SCOPE_AGENT); }
__device__ __forceinline__ unsigned xb_xcc_id() { return (unsigned)__builtin_amdgcn_s_getreg((3 << 11) | 20) & 0xFu; }
#define XB_SPIN(cond, bar) do { unsigned _sp = 0; while (cond) { __builtin_amdgcn_s_sleep(1); \
    if ((++_sp & 255u) == 0u) { if (xb_ld(&(bar)[XB_TMO])) break; if (_sp > XB_SPIN_CAP) { atomicAdd(&(bar)[XB_TMO], 1u); break; } } } } while (0)

struct XcdBarrier {
    unsigned* bar; unsigned x; bool t0;
    volatile LAS unsigned* st;
};

__device__ __forceinline__ XcdBarrier xcd_barrier_post(unsigned* bar, volatile LAS unsigned* st) {
    XcdBarrier b; b.bar = bar; b.x = xb_xcc_id(); b.st = st;
    if (threadIdx.x == 0) (void)xb_add(&bar[XB_XCNT(b.x)], 1u);
    return b;
}
__device__ __forceinline__ void xcd_barrier_complete(unsigned* bar, unsigned x, unsigned& nloc, unsigned& nx) {
    const unsigned G = gridDim.x * gridDim.y * gridDim.z;
    unsigned sum, cnt, mine, sp = 0u;
    for (;;) {
        sum = 0u; cnt = 0u; mine = 0u;
#pragma unroll
        for (unsigned j = 0; j < 16; ++j) { const unsigned c = xb_ld(&bar[XB_XCNT(j)]); sum += c; cnt += (c > 0u) ? 1u : 0u; mine = (j == x) ? c : mine; }
        if (sum == G) break;
        __builtin_amdgcn_s_sleep(1);
        if ((++sp & 255u) == 0u) { if (xb_ld(&bar[XB_TMO])) break; if (sp > XB_SPIN_CAP) { atomicAdd(&bar[XB_TMO], 1u); break; } }
    }
    nloc = mine > 0u ? mine : 1u; nx = cnt > 0u ? cnt : 1u;
}

__device__ __forceinline__ void xcd_barrier(const XcdBarrier& b) {
    asm volatile("s_waitcnt vmcnt(0)" ::: "memory");
    __syncthreads();
    if (b.t0) {
        unsigned* bar = b.bar;
        __builtin_amdgcn_s_waitcnt(0);
        unsigned nloc = b.st[0], nx = b.st[1];
        if (nloc == 0u) { xcd_barrier_complete(bar, b.x, nloc, nx); b.st[0] = nloc; b.st[1] = nx; }
        const unsigned old = xb_add(&bar[XB_XSUB(b.x)], 1u);
        const unsigned gen = old / nloc;
        if (old + 1u == (gen + 1u) * nloc) {
            __builtin_amdgcn_fence(__ATOMIC_RELEASE, "agent");
            asm volatile("s_waitcnt vmcnt(0)" ::: "memory");
            const unsigned og = xb_add(&bar[XB_TOP], 1u);
            const unsigned tg = og / nx;
            if (og + 1u == (tg + 1u) * nx) xb_add(&bar[XB_TOPGEN], 1u);
            else XB_SPIN(xb_ld(&bar[XB_TOPGEN]) == tg, bar);
            __builtin_amdgcn_fence(__ATOMIC_ACQUIRE, "agent");
            xb_add(&bar[XB_XGEN(b.x)], 1u);
            asm volatile("s_waitcnt vmcnt(0)" ::: "memory");
        } else {
            XB_SPIN(xb_ld(&bar[XB_XGEN(b.x)]) == gen, bar);
            __builtin_amdgcn_fence(__ATOMIC_ACQUIRE, "agent");
            asm volatile("s_waitcnt vmcnt(0)" ::: "memory");
        }
    }
    __syncthreads();
}
struct Ctx { LAS unsigned char* lds; unsigned char* ws; int tid, lane, wave, gw, NGW, G, bid; };
struct Args { const float* in[34]; float* out; unsigned char* ws; int ph_lo, ph_hi; };
struct InTab { const Args* a; DI const float* operator[](int i) const { asm volatile("" : "+s"(i)); return (const float*)(const GAS float*)a->in[i]; } };
DI unsigned char* opaque_ws(const Args& args) { const unsigned long long w0_ = (unsigned long long)args.ws; unsigned wl_ = __builtin_amdgcn_readfirstlane((unsigned)w0_), wh_ = __builtin_amdgcn_readfirstlane((unsigned)(w0_ >> 32)); asm volatile("" : "+s"(wl_), "+s"(wh_)); return (unsigned char*)(GAS unsigned char*)(((unsigned long long)wh_ << 32) | wl_); }
DI int lane_id() { int l; asm volatile("v_mbcnt_lo_u32_b32 %0, -1, 0\n\tv_mbcnt_hi_u32_b32 %0, -1, %0" : "=v"(l)); return l; }
DI Ctx make_ctx(const Args& args, LAS unsigned char* lds, int wave_s) {
    Ctx F; int tid = wave_s * 64 + lane_id(); asm volatile("" : "+v"(tid));
    const unsigned long long w0_ = (unsigned long long)args.ws; unsigned wl_ = __builtin_amdgcn_readfirstlane((unsigned)w0_), wh_ = __builtin_amdgcn_readfirstlane((unsigned)(w0_ >> 32)); asm volatile("" : "+s"(wl_), "+s"(wh_)); const unsigned long long w = ((unsigned long long)wh_ << 32) | wl_;
    int bid = __builtin_amdgcn_readfirstlane((int)blockIdx.x), G = __builtin_amdgcn_readfirstlane((int)gridDim.x); asm volatile("" : "+s"(bid), "+s"(G));
    F.lds = lds; F.ws = (unsigned char*)(GAS unsigned char*)w; F.tid = tid; F.lane = tid & 63; F.wave = __builtin_amdgcn_readfirstlane(tid >> 6);
    F.G = G; F.bid = bid; F.gw = bid * NWAVES + F.wave; F.NGW = G * NWAVES; return F;
}

DI void tr_item(const float* W, int ldn, int K, const float* gain, float scale, bf16* WT, int drow, int nvalid, int k0, LAS float* scr, int lane) {
#pragma unroll 8
    for (int i = 0; i < 32; ++i) { const int kk = 2 * i + (lane >> 5), c = lane & 31; float v = 0.f;
        if (c < nvalid) { v = W[(size_t)(k0 + kk) * ldn + c]; if (gain) v *= gain[k0 + kk]; v *= scale; }
        scr[kk * 33 + c] = v; }
    LDS_WAIT(); asm volatile("" ::: "memory");
    const int c8 = lane & 7;
#pragma unroll
    for (int j = 0; j < 4; ++j) { const int n = (lane >> 3) + 8 * j; const LAS float* s = scr + (8 * c8) * 33 + n;
        v4u o; o.x = pk2(s[0 * 33], s[1 * 33]); o.y = pk2(s[2 * 33], s[3 * 33]); o.z = pk2(s[4 * 33], s[5 * 33]); o.w = pk2(s[6 * 33], s[7 * 33]);
        *(v4u*)(WT + (size_t)(drow + n) * K + k0 + 8 * c8) = o; }
    LDS_WAIT(); asm volatile("" ::: "memory");
}
DI void conv_seg(const Ctx& F, const float* W, int ldn, int K, int ncols, int nsrc, const float* gain, float scale, bf16* WT, int dst0, int kind, int& base, LAS float* scr) {
    const int nblk = (ncols + 31) / 32, nitems = (K / 64) * nblk;
    const int start = (F.gw - base % F.NGW + F.NGW) % F.NGW;
    for (int it = start; it < nitems; it += F.NGW) {
        const int kb = it / nblk, nb = it - kb * nblk, n0 = nb * 32; int nvalid = nsrc - n0; nvalid = nvalid < 0 ? 0 : (nvalid > 32 ? 32 : nvalid);
        const int drow = kind ? (256 * (n0 >> 7) + dst0 + (n0 & 127)) : (dst0 + n0);
        tr_item(W + n0, ldn, K, gain, scale, WT, drow, nvalid, kb * 64, scr, F.lane);
    }
    base += nitems;
}
DI void phase_conv(const Ctx& F, const InTab in, int l) {
    LAS float* scr = (LAS float*)(F.lds + F.wave * 16384);
    unsigned char* ws = F.ws; int base = 0;
    const float* ng = in[2] + (size_t)l * 8 * D;
    conv_seg(F, in[3] + (size_t)l * D * FF, FF, D, FF, FF, ng + 0 * D, 1.f, (bf16*)(ws + WS_WGU1), 0, 1, base, scr);
    conv_seg(F, in[4] + (size_t)l * D * FF, FF, D, FF, FF, ng + 0 * D, 1.f, (bf16*)(ws + WS_WGU1), 128, 1, base, scr);
    conv_seg(F, in[5] + (size_t)l * FF * D, D, FF, D, D, nullptr, 1.f, (bf16*)(ws + WS_WD1), 0, 0, base, scr);
    { const float* W = in[6] + (size_t)l * D * NIN; bf16* WT = (bf16*)(ws + WS_WIN); const float* g2 = ng + 2 * D;
      conv_seg(F, W + 0, NIN, D, 3360, 3360, g2, 1.f, WT, 0, 0, base, scr);
      conv_seg(F, W + 3360, NIN, D, 2400, 2384, g2, 1.f, WT, ZDQ, 0, base, scr);
      conv_seg(F, W + 5744, NIN, D, 3104, 3080, g2, 1.f, WT, ZMQ, 0, base, scr);
      conv_seg(F, W + 8824, NIN, D, 6144, 6144, g2, 1.f, WT, ZG, 0, base, scr);
      conv_seg(F, W, NIN, D, 96, 0, g2, 1.f, WT, 15008, 0, base, scr); }
    for (int b = 0; b < 3; ++b) conv_seg(F, in[27] + ((size_t)l * 3 + b) * 1024 * D, D, 1024, D, D, nullptr, 1.f, (bf16*)(ws + WS_WBR) + (size_t)b * D * 1024, 0, 0, base, scr);
    conv_seg(F, in[28] + (size_t)l * D * D, D, D, D, D, nullptr, 1.f, (bf16*)(ws + WS_WOUT), 0, 0, base, scr);
    conv_seg(F, in[29] + (size_t)l * D * FF, FF, D, FF, FF, ng + 4 * D, 1.f, (bf16*)(ws + WS_WGU2), 0, 1, base, scr);
    conv_seg(F, in[30] + (size_t)l * D * FF, FF, D, FF, FF, ng + 4 * D, 1.f, (bf16*)(ws + WS_WGU2), 128, 1, base, scr);
    conv_seg(F, in[31] + (size_t)l * FF * D, D, FF, D, D, nullptr, 1.f, (bf16*)(ws + WS_WD2), 0, 0, base, scr);
    conv_seg(F, in[33] + (size_t)l * D * D, D, D, D, D, ng + 6 * D, 1.f, (bf16*)(ws + WS_WPG), 0, 0, base, scr);
    conv_seg(F, in[32] + (size_t)l * PLE * D, D, PLE, D, D, nullptr, 1.f, (bf16*)(ws + WS_WPP), 0, 0, base, scr);
    conv_seg(F, in[9] + (size_t)l * 64 * 1024, 1024, 64, 1024, 1024, nullptr, 1.f, (bf16*)(ws + WS_WLW), 0, 0, base, scr);
    conv_seg(F, in[11] + (size_t)l * 64 * 1024, 1024, 64, 1024, 1024, nullptr, 1.f, (bf16*)(ws + WS_WLA), 0, 0, base, scr);
    for (int h = 0; h < 8; ++h) conv_seg(F, in[20] + ((size_t)l * 8 + h) * 128 * 256, 256, 128, 256, 256, nullptr, 0.08838834764831845f, (bf16*)(ws + WS_WUK) + (size_t)h * 256 * 128, 0, 0, base, scr);
    for (int h = 0; h < 8; ++h) conv_seg(F, in[21] + ((size_t)l * 8 + h) * 256 * 128, 128, 256, 128, 128, nullptr, 1.f, (bf16*)(ws + WS_WUV) + (size_t)h * 128 * 256, 0, 0, base, scr);
    { const float* W = in[12] + (size_t)l * 160 * 1024; bf16* WT = (bf16*)(ws + WS_WLG);
      for (int i = F.bid * NTHR + F.tid; i < 1024 * 160; i += F.G * NTHR) { const int n = i / 160, k = i - n * 160; WT[i] = (bf16)f2bf(W[(size_t)k * 1024 + n]); } }
    { const f32x4* P = (const f32x4*)(in[1] + (size_t)l * T * PLE); v2u* PB = (v2u*)(ws + WS_PB);
      for (int i = F.bid * NTHR + F.tid; i < T * PLE / 4; i += F.G * NTHR) { const f32x4 v = P[i]; v2u o; o.x = pk2(v[0], v[1]); o.y = pk2(v[2], v[3]); PB[i] = o; } }
}

template <bool INIT>
DI void phase_resid(const Ctx& F, const float* src, const float* gain, float alpha, float* h) {
    bf16* hb = (bf16*)(F.ws + WS_HB); float* rs = (float*)(F.ws + WS_RS);
    f32x4 g[8];
    if (!INIT) {
#pragma unroll
        for (int j = 0; j < 8; ++j) g[j] = *(const f32x4*)(gain + 4 * F.lane + 256 * j);
    }
    for (int m = F.gw; m < T; m += F.NGW) {
        const f32x4* sr = (const f32x4*)(src + (size_t)m * D) + F.lane; f32x4* hr = (f32x4*)(h + (size_t)m * D) + F.lane;
        v2u* ob = (v2u*)(hb + (size_t)m * D) + F.lane;
        f32x4 v[8]; float fs = 0.f;
#pragma unroll
        for (int j = 0; j < 8; ++j) { v[j] = sr[64 * j]; fs += (v[j][0] * v[j][0] + v[j][1] * v[j][1]) + (v[j][2] * v[j][2] + v[j][3] * v[j][3]); }
        float rinv = 0.f; if (!INIT) rinv = alpha * __builtin_amdgcn_rsqf(wave_sum(fs) * (1.0f / D) + EPS);
        float s2 = 0.f;
#pragma unroll
        for (int j = 0; j < 8; ++j) {
            f32x4 x = v[j];
            if (!INIT) x = hr[64 * j] + x * rinv * g[j];
            hr[64 * j] = x; v2u o; o.x = pk2(x[0], x[1]); o.y = pk2(x[2], x[3]); ob[64 * j] = o;
            s2 += (x[0] * x[0] + x[1] * x[1]) + (x[2] * x[2] + x[3] * x[3]);
        }
        s2 = wave_sum(s2);
        if (F.lane == 0) rs[m] = s2;
    }
}

DI void wave_gemm32_bf16(const bf16* A, int lda, const bf16* Bt, int ldb, int K, bf16* O, int ldo, int lane) {
    const int r = lane & 15, q = lane >> 4;
    f32x4 acc[2][2];
#pragma unroll
    for (int i = 0; i < 2; ++i)
#pragma unroll
        for (int j = 0; j < 2; ++j) acc[i][j] = (f32x4){0.f, 0.f, 0.f, 0.f};
    for (int k0 = 0; k0 < K; k0 += 32) {
        bf16x8 a[2], b[2];
#pragma unroll
        for (int i = 0; i < 2; ++i) { a[i] = *(const bf16x8*)(A + (size_t)(16 * i + r) * lda + k0 + 8 * q); b[i] = *(const bf16x8*)(Bt + (size_t)(16 * i + r) * ldb + k0 + 8 * q); }
#pragma unroll
        for (int i = 0; i < 2; ++i)
#pragma unroll
            for (int j = 0; j < 2; ++j) acc[i][j] = MFMA16(b[j], a[i], acc[i][j]);
    }
#pragma unroll
    for (int i = 0; i < 2; ++i)
#pragma unroll
        for (int j = 0; j < 2; ++j) { v2u w; w.x = pk2(acc[i][j][0], acc[i][j][1]); w.y = pk2(acc[i][j][2], acc[i][j][3]); *(v2u*)(O + (size_t)(16 * i + r) * ldo + 16 * j + 4 * q) = w; }
}
DI float* rwbuf(const Ctx& F, int i) { return (float*)(F.ws + WS_RW + (size_t)i * RW_STRIDE); }
enum { RW_R = 0, RW_W = 1, RW_K = 2, RW_V = 3, RW_AA = 4, RW_BB = 5, RW_G = 6, RW_Y = 7 };
DI f32x4 shift4(const bf16* Z, int t, int col, const float* mu) {
    const v2u c = *(const v2u*)(Z + (size_t)t * NZ + col); v2u p = (v2u){0u, 0u}; if (t > 0) p = *(const v2u*)(Z + (size_t)(t - 1) * NZ + col);
    const f32x4 m = *(const f32x4*)(mu + col);
    f32x4 cv = (f32x4){bflo(c.x), bfhi(c.x), bflo(c.y), bfhi(c.y)}, pv = (f32x4){bflo(p.x), bfhi(p.x), bflo(p.y), bfhi(p.y)};
    return cv + (pv - cv) * m;
}
DI void phase_rw_prep(const Ctx& F, const InTab in, int l) {
    const bf16* Z = (const bf16*)(F.ws + WS_Z);
    const float* mu = in[7] + (size_t)l * 3360; const float* w0 = in[8] + (size_t)l * 1024; const float* a0 = in[10] + (size_t)l * 1024;
    const float* k_k = in[13] + (size_t)l * 1024; const float* k_a = in[14] + (size_t)l * 1024;
    const bf16* WLW = (const bf16*)(F.ws + WS_WLW); const bf16* WLA = (const bf16*)(F.ws + WS_WLA); const bf16* WLG = (const bf16*)(F.ws + WS_WLG);
    float* R = rwbuf(F, RW_R); float* W = rwbuf(F, RW_W); float* K2 = rwbuf(F, RW_K); float* V = rwbuf(F, RW_V); float* AA = rwbuf(F, RW_AA); float* BB = rwbuf(F, RW_BB); float* G = rwbuf(F, RW_G);
    LAS bf16* As = (LAS bf16*)F.lds;
    const int r = F.lane & 15, q = F.lane >> 4;
    for (int tile = F.bid; tile < T / 16; tile += F.G) {
        const int t0 = tile * 16;
        for (int i = F.tid; i < 16 * 288; i += NTHR) { const int row = i / 288, c = i - row * 288, t = t0 + row, zc = ZWD + c;
            const float cur = bf2f(Z[(size_t)t * NZ + zc]); const float prev = t > 0 ? bf2f(Z[(size_t)(t - 1) * NZ + zc]) : 0.f;
            const float zs = cur + (prev - cur) * mu[zc];
            const float val = c < 64 ? ftanh(zs) : (c < 128 ? zs : sigmoidf_(zs));
            As[row * 296 + c] = (bf16)f2bf(val); }
        __syncthreads();
        bf16x8 aw[2], aa[2], ag[5];
#pragma unroll
        for (int s = 0; s < 2; ++s) { aw[s] = *(const LAS bf16x8*)(As + r * 296 + 32 * s + 8 * q); aa[s] = *(const LAS bf16x8*)(As + r * 296 + 64 + 32 * s + 8 * q); }
#pragma unroll
        for (int s = 0; s < 5; ++s) ag[s] = *(const LAS bf16x8*)(As + r * 296 + 128 + 32 * s + 8 * q);
        const int t = t0 + r;
#pragma unroll 1
        for (int hh = 0; hh < 2; ++hh) {
            f32x4 kraw[4], av[4]; float ssq = 0.f;
#pragma unroll
            for (int ct = 0; ct < 4; ++ct) {
                const int n0 = F.wave * 128 + hh * 64 + ct * 16, n = n0 + 4 * q;
                f32x4 cw = (f32x4){0.f, 0.f, 0.f, 0.f}, ca = cw, cg = cw;
#pragma unroll
                for (int s = 0; s < 2; ++s) { cw = MFMA16(*(const bf16x8*)(WLW + (size_t)(n0 + r) * 64 + 32 * s + 8 * q), aw[s], cw); ca = MFMA16(*(const bf16x8*)(WLA + (size_t)(n0 + r) * 64 + 32 * s + 8 * q), aa[s], ca); }
#pragma unroll
                for (int s = 0; s < 5; ++s) cg = MFMA16(*(const bf16x8*)(WLG + (size_t)(n0 + r) * 160 + 32 * s + 8 * q), ag[s], cg);
                const f32x4 w0v = *(const f32x4*)(w0 + n), a0v = *(const f32x4*)(a0 + n), kkv = *(const f32x4*)(k_k + n), kav = *(const f32x4*)(k_a + n);
                const f32x4 rs_ = shift4(Z, t, ZR + n, mu), ks_ = shift4(Z, t, ZK + n, mu), vs_ = shift4(Z, t, ZV + n, mu);
                f32x4 dec, a, k2;
#pragma unroll
                for (int j = 0; j < 4; ++j) { const float wl = w0v[j] + cw[j]; const float ls = flog_sigmoid(wl);
                    dec[j] = fexp(-fexp(ls - 0.5f)); a[j] = sigmoidf_(a0v[j] + ca[j]); k2[j] = ks_[j] * (1.0f + (a[j] - 1.0f) * kav[j]); }
                kraw[ct] = ks_ * kkv; av[ct] = a; ssq += (kraw[ct][0] * kraw[ct][0] + kraw[ct][1] * kraw[ct][1]) + (kraw[ct][2] * kraw[ct][2] + kraw[ct][3] * kraw[ct][3]);
                const size_t o = (size_t)t * 1024 + n;
                *(f32x4*)(R + o) = rs_; *(f32x4*)(W + o) = dec; *(f32x4*)(K2 + o) = k2; *(f32x4*)(V + o) = vs_; *(f32x4*)(G + o) = cg;
            }
            ssq += __shfl_xor(ssq, 16); ssq += __shfl_xor(ssq, 32);
            const float inv = fminf(__builtin_amdgcn_rsqf(ssq), 1e12f);
#pragma unroll
            for (int ct = 0; ct < 4; ++ct) { const size_t o = (size_t)t * 1024 + F.wave * 128 + hh * 64 + ct * 16 + 4 * q; const f32x4 kk = kraw[ct] * inv;
                *(f32x4*)(AA + o) = -kk; *(f32x4*)(BB + o) = kk * av[ct]; }
        }
        __syncthreads();
    }
}
DI void lds_read8(unsigned addr, f32x4 (&d)[8]) {
    asm volatile("ds_read_b128 %0, %8\n\tds_read_b128 %1, %8 offset:16\n\tds_read_b128 %2, %8 offset:32\n\tds_read_b128 %3, %8 offset:48\n\t"
                 "ds_read_b128 %4, %8 offset:64\n\tds_read_b128 %5, %8 offset:80\n\tds_read_b128 %6, %8 offset:96\n\tds_read_b128 %7, %8 offset:112\n\ts_waitcnt lgkmcnt(0)"
                 : "=&v"(d[0]), "=&v"(d[1]), "=&v"(d[2]), "=&v"(d[3]), "=&v"(d[4]), "=&v"(d[5]), "=&v"(d[6]), "=&v"(d[7]) : "v"(addr) : "memory");
}
DI void lds_read4x1(unsigned addr, f32x4& w, f32x4& b, f32x4& k, f32x4& r) {
    asm volatile("ds_read_b128 %0, %4\n\tds_read_b128 %1, %4 offset:256\n\tds_read_b128 %2, %4 offset:512\n\tds_read_b128 %3, %4 offset:768\n\ts_waitcnt lgkmcnt(0)"
                 : "=&v"(w), "=&v"(b), "=&v"(k), "=&v"(r) : "v"(addr) : "memory");
}
DI void phase_rw_local(const Ctx& F) {
    const float* AA = rwbuf(F, RW_AA); const float* W = rwbuf(F, RW_W); const float* BB = rwbuf(F, RW_BB); const float* K2 = rwbuf(F, RW_K); const float* R = rwbuf(F, RW_R); const float* V = rwbuf(F, RW_V);
    float* YL = rwbuf(F, RW_Y); float* QT = rwbuf(F, 8);
    bf16* MTb = (bf16*)(F.ws + WS_ACT); float* GTt = (float*)(F.ws + WS_ACT + 32 * MiB);
    LAS unsigned char* buf = F.lds + F.wave * 12288;
    const unsigned bufa = (unsigned)(size_t)buf;
    const int lane = F.lane;
    for (int unit = F.gw; unit < 2048; unit += F.NGW) {
        const int c = unit >> 4, h = unit & 15; const unsigned ob0 = (unsigned)(((c * 64) * 1024 + h * 64 + lane) * 4);
        float Sr[64], Si[64];
#pragma unroll
        for (int k = 0; k < 64; ++k) { Sr[k] = 0.f; Si[k] = (k == lane) ? 1.f : 0.f; }
#define RW_DMA(sub_, pb_) do { _Pragma("unroll") for (int s_ = 0; s_ < 4; ++s_) { const unsigned o_ = ob0 + (unsigned)((4 * (sub_) + s_) * 4096); LAS unsigned* lp_ = (LAS unsigned*)(buf + (pb_) * 6144 + s_ * 1536); \
            __builtin_amdgcn_global_load_lds((const unsigned*)((const char*)AA + o_), lp_, 4, 0, 0); __builtin_amdgcn_global_load_lds((const unsigned*)((const char*)W + o_), lp_ + 64, 4, 0, 0); __builtin_amdgcn_global_load_lds((const unsigned*)((const char*)BB + o_), lp_ + 128, 4, 0, 0); \
            __builtin_amdgcn_global_load_lds((const unsigned*)((const char*)K2 + o_), lp_ + 192, 4, 0, 0); __builtin_amdgcn_global_load_lds((const unsigned*)((const char*)R + o_), lp_ + 256, 4, 0, 0); __builtin_amdgcn_global_load_lds((const unsigned*)((const char*)V + o_), lp_ + 320, 4, 0, 0); } } while (0)
        RW_DMA(0, 0);
#pragma unroll 1
        for (int sub = 0; sub < 16; ++sub) {
            const int pb = sub & 1;
            asm volatile("s_waitcnt vmcnt(0)" ::: "memory");
            if (sub < 15) RW_DMA(sub + 1, pb ^ 1);
#pragma unroll 1
            for (int s = 0; s < 4; ++s) {
                const unsigned sa_ = bufa + (unsigned)(pb * 6144 + s * 1536);
                const float v = *(const LAS float*)(buf + pb * 6144 + s * 1536 + 1280 + 4 * lane);
                float sar0 = 0.f, sar1 = 0.f, sai0 = 0.f, sai1 = 0.f;
#pragma unroll
                for (int qd = 0; qd < 4; ++qd) { f32x4 d[4];
                    asm volatile("ds_read_b128 %0, %4\n\tds_read_b128 %1, %4 offset:16\n\tds_read_b128 %2, %4 offset:32\n\tds_read_b128 %3, %4 offset:48\n\ts_waitcnt lgkmcnt(0)"
                                 : "=&v"(d[0]), "=&v"(d[1]), "=&v"(d[2]), "=&v"(d[3]) : "v"(sa_ + (unsigned)(qd * 64)) : "memory");
#pragma unroll
                    for (int k4 = 0; k4 < 4; ++k4) { const int k = 16 * qd + 4 * k4; sar0 = fmaf(Sr[k], d[k4][0], sar0); sar1 = fmaf(Sr[k + 1], d[k4][1], sar1); sar0 = fmaf(Sr[k + 2], d[k4][2], sar0); sar1 = fmaf(Sr[k + 3], d[k4][3], sar1);
                        sai0 = fmaf(Si[k], d[k4][0], sai0); sai1 = fmaf(Si[k + 1], d[k4][1], sai1); sai0 = fmaf(Si[k + 2], d[k4][2], sai0); sai1 = fmaf(Si[k + 3], d[k4][3], sai1); } }
                const float sar = sar0 + sar1, sai = sai0 + sai1;
                float yr0 = 0.f, yi0 = 0.f;
#pragma unroll
                for (int g = 0; g < 16; ++g) {
                    f32x4 w4, b4, k4_, r4; lds_read4x1(sa_ + 256u + (unsigned)(g * 16), w4, b4, k4_, r4);
#pragma unroll
                    for (int j = 0; j < 4; ++j) { const int k = 4 * g + j;
                        float x = Sr[k] * w4[j]; x = fmaf(sar, b4[j], x); x = fmaf(v, k4_[j], x); Sr[k] = x;
                        float z = Si[k] * w4[j]; z = fmaf(sai, b4[j], z); Si[k] = z;
                        yr0 = fmaf(x, r4[j], yr0); yi0 = fmaf(z, r4[j], yi0); }
                }
                const unsigned o = ob0 + (unsigned)((4 * sub + s) * 4096);
                *(float*)((char*)YL + o) = yr0; *(float*)((char*)QT + o) = yi0;
            }
        }
#undef RW_DMA
        int lane2 = lane; asm volatile("" : "+v"(lane2));
        bf16* mp = MTb + (size_t)unit * 4096 + lane2; float* gp = GTt + (size_t)unit * 4096 + lane2;
#pragma unroll
        for (int k = 0; k < 64; ++k) { mp[k * 64] = (bf16)f2bf(Si[k]); gp[k * 64] = Sr[k]; }
        asm volatile("s_waitcnt vmcnt(0)" ::: "memory");
    }
}
DI void phase_rw_combine(const Ctx& F, int cw) {
    const bf16* MTb = (const bf16*)(F.ws + WS_ACT); const float* GTt = (const float*)(F.ws + WS_ACT + 32 * MiB); bf16* SCb = (bf16*)(F.ws + WS_F);
    const int h = cw >> 2, i0 = (cw & 3) * 16, lane = F.lane, r = lane & 15, q = lane >> 4;
    f32x4 X[4];
#pragma unroll
    for (int kt = 0; kt < 4; ++kt) X[kt] = (f32x4){0.f, 0.f, 0.f, 0.f};
    f32x4 gq[4]; v4u af[4][2];
#define RWC_LOAD(unit_) do { const bf16* mrow_ = MTb + (size_t)(unit_) * 4096 + 4 * q; const float* gcol_ = GTt + (size_t)(unit_) * 4096 + i0 + r; \
        _Pragma("unroll") for (int kt = 0; kt < 4; ++kt) { _Pragma("unroll") for (int e = 0; e < 4; ++e) gq[kt][e] = gcol_[(size_t)(16 * kt + 4 * q + e) * 64]; \
            _Pragma("unroll") for (int ks = 0; ks < 2; ++ks) { const bf16* ap_ = mrow_ + (size_t)(16 * kt + r) * 64 + 32 * ks; const v2u lo_ = *(const v2u*)ap_, hi_ = *(const v2u*)(ap_ + 16); af[kt][ks] = (v4u){lo_.x, lo_.y, hi_.x, hi_.y}; } } } while (0)
    RWC_LOAD(h);
#pragma unroll 1
    for (int c = 0; c < 128; ++c) {
        const int unit = c * 16 + h;
        bf16* sp = SCb + (size_t)unit * 4096 + (size_t)(i0 + r) * 64 + 4 * q;
        bf16x8 Bf[2];
        { v4u b0, b1;
          b0.x = pk2(X[0][0], X[0][1]); b0.y = pk2(X[0][2], X[0][3]); b0.z = pk2(X[1][0], X[1][1]); b0.w = pk2(X[1][2], X[1][3]);
          b1.x = pk2(X[2][0], X[2][1]); b1.y = pk2(X[2][2], X[2][3]); b1.z = pk2(X[3][0], X[3][1]); b1.w = pk2(X[3][2], X[3][3]);
          *(v2u*)(sp + 0) = (v2u){b0.x, b0.y}; *(v2u*)(sp + 16) = (v2u){b0.z, b0.w}; *(v2u*)(sp + 32) = (v2u){b1.x, b1.y}; *(v2u*)(sp + 48) = (v2u){b1.z, b1.w};
          Bf[0] = __builtin_bit_cast(bf16x8, b0); Bf[1] = __builtin_bit_cast(bf16x8, b1); }
        if (c == 127) break;
        f32x4 gc[4]; v4u ac[4][2];
#pragma unroll
        for (int kt = 0; kt < 4; ++kt) { gc[kt] = gq[kt]; ac[kt][0] = af[kt][0]; ac[kt][1] = af[kt][1]; }
        if (c < 126) RWC_LOAD(unit + 16);
#pragma unroll
        for (int kt = 0; kt < 4; ++kt) {
            f32x4 acc = gc[kt];
#pragma unroll
            for (int ks = 0; ks < 2; ++ks) acc = MFMA16(__builtin_bit_cast(bf16x8, ac[kt][ks]), Bf[ks], acc);
            X[kt] = acc;
        }
    }
#undef RWC_LOAD
}
DI void phase_rw_out(const Ctx& F, const InTab in, int l) {
    const float* YL = rwbuf(F, RW_Y); const float* QT = rwbuf(F, 8); const float* R = rwbuf(F, RW_R); const float* K2 = rwbuf(F, RW_K); const float* V = rwbuf(F, RW_V); const float* G = rwbuf(F, RW_G);
    const bf16* SCb = (const bf16*)(F.ws + WS_F);
    const float* r_k = in[15] + (size_t)l * 1024; const float* lg = in[16] + (size_t)l * 1024; const float* lb = in[17] + (size_t)l * 1024;
    bf16* YO = (bf16*)(F.ws + WS_Y);
    const int lane = F.lane, r = lane & 15, q = lane >> 4;
    for (int unit = F.gw; unit < 2048; unit += F.NGW) {
        const int c = unit >> 4, h = unit & 15, t0 = c * 64;
        bf16x8 Sf[4][2];
#pragma unroll
        for (int it = 0; it < 4; ++it)
#pragma unroll
            for (int ks = 0; ks < 2; ++ks) Sf[it][ks] = *(const bf16x8*)(SCb + (size_t)unit * 4096 + (size_t)(16 * it + r) * 64 + 32 * ks + 8 * q);
#pragma unroll 1
        for (int tt = 0; tt < 4; ++tt) {
            const int t = t0 + 16 * tt + r; const size_t ob = (size_t)t * 1024 + h * 64;
            bf16x8 Af[2];
#pragma unroll
            for (int ks = 0; ks < 2; ++ks) { const f32x4 x0 = *(const f32x4*)(QT + ob + 32 * ks + 8 * q), x1 = *(const f32x4*)(QT + ob + 32 * ks + 8 * q + 4);
                v4u o; o.x = pk2(x0[0], x0[1]); o.y = pk2(x0[2], x0[3]); o.z = pk2(x1[0], x1[1]); o.w = pk2(x1[2], x1[3]); Af[ks] = __builtin_bit_cast(bf16x8, o); }
            f32x4 y[4], rr[4], kk[4], vv[4]; float s = 0.f, bs = 0.f;
#pragma unroll
            for (int it = 0; it < 4; ++it) { const size_t o = ob + 16 * it + 4 * q;
                f32x4 acc = *(const f32x4*)(YL + o);
#pragma unroll
                for (int ks = 0; ks < 2; ++ks) acc = MFMA16(Sf[it][ks], Af[ks], acc);
                y[it] = acc; rr[it] = *(const f32x4*)(R + o); kk[it] = *(const f32x4*)(K2 + o); vv[it] = *(const f32x4*)(V + o);
                const f32x4 rk = *(const f32x4*)(r_k + h * 64 + 16 * it + 4 * q);
#pragma unroll
                for (int e = 0; e < 4; ++e) { s += acc[e]; bs += rr[it][e] * kk[it][e] * rk[e]; } }
            s += __shfl_xor(s, 16); s += __shfl_xor(s, 32); bs += __shfl_xor(bs, 16); bs += __shfl_xor(bs, 32);
            const float mean = s * (1.0f / 64.0f); float q2 = 0.f;
#pragma unroll
            for (int it = 0; it < 4; ++it)
#pragma unroll
                for (int e = 0; e < 4; ++e) { const float d = y[it][e] - mean; q2 += d * d; }
            q2 += __shfl_xor(q2, 16); q2 += __shfl_xor(q2, 32);
            const float rstd = __builtin_amdgcn_rsqf(q2 * (1.0f / 64.0f) + 64e-5f);
#pragma unroll
            for (int it = 0; it < 4; ++it) { const int ch = h * 64 + 16 * it + 4 * q; const f32x4 g4 = *(const f32x4*)(lg + ch), b4 = *(const f32x4*)(lb + ch), gg = *(const f32x4*)(G + (size_t)t * 1024 + ch); float ov[4];
#pragma unroll
                for (int e = 0; e < 4; ++e) ov[e] = (((y[it][e] - mean) * rstd) * g4[e] + b4[e] + bs * vv[it][e]) * gg[e];
                v2u w; w.x = pk2(ov[0], ov[1]); w.y = pk2(ov[2], ov[3]); *(v2u*)(YO + (size_t)t * 1024 + ch) = w; }
        }
    }
}
DI void phase_dsa_prep(const Ctx& F, const InTab in, int l) {
    const bf16* Z = (const bf16*)(F.ws + WS_Z); bf16* DC = (bf16*)(F.ws + WS_DC); bf16* DKI = (bf16*)(F.ws + WS_DKI); float* DWI = (float*)(F.ws + WS_DWI);
    const float* cg = in[18] + (size_t)l * 256; const float* kg = in[19] + (size_t)l * 64;
    const f32x4 cg4 = *(const f32x4*)(cg + 4 * F.lane); const float kg1 = kg[F.lane];
    for (int t = F.gw; t < T; t += F.NGW) {
        const v2u c = *(const v2u*)(Z + (size_t)t * NZ + ZCKV + 4 * F.lane);
        f32x4 cv = (f32x4){bflo(c.x), bfhi(c.x), bflo(c.y), bfhi(c.y)};
        const float ss = wave_sum((cv[0] * cv[0] + cv[1] * cv[1]) + (cv[2] * cv[2] + cv[3] * cv[3]));
        cv = cv * __builtin_amdgcn_rsqf(ss * (1.0f / 256.0f) + EPS) * cg4;
        v2u o; o.x = pk2(cv[0], cv[1]); o.y = pk2(cv[2], cv[3]); *(v2u*)(DC + (size_t)t * 256 + 4 * F.lane) = o;
        const float kv = bf2f(Z[(size_t)t * NZ + ZKI + F.lane]);
        const float ks = wave_sum(kv * kv);
        DKI[(size_t)t * 64 + F.lane] = (bf16)f2bf(kv * __builtin_amdgcn_rsqf(ks * (1.0f / 64.0f) + EPS) * kg1);
        if (F.lane < 16) DWI[(size_t)t * 16 + F.lane] = bf2f(Z[(size_t)t * NZ + ZWI + F.lane]) * (1.0f / 32.0f);
    }
    const bf16* WUK = (const bf16*)(F.ws + WS_WUK); bf16* DQL = (bf16*)(F.ws + WS_DQL);
    for (int it = F.gw; it < 256 * 8; it += F.NGW) { const int mt = it >> 3, h = it & 7;
#pragma unroll 1
        for (int nt = 0; nt < 8; ++nt)
            wave_gemm32_bf16(Z + (size_t)(mt * 32) * NZ + ZDQ + h * 128, NZ, WUK + (size_t)h * 256 * 128 + (size_t)(nt * 32) * 128, 128, 128, DQL + (size_t)(mt * 32) * 2048 + h * 256 + nt * 32, 2048, F.lane); }
}
DI void phase_dsa_index(const Ctx& F, int wi, int nw) {
    const bf16* Z = (const bf16*)(F.ws + WS_Z); const bf16* DKI = (const bf16*)(F.ws + WS_DKI); const float* DWI = (const float*)(F.ws + WS_DWI); float* DSC = (float*)(F.ws + WS_DSC);
    const int r = F.lane & 31, hh = F.lane >> 5;
    for (int task = wi; task < 4608; task += nw) {
        int c = 0, rem = task; while (rem >= 1024 - 128 * c) { rem -= 1024 - 128 * c; ++c; }
        const int g = 128 * c + rem, t0 = 8 * g, kstart = 1024 * c; int kend = kstart + 1024; if (kend > t0 + 8) kend = t0 + 8;
        const int nblk = (kend - kstart + 31) >> 5;
        bf16x8 A[4][4]; float wv[4][2][8];
#pragma unroll
        for (int rb = 0; rb < 4; ++rb) { const int tok = t0 + 2 * rb + (r >> 4), head = r & 15;
#pragma unroll
            for (int s = 0; s < 4; ++s) A[rb][s] = *(const bf16x8*)(Z + (size_t)tok * NZ + ZQI + head * 64 + 16 * s + 8 * hh);
#pragma unroll
            for (int tk = 0; tk < 2; ++tk)
#pragma unroll
                for (int i = 0; i < 8; ++i) wv[rb][tk][i] = DWI[(size_t)(t0 + 2 * rb + tk) * 16 + (i & 3) + 8 * (i >> 2) + 4 * hh]; }
#pragma unroll 1
        for (int kb = 0; kb < nblk; ++kb) {
            const int s0 = kstart + 32 * kb;
            bf16x8 B[4];
#pragma unroll
            for (int s = 0; s < 4; ++s) B[s] = *(const bf16x8*)(DKI + (size_t)(s0 + r) * 64 + 16 * s + 8 * hh);
#pragma unroll
            for (int rb = 0; rb < 4; ++rb) {
                f32x16 x;
#pragma unroll
                for (int i = 0; i < 16; ++i) x[i] = 0.f;
#pragma unroll
                for (int s = 0; s < 4; ++s) x = MFMA32(A[rb][s], B[s], x);
                float p0 = 0.f, p1 = 0.f;
#pragma unroll
                for (int i = 0; i < 8; ++i) { p0 = fmaf(wv[rb][0][i], fmaxf(x[i], 0.f), p0); p1 = fmaf(wv[rb][1][i], fmaxf(x[8 + i], 0.f), p1); }
                p0 += __shfl_xor(p0, 32); p1 += __shfl_xor(p1, 32);
                DSC[(size_t)(t0 + 2 * rb + hh) * T + s0 + r] = hh ? p1 : p0;
            }
        }
    }
}
DI unsigned fkey(float f) { const unsigned u = __float_as_uint(f); return (u & 0x80000000u) ? ~u : (u | 0x80000000u); }
DI void phase_dsa_topk(const Ctx& F) {
    const float* DSC = (const float*)(F.ws + WS_DSC); int* IDX = (int*)(F.ws + WS_DIDX);
    LAS unsigned* hist = (LAS unsigned*)(F.lds + F.wave * 8192);
    const int lane = F.lane;
    for (int t = F.gw; t < T; t += F.NGW) {
        const int n = t + 1; int* out = IDX + (size_t)t * 256; const float* row = DSC + (size_t)t * T + lane;
        if (n <= 256) { for (int i = lane; i < 256; i += 64) out[i] = i < n ? i : -1; continue; }
        const int nreg = (n + 63) >> 6;
        unsigned key[128];
#pragma unroll
        for (int g = 0; g < 8; ++g) {
            if (16 * g < nreg) {
#pragma unroll
                for (int j = 0; j < 16; ++j) { const int i = 16 * g + j; key[i] = (64 * i + lane < n) ? fkey(row[64 * i]) : 0u; }
            } else {
#pragma unroll
                for (int j = 0; j < 16; ++j) key[16 * g + j] = 0u;
            }
        }
        unsigned prefix = 0u, mask = 0u; int need = 256;
#pragma unroll
        for (int pass = 0; pass < 3; ++pass) {
            const int shift = pass == 0 ? 21 : (pass == 1 ? 10 : 0); const unsigned bm = pass == 2 ? 1023u : 2047u;
#pragma unroll
            for (int j = 0; j < 8; ++j) *(LAS v4u*)(hist + 4 * lane + 256 * j) = (v4u){0u, 0u, 0u, 0u};
            LDS_WAIT(); asm volatile("" ::: "memory");
#pragma unroll
            for (int g = 0; g < 8; ++g) {
                if (16 * g < nreg) {
#pragma unroll
                    for (int j = 0; j < 16; ++j) { const unsigned u = key[16 * g + j]; if (u != 0u && (u & mask) == prefix) __hip_atomic_fetch_add(hist + ((u >> shift) & bm), 1u, __ATOMIC_RELAXED, __HIP_MEMORY_SCOPE_WORKGROUP); }
                }
            }
            LDS_WAIT(); asm volatile("" ::: "memory");
            int ct = 0;
#pragma unroll
            for (int j = 0; j < 8; ++j) { const v4u c4 = *(const LAS v4u*)(hist + 32 * lane + 4 * j); ct += (int)(c4.x + c4.y) + (int)(c4.z + c4.w); }
            int incl = ct;
#pragma unroll
            for (int o = 1; o < 64; o <<= 1) { const int v = __shfl_down(incl, o); if (lane + o < 64) incl += v; }
            const int above = incl - ct;
            const bool target = (above < need) && (incl >= need);
            int bin_l = 0, cab_l = 0;
            if (target) { int cum = above; bool done = false;
#pragma unroll 1
                for (int j = 7; j >= 0 && !done; --j) { const v4u c4 = *(const LAS v4u*)(hist + 32 * lane + 4 * j); const unsigned cc[4] = {c4.x, c4.y, c4.z, c4.w};
#pragma unroll
                    for (int e = 3; e >= 0; --e) { if (!done) { if (cum + (int)cc[e] >= need) { bin_l = 32 * lane + 4 * j + e; cab_l = cum; done = true; } else cum += (int)cc[e]; } } } }
            LDS_WAIT(); asm volatile("" ::: "memory");
            const unsigned long long bal = __ballot(target); const int src = bal ? (__ffsll((long long)bal) - 1) : 0;
            const int bin = __shfl(bin_l, src), cab = __shfl(cab_l, src);
            need -= cab; prefix |= ((unsigned)bin) << shift; mask |= bm << shift;
        }
        const int ngt = 256 - need; int cgt = 0, ceq = 0; const unsigned long long lt = (1ull << lane) - 1ull;
#pragma unroll
        for (int g = 0; g < 8; ++g) {
            if (16 * g < nreg) {
#pragma unroll
                for (int j = 0; j < 16; ++j) { const int i = 16 * g + j; const unsigned u = key[i];
                    const bool gt = u > prefix, eq = u == prefix;
                    const unsigned long long bg = __ballot(gt), be = __ballot(eq);
                    if (gt) { const int pos = cgt + __popcll(bg & lt); if (pos < 256) out[pos] = 64 * i + lane; }
                    if (eq) { const int pe = ceq + __popcll(be & lt); if (pe < need) out[ngt + pe] = 64 * i + lane; }
                    cgt += __popcll(bg); ceq += __popcll(be); }
            }
        }
    }
}
constexpr int ATT_RS = 544;
DI void phase_dsa_attn(const Ctx& F, const InTab in) {
    const bf16* DC = (const bf16*)(F.ws + WS_DC); const bf16* DQL = (const bf16*)(F.ws + WS_DQL); const int* IDX = (const int*)(F.ws + WS_DIDX); bf16* DOL = (bf16*)(F.ws + WS_DOL);
    LAS int* tab = (LAS int*)(F.lds + 139264); LAS float* rbs = (LAS float*)(F.lds + 139264 + 512);
    if (F.tid < 128) { const int nn = F.tid; int b;
        if (nn < 16) b = nn; else { b = 16 + (nn >= 19) + (nn >= 21) + (nn >= 24) + (nn >= 27) + (nn >= 31) + (nn >= 35) + (nn >= 40) + (nn >= 46) + (nn >= 52) + (nn >= 59) + (nn >= 67) + (nn >= 77) + (nn >= 87) + (nn >= 99) + (nn >= 113); }
        tab[nn] = b; }
    if (F.tid < 256) rbs[F.tid] = in[22][F.tid];
    __syncthreads();
    LAS unsigned char* tile = F.lds + F.wave * (32 * ATT_RS);
    const unsigned tile_a = (unsigned)(size_t)tile;
    const int lane = F.lane, r = lane & 15, q = lane >> 4, head = r & 7;
    for (int t = F.gw; t < T; t += F.NGW) {
        const int cnt = t + 1 < 256 ? t + 1 : 256, nch = (cnt + 31) >> 5;
        bf16x8 Qf[8];
#pragma unroll
        for (int s = 0; s < 8; ++s) Qf[s] = *(const bf16x8*)(DQL + (size_t)t * 2048 + head * 256 + 32 * s + 8 * q);
        f32x4 OT[16];
#pragma unroll
        for (int d = 0; d < 16; ++d) OT[d] = (f32x4){0.f, 0.f, 0.f, 0.f};
        float mrun = -INFINITY, lrun = 0.f;
#pragma unroll 1
        for (int ch = 0; ch < nch; ++ch) {
            const int slot_l = 32 * ch + (lane & 31);
            int idxv = slot_l < cnt ? IDX[(size_t)t * 256 + slot_l] : 0;
#pragma unroll
            for (int i = 0; i < 16; ++i) { const int row = 2 * i + (lane >> 5); const int src = __shfl(idxv, row);
                const v4u v = *(const v4u*)(DC + (size_t)src * 256 + 8 * (lane & 31)); *(LAS v4u*)(tile + row * ATT_RS + 16 * (lane & 31)) = v; }
            LDS_WAIT(); asm volatile("" ::: "memory");
            f32x4 st[2];
#pragma unroll
            for (int rt = 0; rt < 2; ++rt) { st[rt] = (f32x4){0.f, 0.f, 0.f, 0.f};
#pragma unroll
                for (int s = 0; s < 8; ++s) { const bf16x8 cf = *(const LAS bf16x8*)(tile + (16 * rt + r) * ATT_RS + (32 * s + 8 * q) * 2); st[rt] = MFMA16(cf, Qf[s], st[rt]); } }
            float p[2][4]; float cmax = -INFINITY;
#pragma unroll
            for (int rt = 0; rt < 2; ++rt)
#pragma unroll
                for (int e = 0; e < 4; ++e) { const int kl = 16 * rt + 4 * q + e; const int kidx = __shfl(idxv, kl); const int dist = t - kidx;
                    const int bkt = dist < 128 ? tab[dist < 0 ? 0 : dist] : 31; const float lg = (32 * ch + kl < cnt) ? st[rt][e] + rbs[bkt * 8 + head] : -INFINITY;
                    p[rt][e] = lg; cmax = fmaxf(cmax, lg); }
            cmax = fmaxf(cmax, __shfl_xor(cmax, 16)); cmax = fmaxf(cmax, __shfl_xor(cmax, 32));
            const float mnew = fmaxf(mrun, cmax); const float alpha = fexp(mrun - mnew); float psum = 0.f;
#pragma unroll
            for (int rt = 0; rt < 2; ++rt)
#pragma unroll
                for (int e = 0; e < 4; ++e) { p[rt][e] = fexp(p[rt][e] - mnew); psum += p[rt][e]; }
            psum += __shfl_xor(psum, 16); psum += __shfl_xor(psum, 32);
            lrun = lrun * alpha + psum; mrun = mnew;
            v4u pbw; pbw.x = pk2(p[0][0], p[0][1]); pbw.y = pk2(p[0][2], p[0][3]); pbw.z = pk2(p[1][0], p[1][1]); pbw.w = pk2(p[1][2], p[1][3]);
            const bf16x8 pb = __builtin_bit_cast(bf16x8, pbw);
            const unsigned ra = tile_a + (unsigned)((4 * q + (r >> 2)) * ATT_RS + 8 * (r & 3));
#pragma unroll
            for (int d = 0; d < 16; ++d) { OT[d] = OT[d] * alpha;
                const bf16x4 lo = tr_read(ra + 32 * d), hi = tr_read(ra + 16 * ATT_RS + 32 * d);
                OT[d] = MFMA16(cat8(lo, hi), pb, OT[d]); }
        }
        const float inv = frcp(lrun);
        if (r < 8) {
#pragma unroll
            for (int d = 0; d < 16; ++d) { v2u w; w.x = pk2(OT[d][0] * inv, OT[d][1] * inv); w.y = pk2(OT[d][2] * inv, OT[d][3] * inv);
                *(v2u*)(DOL + (size_t)t * 2048 + head * 256 + 16 * d + 4 * q) = w; }
        }
    }
}
DI void phase_dsa_uv(const Ctx& F) {
    const bf16* DOL = (const bf16*)(F.ws + WS_DOL); const bf16* WUV = (const bf16*)(F.ws + WS_WUV); bf16* YO = (bf16*)(F.ws + WS_Y) + (size_t)T * 1024;
    for (int it = F.gw; it < 256 * 8; it += F.NGW) { const int mt = it >> 3, h = it & 7;
#pragma unroll 1
        for (int nt = 0; nt < 4; ++nt)
            wave_gemm32_bf16(DOL + (size_t)(mt * 32) * 2048 + h * 256, 2048, WUV + (size_t)h * 128 * 256 + (size_t)(nt * 32) * 256, 256, 256, YO + (size_t)(mt * 32) * 1024 + h * 128 + nt * 32, 1024, F.lane); }
}
DI float* ml_small(const Ctx& F, int off_floats) { return (float*)(F.ws + WS_MSM) + off_floats; }
constexpr int MS_LI = 0, MS_LF = 32768, MS_GC = 65536, MS_GTOT = 98304, MS_WMAX = 98560, MS_MST = 98816, MS_NLOC = 99072, MS_NST = 99072 + 32768;
DI float log_sigmoid(float x) { return flog_sigmoid(x); }
DI void phase_ml_prep(const Ctx& F, const InTab in, int l) {
    const bf16* Z = (const bf16*)(F.ws + WS_Z); bf16* MQK = (bf16*)(F.ws + WS_MQK);
    const float* cw = in[23] + (size_t)l * 4 * 1024; const float* b_i = in[24] + (size_t)l * 4; const float* b_f = in[25] + (size_t)l * 4;
    float* LI = ml_small(F, MS_LI); float* LF = ml_small(F, MS_LF);
    const int c0 = 16 * F.lane; const float qs = c0 < 512 ? 0.08838834764831845f : 1.0f;
    for (int t = F.gw; t < T; t += F.NGW) {
        float acc[16];
#pragma unroll
        for (int e = 0; e < 16; ++e) acc[e] = 0.f;
#pragma unroll
        for (int j = 0; j < 4; ++j) { const int tt = t - 3 + j; if (tt < 0) continue;
            const v4u z0 = *(const v4u*)(Z + (size_t)tt * NZ + ZMQ + c0), z1 = *(const v4u*)(Z + (size_t)tt * NZ + ZMQ + c0 + 8);
            const unsigned zw[8] = {z0.x, z0.y, z0.z, z0.w, z1.x, z1.y, z1.z, z1.w};
#pragma unroll
            for (int e = 0; e < 8; ++e) { const f32x2 w2 = *(const f32x2*)(cw + (size_t)j * 1024 + c0 + 2 * e); acc[2 * e] = fmaf(w2[0], bflo(zw[e]), acc[2 * e]); acc[2 * e + 1] = fmaf(w2[1], bfhi(zw[e]), acc[2 * e + 1]); } }
        unsigned w[8];
#pragma unroll
        for (int e = 0; e < 8; ++e) { const float a = acc[2 * e], b = acc[2 * e + 1]; w[e] = pk2(a * sigmoidf_(a) * qs, b * sigmoidf_(b) * qs); }
        v4u* op = (v4u*)(MQK + (size_t)t * 1024 + c0); op[0] = (v4u){w[0], w[1], w[2], w[3]}; op[1] = (v4u){w[4], w[5], w[6], w[7]};
        if (F.lane < 4) LI[t * 4 + F.lane] = bf2f(Z[(size_t)t * NZ + ZMI + F.lane]) + b_i[F.lane];
        else if (F.lane < 8) LF[t * 4 + F.lane - 4] = log_sigmoid(bf2f(Z[(size_t)t * NZ + ZMF + F.lane - 4]) + b_f[F.lane - 4]);
    }
}
constexpr int ML_KRS = 288, ML_VRS = 544;
DI void phase_ml_local(const Ctx& F) {
    const bf16* Z = (const bf16*)(F.ws + WS_Z); const bf16* MQK = (const bf16*)(F.ws + WS_MQK); float* MKL = (float*)(F.ws + WS_MKL);
    float* LI = ml_small(F, MS_LI); float* LF = ml_small(F, MS_LF); float* GC = ml_small(F, MS_GC); float* GTOT = ml_small(F, MS_GTOT); float* WMAX = ml_small(F, MS_WMAX); float* NLOC = ml_small(F, MS_NLOC);
    LAS unsigned char* vt = F.lds; LAS unsigned char* kt = F.lds + 128 * ML_VRS; LAS float* wgt = (LAS float*)(F.lds + 128 * ML_VRS + 128 * ML_KRS);
    const int lane = F.lane, r = lane & 15, q = lane >> 4;
    for (int unit = F.bid; unit < 256; unit += F.G) {
        const int c = unit >> 2, h = unit & 3, t0 = c * 128;
        if (F.wave == 0) {
            float f0 = LF[(t0 + 2 * lane) * 4 + h], f1 = LF[(t0 + 2 * lane + 1) * 4 + h];
            float s = f0 + f1;
#pragma unroll
            for (int o = 1; o < 64; o <<= 1) { const float v = __shfl_up(s, o); if (lane >= o) s += v; }
            const float g1 = s, g0 = s - f1;
            const float gtot = __shfl(g1, 63);
            GC[(t0 + 2 * lane) * 4 + h] = g0; GC[(t0 + 2 * lane + 1) * 4 + h] = g1;
            const float w0 = gtot - g0 + LI[(t0 + 2 * lane) * 4 + h], w1 = gtot - g1 + LI[(t0 + 2 * lane + 1) * 4 + h];
            const float wm = wave_max(fmaxf(w0, w1));
            wgt[2 * lane] = fexp(w0 - wm); wgt[2 * lane + 1] = fexp(w1 - wm);
            if (lane == 0) { GTOT[unit] = gtot; WMAX[unit] = wm; }
        }
        __syncthreads();
        for (int i = F.tid; i < 128 * 16; i += NTHR) { const int s = i >> 4, ch = i & 15;
            const v4u kv = *(const v4u*)(MQK + (size_t)(t0 + s) * 1024 + 512 + h * 128 + 8 * ch); const float wg = wgt[s];
            v4u o; o.x = pk2(bflo(kv.x) * wg, bfhi(kv.x) * wg); o.y = pk2(bflo(kv.y) * wg, bfhi(kv.y) * wg); o.z = pk2(bflo(kv.z) * wg, bfhi(kv.z) * wg); o.w = pk2(bflo(kv.w) * wg, bfhi(kv.w) * wg);
            *(LAS v4u*)(kt + s * ML_KRS + 16 * ch) = o; }
        for (int i = F.tid; i < 128 * 32; i += NTHR) { const int s = i >> 5, ch = i & 31;
            *(LAS v4u*)(vt + s * ML_VRS + 16 * ch) = *(const v4u*)(Z + (size_t)(t0 + s) * NZ + ZMV + h * 256 + 8 * ch); }
        __syncthreads();
        f32x4 acc[2][8];
#pragma unroll
        for (int i = 0; i < 2; ++i)
#pragma unroll
            for (int j = 0; j < 8; ++j) acc[i][j] = (f32x4){0.f, 0.f, 0.f, 0.f};
        const unsigned va = (unsigned)(size_t)vt + (unsigned)((r >> 2) * ML_VRS + 8 * (r & 3)), ka = (unsigned)(size_t)kt + (unsigned)((r >> 2) * ML_KRS + 8 * (r & 3));
#pragma unroll 1
        for (int ks = 0; ks < 4; ++ks) {
            bf16x8 af[2], bfr[8];
#pragma unroll
            for (int i = 0; i < 2; ++i) { const unsigned a0 = va + (unsigned)((32 * ks + 8 * q) * ML_VRS + 32 * (2 * F.wave + i)); af[i] = cat8(tr_read(a0), tr_read(a0 + 4 * ML_VRS)); }
#pragma unroll
            for (int j = 0; j < 8; ++j) { const unsigned b0 = ka + (unsigned)((32 * ks + 8 * q) * ML_KRS + 32 * j); bfr[j] = cat8(tr_read(b0), tr_read(b0 + 4 * ML_KRS)); }
#pragma unroll
            for (int i = 0; i < 2; ++i)
#pragma unroll
                for (int j = 0; j < 8; ++j) acc[i][j] = MFMA16(af[i], bfr[j], acc[i][j]);
        }
#pragma unroll
        for (int i = 0; i < 2; ++i)
#pragma unroll
            for (int j = 0; j < 8; ++j)
#pragma unroll
                for (int e = 0; e < 4; ++e) MKL[((size_t)unit * 256 + 16 * (2 * F.wave + i) + 4 * q + e) * 128 + 16 * j + r] = acc[i][j][e];
        if (F.tid < 128) { float s = 0.f; for (int ss = 0; ss < 128; ++ss) s += bf2f(*(const LAS bf16*)(kt + ss * ML_KRS + 2 * F.tid)); NLOC[unit * 128 + F.tid] = s; }
        __syncthreads();
    }
}
DI void phase_ml_scan(const Ctx& F) {
    const float* MKL = (const float*)(F.ws + WS_MKL); bf16* MCS = (bf16*)(F.ws + WS_MCS);
    const float* GTOT = ml_small(F, MS_GTOT); const float* WMAX = ml_small(F, MS_WMAX); float* MST = ml_small(F, MS_MST); const float* NLOC = ml_small(F, MS_NLOC); float* NST = ml_small(F, MS_NST);
    for (int idx = F.bid * NTHR + F.tid; idx < 4 * 256 * 128; idx += F.G * NTHR) {
        const int h = idx >> 15, e = (idx >> 7) & 255, d = idx & 127;
        float m = 0.f, cur = 0.f, ncur = 0.f;
        for (int c = 0; c < 64; ++c) { const int unit = c * 4 + h;
            MCS[((size_t)unit * 256 + e) * 128 + d] = (bf16)f2bf(cur);
            if (e == 0) { NST[unit * 128 + d] = ncur; if (d == 0) MST[unit] = m; }
            const float gt = GTOT[unit], wm = WMAX[unit]; const float mn = fmaxf(gt + m, wm); const float cd = fexp(gt + m - mn), cl = fexp(wm - mn);
            cur = cd * cur + cl * MKL[((size_t)unit * 256 + e) * 128 + d];
            if (e == 0) ncur = cd * ncur + cl * NLOC[unit * 128 + d];
            m = mn; }
    }
}
DI void phase_ml_out(const Ctx& F, const InTab in, int l) {
    const bf16* Z = (const bf16*)(F.ws + WS_Z); const bf16* MQK = (const bf16*)(F.ws + WS_MQK); const bf16* MCS = (const bf16*)(F.ws + WS_MCS);
    const float* LI = ml_small(F, MS_LI); const float* GC = ml_small(F, MS_GC); const float* MST = ml_small(F, MS_MST); const float* NST = ml_small(F, MS_NST);
    const float* hn = in[26] + (size_t)l * 1024; bf16* YO = (bf16*)(F.ws + WS_Y) + (size_t)2 * T * 1024;
    LAS unsigned char* vt = F.lds; LAS float* gcs = (LAS float*)(F.lds + 128 * ML_VRS); LAS float* lgs = gcs + 128; LAS float* pms = gcs + 256; LAS float* nsts = gcs + 384;
    const int lane = F.lane, r = lane & 15, q = lane >> 4, w = F.wave;
    for (int unit = F.bid; unit < 256; unit += F.G) {
        const int c = unit >> 2, h = unit & 3, t0 = c * 128;
        for (int i = F.tid; i < 128 * 32; i += NTHR) { const int s = i >> 5, ch = i & 31;
            *(LAS v4u*)(vt + s * ML_VRS + 16 * ch) = *(const v4u*)(Z + (size_t)(t0 + s) * NZ + ZMV + h * 256 + 8 * ch); }
        if (w == 0) {
            const float g0 = GC[(t0 + 2 * lane) * 4 + h], g1 = GC[(t0 + 2 * lane + 1) * 4 + h];
            const float l0 = LI[(t0 + 2 * lane) * 4 + h] - g0, l1 = LI[(t0 + 2 * lane + 1) * 4 + h] - g1;
            float pm = fmaxf(l0, l1);
#pragma unroll
            for (int o = 1; o < 64; o <<= 1) { const float v = __shfl_up(pm, o); if (lane >= o) pm = fmaxf(pm, v); }
            float pprev = __shfl_up(pm, 1); if (lane == 0) pprev = -INFINITY;
            gcs[2 * lane] = g0; gcs[2 * lane + 1] = g1; lgs[2 * lane] = l0; lgs[2 * lane + 1] = l1; pms[2 * lane] = fmaxf(pprev, l0); pms[2 * lane + 1] = pm;
        }
        if (w == 1) { nsts[lane] = NST[unit * 128 + lane]; nsts[64 + lane] = NST[unit * 128 + 64 + lane]; }
        __syncthreads();
        const int j = 16 * w + r; const float mst = MST[unit];
        const float gcj = gcs[j], alog = gcj + mst, mq = fmaxf(alog, gcj + pms[j]), inter = fexp(alog - mq), gm = gcj - mq;
        bf16x8 qf[4], qi[4];
#pragma unroll
        for (int ks = 0; ks < 4; ++ks) { const v4u qv = *(const v4u*)(MQK + (size_t)(t0 + j) * 1024 + h * 128 + 32 * ks + 8 * q); qf[ks] = __builtin_bit_cast(bf16x8, qv);
            v4u o; o.x = pk2(bflo(qv.x) * inter, bfhi(qv.x) * inter); o.y = pk2(bflo(qv.y) * inter, bfhi(qv.y) * inter); o.z = pk2(bflo(qv.z) * inter, bfhi(qv.z) * inter); o.w = pk2(bflo(qv.w) * inter, bfhi(qv.w) * inter);
            qi[ks] = __builtin_bit_cast(bf16x8, o); }
        const int nkp = (w >> 1) + 1;
        LAS v4u* pls = (LAS v4u*)(F.lds + 73728) + w * 256;
#pragma unroll 1
        for (int kp = 0; kp < nkp; ++kp) {
            float pv[8];
#pragma unroll
            for (int hf = 0; hf < 2; ++hf) { const int st = 2 * kp + hf;
                f32x4 sacc = (f32x4){0.f, 0.f, 0.f, 0.f};
                if (st <= w) {
                    const bf16* kr = MQK + (size_t)(t0 + 16 * st + r) * 1024 + 512 + h * 128 + 8 * q;
#pragma unroll
                    for (int ks = 0; ks < 4; ++ks) { const bf16x8 kf = *(const bf16x8*)(kr + 32 * ks); sacc = MFMA16(kf, qf[ks], sacc); }
                }
#pragma unroll
                for (int e = 0; e < 4; ++e) { const int s = 16 * st + 4 * q + e; pv[4 * hf + e] = (st <= w && s <= j) ? sacc[e] * fexp(gm + lgs[s]) : 0.f; } }
            v4u o; o.x = pk2(pv[0], pv[1]); o.y = pk2(pv[2], pv[3]); o.z = pk2(pv[4], pv[5]); o.w = pk2(pv[6], pv[7]); pls[kp * 64 + lane] = o;
        }
        LDS_WAIT(); asm volatile("" ::: "memory");
        const unsigned va = (unsigned)(size_t)vt + (unsigned)((r >> 2) * ML_VRS + 8 * (r & 3)) + (unsigned)(4 * q * ML_VRS);
        const bf16* crow = MCS + ((size_t)unit * 256 + r) * 128 + 8 * q;
        f32x4 dacc = (f32x4){0.f, 0.f, 0.f, 0.f};
#pragma unroll
        for (int ks = 0; ks < 4; ++ks) { v4u o = (v4u){0u, 0u, 0u, 0u};
            if (r == 0) { const LAS float* np = nsts + 32 * ks + 8 * q; o.x = pk2(np[0], np[1]); o.y = pk2(np[2], np[3]); o.z = pk2(np[4], np[5]); o.w = pk2(np[6], np[7]); }
            dacc = MFMA16(__builtin_bit_cast(bf16x8, o), qi[ks], dacc); }
#pragma unroll
        for (int kp = 0; kp < 4; ++kp) if (kp < nkp) { const unsigned one2 = r == 0 ? 0x3f803f80u : 0u; const v4u o = (v4u){one2, one2, one2, one2}; dacc = MFMA16(__builtin_bit_cast(bf16x8, o), __builtin_bit_cast(bf16x8, pls[kp * 64 + lane]), dacc); }
        const float den = __shfl(dacc[0], r);
        const float dinv = frcp(fmaxf(fabsf(den), fexp(-mq)));
        float ss = 0.f;
#pragma unroll 1
        for (int et = 0; et < 16; ++et) {
            f32x4 a = (f32x4){0.f, 0.f, 0.f, 0.f};
#pragma unroll
            for (int ks = 0; ks < 4; ++ks) { const bf16x8 cf = *(const bf16x8*)(crow + (size_t)(16 * et) * 128 + 32 * ks); a = MFMA16(cf, qi[ks], a); }
#pragma unroll
            for (int kp = 0; kp < 4; ++kp) if (kp < nkp) { const unsigned a0 = va + (unsigned)((32 * kp) * ML_VRS + 32 * et); a = MFMA16(cat8(tr_read(a0), tr_read(a0 + 16 * ML_VRS)), __builtin_bit_cast(bf16x8, pls[kp * 64 + lane]), a); }
            a = a * dinv; ss += (a[0] * a[0] + a[1] * a[1]) + (a[2] * a[2] + a[3] * a[3]);
        }
        ss += __shfl_xor(ss, 16); ss += __shfl_xor(ss, 32);
        const float rinv = __builtin_amdgcn_rsqf(ss * (1.0f / 256.0f) + EPS) * dinv;
        const int t = t0 + j;
#pragma unroll 1
        for (int et = 0; et < 16; ++et) {
            f32x4 a = (f32x4){0.f, 0.f, 0.f, 0.f};
#pragma unroll
            for (int ks = 0; ks < 4; ++ks) { const bf16x8 cf = *(const bf16x8*)(crow + (size_t)(16 * et) * 128 + 32 * ks); a = MFMA16(cf, qi[ks], a); }
#pragma unroll
            for (int kp = 0; kp < 4; ++kp) if (kp < nkp) { const unsigned a0 = va + (unsigned)((32 * kp) * ML_VRS + 32 * et); a = MFMA16(cat8(tr_read(a0), tr_read(a0 + 16 * ML_VRS)), __builtin_bit_cast(bf16x8, pls[kp * 64 + lane]), a); }
            const int e0 = 16 * et + 4 * q; const v2u ov = *(const v2u*)(Z + (size_t)t * NZ + ZMO + h * 256 + e0); const f32x4 g4 = *(const f32x4*)(hn + h * 256 + e0);
            const float o0 = sigmoidf_(bflo(ov.x)) * a[0] * rinv * g4[0], o1 = sigmoidf_(bfhi(ov.x)) * a[1] * rinv * g4[1], o2 = sigmoidf_(bflo(ov.y)) * a[2] * rinv * g4[2], o3 = sigmoidf_(bfhi(ov.y)) * a[3] * rinv * g4[3];
            v2u wv; wv.x = pk2(o0, o1); wv.y = pk2(o2, o3); *(v2u*)(YO + (size_t)t * 1024 + h * 256 + e0) = wv;
        }
        __syncthreads();
    }
}
constexpr int NPH = 20;
#ifndef PROBE_MASK
#define PROBE_MASK 0u
#endif
#ifndef MK_PER_PHASE
#define MK_PER_PHASE 0
#endif

template <int PH> __global__ void __launch_bounds__(NTHR, 2) mega(Args args) {
    extern __shared__ __attribute__((aligned(16))) unsigned char lds_raw[];
    LAS unsigned char* glds = (LAS unsigned char*)lds_raw;
    const int wave_s = __builtin_amdgcn_readfirstlane((int)(threadIdx.x >> 6));
    for (int u = threadIdx.x; u < (LDS_BYTES - LDSCTL_OFF) / 4; u += NTHR) ((LAS unsigned*)(glds + LDSCTL_OFF))[u] = 0u;
    __syncthreads();
    const int lo = args.ph_lo, hi = args.ph_hi;
    if (hi - lo > 1) (void)xcd_barrier_post((unsigned*)(opaque_ws(args) + WS_CTL) + CW_BAR, (volatile LAS unsigned*)(glds + MISC_OFF));
    const InTab in{&args};
#pragma unroll
    for (int l = 0; l < NL; ++l) {
        const int pb = l * NPH;
#define IN(k) ((PH < 0 || PH == (k)) && lo <= pb + (k) && pb + (k) < hi)
#define SEAM(k) do { if (IN(k) && pb + (k) + 1 < hi) { XcdBarrier b_; b_.bar = (unsigned*)(opaque_ws(args) + WS_CTL) + CW_BAR; b_.x = xb_xcc_id(); b_.st = (volatile LAS unsigned*)(glds + MISC_OFF); b_.t0 = (wave_s == 0) && (lane_id() == 0); xcd_barrier(b_); } } while (0)
#define SEAMX(k, more) do { if (IN(k) && ((more) || pb + (k) + 1 < hi)) { XcdBarrier b_; b_.bar = (unsigned*)(opaque_ws(args) + WS_CTL) + CW_BAR; b_.x = xb_xcc_id(); b_.st = (volatile LAS unsigned*)(glds + MISC_OFF); b_.t0 = (wave_s == 0) && (lane_id() == 0); xcd_barrier(b_); } } while (0)
#define PHX const Ctx F = make_ctx(args, glds, wave_s); unsigned char* ws = F.ws; bf16* HB = (bf16*)(ws + WS_HB); bf16* ACT = (bf16*)(ws + WS_ACT); float* FB = (float*)(ws + WS_F); bf16* Zb = (bf16*)(ws + WS_Z); float* RS = (float*)(ws + WS_RS); float* FSS = (float*)(ws + WS_FSS); \
        const float* ng = in[2] + (size_t)l * 8 * D; (void)HB; (void)ACT; (void)FB; (void)Zb; (void)RS; (void)FSS; (void)ng;
        for (int rep_ = 0; rep_ < 1 + (int)((PROBE_MASK >> 0) & 1u); ++rep_) {
        if (IN(0)) { PHX phase_conv(F, in, l); if (l == 0) phase_resid<true>(F, in[0], nullptr, 0.f, args.out); }
        SEAMX(0, rep_ + 1 < 1 + (int)((PROBE_MASK >> 0) & 1u)); }
        for (int rep_ = 0; rep_ < 1 + (int)((PROBE_MASK >> 1) & 1u); ++rep_) {
        if (IN(1)) { PHX pg8::Gemm g{HB, (const bf16*)(ws + WS_WGU1), T, 2 * FF, D}; pg8::StaticOrder S; S.init(T, 2 * FF, F.G, F.bid);
            pg8::EpiSwiglu E{ACT, FF, RS, 1.0f / D, EPS}; pg8::gemm_phase<pg8::EpiSwiglu, pg8::StaticOrder, true, true>(glds, g, S, E, F.tid); }
        SEAMX(1, rep_ + 1 < 1 + (int)((PROBE_MASK >> 1) & 1u)); }
        for (int rep_ = 0; rep_ < 1 + (int)((PROBE_MASK >> 2) & 1u); ++rep_) {
        if (IN(2)) { PHX pg8::Gemm g{ACT, (const bf16*)(ws + WS_WD1), T, D, FF}; pg8::StaticOrder S; S.init(T, D, F.G, F.bid);
            pg8::EpiF32SS E{FB, D, FSS}; pg8::gemm_phase<pg8::EpiF32SS, pg8::StaticOrder, true, true>(glds, g, S, E, F.tid); }
        SEAMX(2, rep_ + 1 < 1 + (int)((PROBE_MASK >> 2) & 1u)); }
        for (int rep_ = 0; rep_ < 1 + (int)((PROBE_MASK >> 3) & 1u); ++rep_) {
        if (IN(3)) { PHX phase_resid<false>(F, FB, ng + 1 * D, 0.5f, args.out); }
        SEAMX(3, rep_ + 1 < 1 + (int)((PROBE_MASK >> 3) & 1u)); }
        for (int rep_ = 0; rep_ < 1 + (int)((PROBE_MASK >> 4) & 1u); ++rep_) {
        if (IN(4)) { PHX pg8::Gemm g{HB, (const bf16*)(ws + WS_WIN), T, NZ, D}; pg8::StaticOrder S; S.init(T, NZ, F.G, F.bid);
            pg8::EpiScaleBf16 E{Zb, NZ, RS, 1.0f / D, EPS}; pg8::gemm_phase<pg8::EpiScaleBf16, pg8::StaticOrder, true, true>(glds, g, S, E, F.tid); }
        SEAMX(4, rep_ + 1 < 1 + (int)((PROBE_MASK >> 4) & 1u)); }
        for (int rep_ = 0; rep_ < 1 + (int)((PROBE_MASK >> 5) & 1u); ++rep_) {
        if (IN(5)) { PHX phase_rw_prep(F, in, l); phase_dsa_prep(F, in, l); phase_ml_prep(F, in, l); }
        SEAMX(5, rep_ + 1 < 1 + (int)((PROBE_MASK >> 5) & 1u)); }
        for (int rep_ = 0; rep_ < 1 + (int)((PROBE_MASK >> 6) & 1u); ++rep_) {
        if (IN(6)) { PHX phase_rw_local(F); }
        SEAMX(6, rep_ + 1 < 1 + (int)((PROBE_MASK >> 6) & 1u)); }
        for (int rep_ = 0; rep_ < 1 + (int)((PROBE_MASK >> 7) & 1u); ++rep_) {
        if (IN(7)) { PHX
            if (F.wave == 0 && F.bid < 64) phase_rw_combine(F, F.bid);
            else { const int nskip = F.bid < 64 ? F.bid + 1 : 64; phase_dsa_index(F, F.gw - nskip, F.NGW - 64); }
            __syncthreads(); phase_ml_local(F); }
        SEAMX(7, rep_ + 1 < 1 + (int)((PROBE_MASK >> 7) & 1u)); }
        for (int rep_ = 0; rep_ < 1 + (int)((PROBE_MASK >> 8) & 1u); ++rep_) {
        if (IN(8)) { PHX phase_dsa_topk(F); phase_ml_scan(F); phase_rw_out(F, in, l); }
        SEAMX(8, rep_ + 1 < 1 + (int)((PROBE_MASK >> 8) & 1u)); }
        for (int rep_ = 0; rep_ < 1 + (int)((PROBE_MASK >> 9) & 1u); ++rep_) {
        if (IN(9)) { PHX
            __syncthreads(); phase_dsa_attn(F, in);
            __syncthreads(); phase_ml_out(F, in, l);
        }
        SEAMX(9, rep_ + 1 < 1 + (int)((PROBE_MASK >> 9) & 1u)); }
        for (int rep_ = 0; rep_ < 1 + (int)((PROBE_MASK >> 10) & 1u); ++rep_) {
        if (IN(10)) { PHX phase_dsa_uv(F); }
        SEAMX(10, rep_ + 1 < 1 + (int)((PROBE_MASK >> 10) & 1u)); }
        for (int rep_ = 0; rep_ < 1 + (int)((PROBE_MASK >> 11) & 1u); ++rep_) {
        if (IN(11)) { PHX pg8::Gemm g{(const bf16*)(ws + WS_Y), (const bf16*)(ws + WS_WBR), 3 * T, 3 * D, 1024}; pg8::BranchOrder S{F.G, F.bid};
            pg8::EpiBranch E{FB, (bf16*)(ws + WS_MIXG), Zb, NZ, ZG}; pg8::gemm_phase<pg8::EpiBranch, pg8::BranchOrder, true, true>(glds, g, S, E, F.tid); }
        SEAMX(11, rep_ + 1 < 1 + (int)((PROBE_MASK >> 11) & 1u)); }
        for (int rep_ = 0; rep_ < 1 + (int)((PROBE_MASK >> 12) & 1u); ++rep_) {
        if (IN(12)) { PHX pg8::Gemm g{(const bf16*)(ws + WS_MIXG), (const bf16*)(ws + WS_WOUT), T, D, D}; pg8::StaticOrder S; S.init(T, D, F.G, F.bid);
            pg8::EpiF32SS E{FB, D, FSS}; pg8::gemm_phase<pg8::EpiF32SS, pg8::StaticOrder, true, true>(glds, g, S, E, F.tid); }
        SEAMX(12, rep_ + 1 < 1 + (int)((PROBE_MASK >> 12) & 1u)); }
        for (int rep_ = 0; rep_ < 1 + (int)((PROBE_MASK >> 13) & 1u); ++rep_) {
        if (IN(13)) { PHX phase_resid<false>(F, FB, ng + 3 * D, 1.0f, args.out); }
        SEAMX(13, rep_ + 1 < 1 + (int)((PROBE_MASK >> 13) & 1u)); }
        for (int rep_ = 0; rep_ < 1 + (int)((PROBE_MASK >> 14) & 1u); ++rep_) {
        if (IN(14)) { PHX pg8::Gemm g{HB, (const bf16*)(ws + WS_WGU2), T, 2 * FF, D}; pg8::StaticOrder S; S.init(T, 2 * FF, F.G, F.bid);
            pg8::EpiSwiglu E{ACT, FF, RS, 1.0f / D, EPS}; pg8::gemm_phase<pg8::EpiSwiglu, pg8::StaticOrder, true, true>(glds, g, S, E, F.tid); }
        SEAMX(14, rep_ + 1 < 1 + (int)((PROBE_MASK >> 14) & 1u)); }
        for (int rep_ = 0; rep_ < 1 + (int)((PROBE_MASK >> 15) & 1u); ++rep_) {
        if (IN(15)) { PHX pg8::Gemm g{ACT, (const bf16*)(ws + WS_WD2), T, D, FF}; pg8::StaticOrder S; S.init(T, D, F.G, F.bid);
            pg8::EpiF32SS E{FB, D, FSS}; pg8::gemm_phase<pg8::EpiF32SS, pg8::StaticOrder, true, true>(glds, g, S, E, F.tid); }
        SEAMX(15, rep_ + 1 < 1 + (int)((PROBE_MASK >> 15) & 1u)); }
        for (int rep_ = 0; rep_ < 1 + (int)((PROBE_MASK >> 16) & 1u); ++rep_) {
        if (IN(16)) { PHX phase_resid<false>(F, FB, ng + 5 * D, 0.5f, args.out); }
        SEAMX(16, rep_ + 1 < 1 + (int)((PROBE_MASK >> 16) & 1u)); }
        for (int rep_ = 0; rep_ < 1 + (int)((PROBE_MASK >> 17) & 1u); ++rep_) {
        if (IN(17)) { PHX int kple = PLE; asm volatile("" : "+s"(kple)); pg8::Gemm g{(const bf16*)(ws + WS_PB), (const bf16*)(ws + WS_WPP), T, D, kple}; pg8::StaticOrder S; S.init(T, D, F.G, F.bid);
            pg8::EpiScaleBf16 E{(bf16*)(ws + WS_E), D, nullptr, 0.f, 0.f}; pg8::gemm_phase<pg8::EpiScaleBf16, pg8::StaticOrder, true, true>(glds, g, S, E, F.tid); }
        SEAMX(17, rep_ + 1 < 1 + (int)((PROBE_MASK >> 17) & 1u)); }
        for (int rep_ = 0; rep_ < 1 + (int)((PROBE_MASK >> 18) & 1u); ++rep_) {
        if (IN(18)) { PHX pg8::Gemm g{HB, (const bf16*)(ws + WS_WPG), T, D, D}; pg8::StaticOrder S; S.init(T, D, F.G, F.bid);
            pg8::EpiPleGate E{FB, D, FSS, RS, (const bf16*)(ws + WS_E), 1.0f / D, EPS}; pg8::gemm_phase<pg8::EpiPleGate, pg8::StaticOrder, true, true>(glds, g, S, E, F.tid); }
        SEAMX(18, rep_ + 1 < 1 + (int)((PROBE_MASK >> 18) & 1u)); }
        for (int rep_ = 0; rep_ < 1 + (int)((PROBE_MASK >> 19) & 1u); ++rep_) {
        if (IN(19)) { PHX phase_resid<false>(F, FB, ng + 7 * D, 1.0f, args.out); }
        SEAMX(19, rep_ + 1 < 1 + (int)((PROBE_MASK >> 19) & 1u)); }
#undef IN
#undef SEAM
#undef PHX
#undef SEAMX
    }
}

extern "C" void kernel_launch(void* const* d_in, const int* in_sizes, int n_in, void* d_out, int out_size, void* d_ws, size_t ws_size, hipStream_t stream) {
    static int grid = 0;
    if (grid == 0) {
        if (n_in != 34 || in_sizes[0] != T * D || out_size != T * D || ws_size < WS_END) { fprintf(stderr, "kernel_launch: unexpected problem (n_in %d, in0 %d, out %d, ws %zu < %zu); nothing launched\n", n_in, n_in > 0 ? in_sizes[0] : -1, out_size, ws_size, (size_t)WS_END); grid = -1; return; }
        int dev = 0, cus = 0;
        if (hipGetDevice(&dev) != hipSuccess || hipDeviceGetAttribute(&cus, hipDeviceAttributeMultiprocessorCount, dev) != hipSuccess) { grid = -1; return; }
        grid = cus;
    }
    if (grid < 0) return;
    (void)hipMemsetAsync((char*)d_ws + WS_CTL, 0, CTL_ZERO_BYTES, stream);
    Args a{};
    for (int i = 0; i < 34; ++i) a.in[i] = (const float*)d_in[i];
    a.out = (float*)d_out; a.ws = (unsigned char*)d_ws;
#if MK_PER_PHASE
    typedef void (*kfn)(Args);
    static const kfn tab[NPH] = { mega<0>, mega<1>, mega<2>, mega<3>, mega<4>, mega<5>, mega<6>, mega<7>, mega<8>, mega<9>, mega<10>, mega<11>, mega<12>, mega<13>, mega<14>, mega<15>, mega<16>, mega<17>, mega<18>, mega<19> };
    static bool attr = false;
    if (!attr) { for (int k = 0; k < NPH; ++k) if (hipFuncSetAttribute((const void*)tab[k], hipFuncAttributeMaxDynamicSharedMemorySize, LDS_BYTES) != hipSuccess) fprintf(stderr, "kernel_launch: hipFuncSetAttribute failed (phase %d)\n", k); attr = true; }
    for (int p = 0; p < NL * NPH; ++p) { a.ph_lo = p; a.ph_hi = p + 1; hipLaunchKernelGGL(tab[p % NPH], dim3(grid), dim3(NTHR), LDS_BYTES, stream, a); }
#else
    static bool attr = false;
    if (!attr) { if (hipFuncSetAttribute((const void*)mega<-1>, hipFuncAttributeMaxDynamicSharedMemorySize, LDS_BYTES) != hipSuccess) fprintf(stderr, "kernel_launch: hipFuncSetAttribute failed\n"); attr = true; }
    a.ph_lo = 0; a.ph_hi = NL * NPH; hipLaunchKernelGGL(mega<-1>, dim3(grid), dim3(NTHR), LDS_BYTES, stream, a);
#endif
}
```

```cpp
#include <hip/hip_runtime.h>
#include <cstdio>
#include <cstdint>
namespace pg8 {
#define PG8_LAS __attribute__((address_space(3)))
typedef unsigned short bf16_t;
typedef short bf16x8 __attribute__((ext_vector_type(8)));
typedef float f32x4 __attribute__((ext_vector_type(4)));
typedef unsigned u32x4 __attribute__((ext_vector_type(4)));
constexpr int BM = 256, BK = 64, HALF = 128, HTB = HALF * BK * 2  , STAGE_BYTES = 8 * HTB, NXCD = 8, WGM = 8;

__host__ __device__ __forceinline__ int lds_byte(int r, int c) { const int st = (r >> 4) * 2 + (c >> 5), rr = r & 15, cc = c & 31, ob = rr * 64 + cc * 2; return st * 1024 + (ob ^ (((ob >> 9) & 1) << 5)); }
__host__ __device__ __forceinline__ void stage_rc(int b, int& R, int& C) { const int st = b / 1024, sb = b % 1024, swz = sb ^ (((sb >> 9) & 1) << 5); R = (st >> 1) * 16 + swz / 64; C = (st & 1) * 32 + (swz % 64) / 2; }
__host__ __device__ __forceinline__ int perm32(int rho) { const int n = rho >> 4, i = rho & 15; return 8 * (i >> 2) + 4 * n + (i & 3); }

struct Unit { int pm, pn; };
struct Gemm { const bf16_t* A; const bf16_t* Bt; int M, N, K; };

struct StaticOrder {
    int nM, nN, nwg, G, c;
    __host__ __device__ void init(int M, int N, int G_, int c_) { nM = M / BM; nN = N / BM; nwg = nM * nN; G = G_; c = c_; }
    __host__ __device__ bool next(int i, Unit& u) const {
        const long L = (long)i * G + c; if (L >= nwg) return false;
        int wgid = (int)L; { const int q = nwg / NXCD, r = nwg % NXCD, xcd = wgid % NXCD, off = wgid / NXCD; wgid = (xcd < r ? xcd * (q + 1) : r * (q + 1) + (xcd - r) * q) + off; }
        const int nig = WGM * nN, gid = wgid / nig, fm = gid * WGM, gsz = (nM - fm) < WGM ? (nM - fm) : WGM;
        u.pm = fm + ((wgid % nig) % gsz); u.pn = (wgid % nig) / gsz; return true;
    }
    __device__ __forceinline__ void a_ready(const Unit&) const {}
    __device__ __forceinline__ void done(const Unit&) const {}
};
__device__ __forceinline__ unsigned cvt_pk_bf16(float lo, float hi) { unsigned r; asm volatile("v_cvt_pk_bf16_f32 %0, %1, %2" : "=v"(r) : "v"(lo), "v"(hi)); return r; }
typedef float f32x2 __attribute__((ext_vector_type(2)));
__device__ __forceinline__ float fast_sigmoid(float x) { return __builtin_amdgcn_rcpf(1.0f + __builtin_amdgcn_exp2f(-1.44269504089f * x)); }
typedef unsigned u32x2 __attribute__((ext_vector_type(2)));
struct EpiSwiglu {
    static constexpr bool PERM = true, AFTER_DRAIN = false;
    bf16_t* O; int ldo; const float* rs; float inv_d, eps;
    __device__ __forceinline__ void operator()(const f32x4 (&acc)[2][2][4][2], const Unit& u, int wr, int wc, int fr, int fq) const {
        const int row0 = u.pm * BM + wr * 64 + fr, col0 = u.pn * HALF + wc * 32 + 8 * fq;
#pragma unroll
        for (int ai = 0; ai < 2; ++ai)
#pragma unroll
            for (int m = 0; m < 4; ++m) { const int row = row0 + ai * HALF + m * 16; const float rinv = __builtin_amdgcn_rsqf(rs[row] * inv_d + eps);
                float o[8];
#pragma unroll
                for (int n = 0; n < 2; ++n)
#pragma unroll
                    for (int j = 0; j < 4; ++j) { const float g = acc[ai][0][m][n][j] * rinv, up = acc[ai][1][m][n][j] * rinv; o[4 * n + j] = g * fast_sigmoid(g) * up; }
                u32x4 w; w.x = cvt_pk_bf16(o[0], o[1]); w.y = cvt_pk_bf16(o[2], o[3]); w.z = cvt_pk_bf16(o[4], o[5]); w.w = cvt_pk_bf16(o[6], o[7]);
                *(u32x4*)(O + (size_t)row * ldo + col0) = w; }
    }
};
struct EpiScaleBf16 {
    static constexpr bool PERM = true, AFTER_DRAIN = false;
    bf16_t* O; int ldo; const float* rs; float inv_d, eps;
    __device__ __forceinline__ void operator()(const f32x4 (&acc)[2][2][4][2], const Unit& u, int wr, int wc, int fr, int fq) const {
        const int row0 = u.pm * BM + wr * 64 + fr, col0 = u.pn * BM + wc * 32 + 8 * fq;
#pragma unroll
        for (int ai = 0; ai < 2; ++ai)
#pragma unroll
            for (int m = 0; m < 4; ++m) { const int row = row0 + ai * HALF + m * 16; const float rinv = rs ? __builtin_amdgcn_rsqf(rs[row] * inv_d + eps) : 1.0f;
                bf16_t* rowp = O + (size_t)row * ldo + col0;
#pragma unroll
                for (int bj = 0; bj < 2; ++bj) { const f32x4 v0 = acc[ai][bj][m][0] * rinv, v1 = acc[ai][bj][m][1] * rinv;
                    u32x4 w; w.x = cvt_pk_bf16(v0[0], v0[1]); w.y = cvt_pk_bf16(v0[2], v0[3]); w.z = cvt_pk_bf16(v1[0], v1[1]); w.w = cvt_pk_bf16(v1[2], v1[3]);
                    *(u32x4*)(rowp + bj * HALF) = w; } }
    }
};
struct EpiF32SS {
    static constexpr bool PERM = false, AFTER_DRAIN = false;
    float* C; int ldc; float* ss;
    __device__ __forceinline__ void operator()(const f32x4 (&acc)[2][2][4][2], const Unit& u, int wr, int wc, int fr, int fq) const {
        const int row0 = u.pm * BM + wr * 64 + fr, col0 = u.pn * BM + wc * 32 + 4 * fq;
#pragma unroll
        for (int ai = 0; ai < 2; ++ai)
#pragma unroll
            for (int m = 0; m < 4; ++m) { const int row = row0 + ai * HALF + m * 16; float* rowp = C + (size_t)row * ldc + col0; float s = 0.f;
#pragma unroll
                for (int bj = 0; bj < 2; ++bj)
#pragma unroll
                    for (int n = 0; n < 2; ++n) { const f32x4 v = acc[ai][bj][m][n]; *(f32x4*)(rowp + bj * HALF + n * 16) = v; s += (v[0] * v[0] + v[1] * v[1]) + (v[2] * v[2] + v[3] * v[3]); }
                (void)s; }
    }
};
struct EpiBranch {
    static constexpr bool PERM = false, AFTER_DRAIN = false;
    float* MIX; bf16_t* MIXG; const bf16_t* Z; int ldz, zg0;
    __device__ __forceinline__ void operator()(const f32x4 (&acc)[2][2][4][2], const Unit& u, int wr, int wc, int fr, int fq) const {
        const int b = u.pm >> 5, pm = u.pm & 31, pn = u.pn & 7;
        const int row0 = pm * BM + wr * 64 + fr, col0 = pn * BM + wc * 32 + 4 * fq;
#pragma unroll
        for (int ai = 0; ai < 2; ++ai)
#pragma unroll
            for (int m = 0; m < 4; ++m) { const int row = row0 + ai * HALF + m * 16; const bf16_t* zp = Z + (size_t)row * ldz + zg0 + b * 2048 + col0; float* mp = MIX + (size_t)row * 2048 + col0; bf16_t* op = MIXG + (size_t)row * 2048 + col0;
#pragma unroll
                for (int bj = 0; bj < 2; ++bj)
#pragma unroll
                    for (int n = 0; n < 2; ++n) { const int co = bj * HALF + n * 16; const u32x2 gz = *(const u32x2*)(zp + co);
                        f32x4 g; g[0] = fast_sigmoid(__uint_as_float(gz.x << 16)); g[1] = fast_sigmoid(__uint_as_float(gz.x & 0xffff0000u)); g[2] = fast_sigmoid(__uint_as_float(gz.y << 16)); g[3] = fast_sigmoid(__uint_as_float(gz.y & 0xffff0000u));
                        f32x4 v = acc[ai][bj][m][n] * g;
                        if (b > 0) { f32x4 o; o[0] = __hip_atomic_load(mp + co + 0, __ATOMIC_RELAXED, __HIP_MEMORY_SCOPE_AGENT); o[1] = __hip_atomic_load(mp + co + 1, __ATOMIC_RELAXED, __HIP_MEMORY_SCOPE_AGENT);
                            o[2] = __hip_atomic_load(mp + co + 2, __ATOMIC_RELAXED, __HIP_MEMORY_SCOPE_AGENT); o[3] = __hip_atomic_load(mp + co + 3, __ATOMIC_RELAXED, __HIP_MEMORY_SCOPE_AGENT); v += o; }
                        if (b < 2) *(f32x4*)(mp + co) = v;
                        else { u32x2 w; w.x = cvt_pk_bf16(v[0], v[1]); w.y = cvt_pk_bf16(v[2], v[3]); *(u32x2*)(op + co) = w; } } }
    }
};
struct EpiPleGate {
    static constexpr bool PERM = false, AFTER_DRAIN = false;
    float* C; int ldc; float* ss; const float* rs; const bf16_t* E; float inv_d, eps;
    __device__ __forceinline__ void operator()(const f32x4 (&acc)[2][2][4][2], const Unit& u, int wr, int wc, int fr, int fq) const {
        const int row0 = u.pm * BM + wr * 64 + fr, col0 = u.pn * BM + wc * 32 + 4 * fq;
#pragma unroll
        for (int ai = 0; ai < 2; ++ai)
#pragma unroll
            for (int m = 0; m < 4; ++m) { const int row = row0 + ai * HALF + m * 16; float* rowp = C + (size_t)row * ldc + col0; const bf16_t* ep = E + (size_t)row * ldc + col0; float s = 0.f;
                const float rinv = __builtin_amdgcn_rsqf(rs[row] * inv_d + eps);
#pragma unroll
                for (int bj = 0; bj < 2; ++bj)
#pragma unroll
                    for (int n = 0; n < 2; ++n) { const int co = bj * HALF + n * 16; const u32x2 ez = *(const u32x2*)(ep + co); f32x4 v = acc[ai][bj][m][n] * rinv;
                        v[0] = fast_sigmoid(v[0]) * __uint_as_float(ez.x << 16); v[1] = fast_sigmoid(v[1]) * __uint_as_float(ez.x & 0xffff0000u);
                        v[2] = fast_sigmoid(v[2]) * __uint_as_float(ez.y << 16); v[3] = fast_sigmoid(v[3]) * __uint_as_float(ez.y & 0xffff0000u);
                        *(f32x4*)(rowp + co) = v; s += (v[0] * v[0] + v[1] * v[1]) + (v[2] * v[2] + v[3] * v[3]); }
                (void)s; }
    }
};
struct BranchOrder {
    int G, c;
    __device__ __forceinline__ bool next(int i, Unit& u) const { const int tile = c + (i / 3) * G, b = i % 3; if (tile >= 256) return false; u.pm = b * 32 + (tile & 31); u.pn = b * 8 + (tile >> 5); return true; }
    __device__ __forceinline__ void a_ready(const Unit&) const {}
    __device__ __forceinline__ void done(const Unit&) const {}
};
template <class Epi, class Sched, bool ALIGN_EPI = false, bool SP2 = false>
__device__ __forceinline__ void gemm_phase(PG8_LAS unsigned char* lds, const Gemm g, const Sched& S, const Epi& E, const int tid_in) {
    const int tid = tid_in, wid = __builtin_amdgcn_readfirstlane(tid >> 6), lane = tid & 63, wr = wid >> 2, wc = wid & 3, fr = lane & 15, fq = lane >> 4;
    const int K = g.K, nt = K / BK;
    unsigned voffA[2], voffB[2];
#pragma unroll
    for (int i = 0; i < 2; ++i) { int R, C; stage_rc(tid * 16 + i * 8192, R, C); const int Rb = Epi::PERM ? ((R & ~31) + perm32(R & 31)) : R;
        voffA[i] = (unsigned)(R * K + C) * 2u; voffB[i] = (unsigned)(Rb * K + C) * 2u; }
    const size_t kstep = (size_t)(BK * 2);
    const size_t hstep = (size_t)HALF * K * 2;
    const size_t tstep = 2 * hstep;
    const unsigned ldsw = (unsigned)wid * 1024u;
    const int aoff = lds_byte(wr * 64 + fr, fq * 8), boff = lds_byte(wc * 32 + fr, fq * 8);
#define PG8_SA(b, h) (((b) * 2 + (h)) * HTB)
#define PG8_SB(b, h) ((4 + (b) * 2 + (h)) * HTB)
#define PG8_STAGE(bufoff, gbase, voff) do { _Pragma("unroll") for (int _i = 0; _i < 2; ++_i) \
        __builtin_amdgcn_global_load_lds((const unsigned*)((const char*)(gbase) + (voff)[_i]), (PG8_LAS unsigned*)(lds + (bufoff) + ldsw + _i * 8192), 16, 0, 0); } while (0)
#define PG8_LDA(dst, b, h) do { _Pragma("unroll") for (int m = 0; m < 4; ++m) _Pragma("unroll") for (int k = 0; k < 2; ++k) dst[m][k] = *(const PG8_LAS bf16x8*)(lds + PG8_SA(b, h) + aoff + m * 2048 + k * 1024); } while (0)
#define PG8_LDB(dst, b, h) do { _Pragma("unroll") for (int n = 0; n < 2; ++n) _Pragma("unroll") for (int k = 0; k < 2; ++k) dst[n][k] = *(const PG8_LAS bf16x8*)(lds + PG8_SB(b, h) + boff + n * 2048 + k * 1024); } while (0)
#define PG8_MMA(ai, bj, At, Bt) do { __builtin_amdgcn_s_setprio(1); _Pragma("unroll") for (int m = 0; m < 4; ++m) _Pragma("unroll") for (int n = 0; n < 2; ++n) _Pragma("unroll") for (int k = 0; k < 2; ++k) \
        acc[ai][bj][m][n] = __builtin_amdgcn_mfma_f32_16x16x32_bf16(Bt[n][k], At[m][k], acc[ai][bj][m][n], 0, 0, 0); __builtin_amdgcn_s_setprio(0); } while (0)
#define PG8_WAIT_V(n) asm volatile("s_waitcnt vmcnt(" #n ")" ::: "memory")
#define PG8_WAIT_L(n) asm volatile("s_waitcnt lgkmcnt(" #n ")" ::: "memory")
#define PG8_BAR __builtin_amdgcn_s_barrier()
#define PG8_SCHED __builtin_amdgcn_sched_barrier(0)
    Unit cur, nxt; int ui = 0;
    if (!S.next(0, cur)) return;
    f32x4 acc[2][2][4][2];
#pragma unroll
    for (int a = 0; a < 2; ++a)
#pragma unroll
        for (int b = 0; b < 2; ++b)
#pragma unroll
            for (int m = 0; m < 4; ++m)
#pragma unroll
                for (int n = 0; n < 2; ++n) acc[a][b][m][n] = (f32x4){0.f, 0.f, 0.f, 0.f};
    bf16x8 At[4][2], B0[2][2], B1[2][2];
    const char* cA = (const char*)g.A + (size_t)cur.pm * tstep; const char* cB = (const char*)g.Bt + (size_t)cur.pn * tstep;
    S.a_ready(cur);
    if constexpr (SP2) {
        PG8_STAGE(PG8_SB(0, 0), cB, voffB); PG8_STAGE(PG8_SB(0, 1), cB + hstep, voffB); PG8_STAGE(PG8_SA(0, 0), cA, voffA); PG8_STAGE(PG8_SA(0, 1), cA + hstep, voffA);
        if (wr == 1) PG8_BAR;
        PG8_WAIT_V(2); PG8_BAR;
        PG8_STAGE(PG8_SB(1, 0), cB + kstep, voffB); PG8_STAGE(PG8_SA(1, 0), cA + kstep, voffA); PG8_STAGE(PG8_SB(1, 1), cB + hstep + kstep, voffB);
        PG8_WAIT_V(6); PG8_BAR;
    } else {
        PG8_STAGE(PG8_SB(0, 0), cB, voffB); PG8_STAGE(PG8_SA(0, 0), cA, voffA); PG8_STAGE(PG8_SB(0, 1), cB + hstep, voffB); PG8_STAGE(PG8_SA(0, 1), cA + hstep, voffA);
        if (wr == 1) PG8_BAR;
        PG8_WAIT_V(4); PG8_BAR;
        PG8_STAGE(PG8_SB(1, 0), cB + kstep, voffB); PG8_STAGE(PG8_SA(1, 0), cA + kstep, voffA); PG8_STAGE(PG8_SB(1, 1), cB + hstep + kstep, voffB);
        PG8_WAIT_V(6); PG8_BAR;
    }
    for (;;) {
        const bool has_next = S.next(ui + 1, nxt);
        const char* nA = has_next ? (const char*)g.A + (size_t)nxt.pm * tstep : cA; const char* nB = has_next ? (const char*)g.Bt + (size_t)nxt.pn * tstep : cB;
        for (int t = 0; t < nt; t += 2) {
            const bool last = (t == nt - 2);
            const char* a1 = cA + (size_t)(t + 1) * kstep;
            const char* a2 = last ? nA : cA + (size_t)(t + 2) * kstep; const char* b2 = last ? nB : cB + (size_t)(t + 2) * kstep;
            const char* a3 = a2 + kstep; const char* b3 = b2 + kstep;
            if (last && has_next) S.a_ready(nxt);
            if constexpr (SP2) {
            PG8_LDB(B0, 0, 0); PG8_LDB(B1, 0, 1); PG8_SCHED; PG8_LDA(At, 0, 0); PG8_STAGE(PG8_SA(1, 1), a1 + hstep, voffA);
            PG8_WAIT_V(8); PG8_WAIT_L(0); PG8_BAR; PG8_MMA(0, 0, At, B0); PG8_MMA(0, 1, At, B1); PG8_BAR; PG8_SCHED;
            PG8_LDA(At, 0, 1); PG8_STAGE(PG8_SB(0, 0), b2, voffB); PG8_STAGE(PG8_SB(0, 1), b2 + hstep, voffB); PG8_STAGE(PG8_SA(0, 0), a2, voffA);
            PG8_WAIT_V(8); PG8_WAIT_L(0); PG8_BAR; PG8_MMA(1, 0, At, B0); PG8_MMA(1, 1, At, B1); PG8_BAR; PG8_SCHED;
            PG8_LDB(B0, 1, 0); PG8_LDB(B1, 1, 1); PG8_SCHED; PG8_LDA(At, 1, 0); PG8_STAGE(PG8_SA(0, 1), a2 + hstep, voffA);
            PG8_WAIT_V(8); PG8_WAIT_L(0); PG8_BAR; PG8_MMA(0, 0, At, B0); PG8_MMA(0, 1, At, B1); PG8_BAR; PG8_SCHED;
            PG8_LDA(At, 1, 1); PG8_STAGE(PG8_SB(1, 0), b3, voffB); PG8_STAGE(PG8_SB(1, 1), b3 + hstep, voffB); PG8_STAGE(PG8_SA(1, 0), a3, voffA);
            PG8_WAIT_V(8); PG8_WAIT_L(0); PG8_BAR; PG8_MMA(1, 0, At, B0); PG8_MMA(1, 1, At, B1); PG8_BAR; PG8_SCHED;
            } else {
            PG8_LDB(B0, 0, 0); PG8_SCHED; PG8_LDA(At, 0, 0); PG8_STAGE(PG8_SA(1, 1), a1 + hstep, voffA);
            PG8_WAIT_L(8); PG8_BAR; PG8_WAIT_L(0); PG8_MMA(0, 0, At, B0); PG8_BAR; PG8_SCHED;
            PG8_LDB(B1, 0, 1); PG8_STAGE(PG8_SB(0, 0), b2, voffB);
            PG8_BAR; PG8_WAIT_L(0); PG8_MMA(0, 1, At, B1); PG8_BAR;
            PG8_LDA(At, 0, 1); PG8_STAGE(PG8_SA(0, 0), a2, voffA);
            PG8_BAR; PG8_WAIT_L(0); PG8_MMA(1, 0, At, B0); PG8_BAR; PG8_SCHED;
            PG8_STAGE(PG8_SB(0, 1), b2 + hstep, voffB);
            PG8_WAIT_V(6); PG8_BAR; PG8_MMA(1, 1, At, B1); PG8_BAR;
            PG8_LDB(B0, 1, 0); PG8_SCHED; PG8_LDA(At, 1, 0); PG8_STAGE(PG8_SA(0, 1), a2 + hstep, voffA);
            PG8_WAIT_L(8); PG8_BAR; PG8_WAIT_L(0); PG8_MMA(0, 0, At, B0); PG8_BAR; PG8_SCHED;
            PG8_LDB(B1, 1, 1); PG8_STAGE(PG8_SB(1, 0), b3, voffB);
            PG8_BAR; PG8_WAIT_L(0); PG8_MMA(0, 1, At, B1); PG8_BAR;
            PG8_LDA(At, 1, 1); PG8_STAGE(PG8_SA(1, 0), a3, voffA);
            PG8_BAR; PG8_WAIT_L(0); PG8_MMA(1, 0, At, B0); PG8_BAR; PG8_SCHED;
            PG8_STAGE(PG8_SB(1, 1), b3 + hstep, voffB);
            PG8_WAIT_V(6); PG8_BAR; PG8_MMA(1, 1, At, B1); PG8_BAR;
            }
        }
        if constexpr (ALIGN_EPI) { if (wr == 0) PG8_BAR; }
        if constexpr (!Epi::AFTER_DRAIN) { E(acc, cur, wr, wc, fr, fq); S.done(cur); }
        if (!has_next) break;
#pragma unroll
        for (int a = 0; a < 2; ++a)
#pragma unroll
            for (int b = 0; b < 2; ++b)
#pragma unroll
                for (int m = 0; m < 4; ++m)
#pragma unroll
                    for (int n = 0; n < 2; ++n) acc[a][b][m][n] = (f32x4){0.f, 0.f, 0.f, 0.f};
        cur = nxt; cA = nA; cB = nB; ++ui;
        if constexpr (ALIGN_EPI) { if (wr == 1) PG8_BAR; }
    }
    PG8_WAIT_V(0);
    if constexpr (!ALIGN_EPI) { if (wr == 0) PG8_BAR; }
    PG8_BAR;
    if constexpr (Epi::AFTER_DRAIN) { E.fused(acc, cur, wr, wc, fr, fq, lds, wid, lane); S.done(cur); }
#undef PG8_SA
#undef PG8_SB
#undef PG8_STAGE
#undef PG8_LDA
#undef PG8_LDB
#undef PG8_MMA
#undef PG8_WAIT_V
#undef PG8_WAIT_L
#undef PG8_BAR
#undef PG8_SCHED
}
}
constexpr int T = 8192, D = 2048, FF = 5632, NL = 4, PLE = 256, NIN = 14968;
constexpr int NZ = 15104;
constexpr int ZR = 0, ZK = 1024, ZV = 2048, ZWD = 3072, ZAD = 3136, ZGD = 3200;
constexpr int ZDQ = 3360, ZCKV = 4384, ZQI = 4640, ZKI = 5664, ZWI = 5728;
constexpr int ZMQ = 5760, ZMK = 6272, ZMV = 6784, ZMO = 7808, ZMI = 8832, ZMF = 8836;
constexpr int ZG = 8864;
constexpr float EPS = 1e-6f;
constexpr int NWAVES = 8, NTHR = 512;

constexpr size_t MiB = 1u << 20;
constexpr size_t WS_CTL = 0, CTL_ZERO_BYTES = 1 * MiB;
constexpr size_t WS_WGU1 = 1 * MiB;
constexpr size_t WS_WD1 = WS_WGU1 + 44 * MiB;
constexpr size_t WS_WIN = WS_WD1 + 22 * MiB;
constexpr size_t WS_WBR = WS_WIN + 59 * MiB;
constexpr size_t WS_WOUT = WS_WBR + 12 * MiB;
constexpr size_t WS_WGU2 = WS_WOUT + 8 * MiB;
constexpr size_t WS_WD2 = WS_WGU2 + 44 * MiB;
constexpr size_t WS_WPG = WS_WD2 + 22 * MiB;
constexpr size_t WS_WPP = WS_WPG + 8 * MiB;
constexpr size_t WS_WLW = WS_WPP + 1 * MiB;
constexpr size_t WS_WLA = WS_WLW + 128 * 1024;
constexpr size_t WS_WLG = WS_WLA + 128 * 1024;
constexpr size_t WS_WUK = WS_WLG + 512 * 1024;
constexpr size_t WS_WUV = WS_WUK + 512 * 1024;
constexpr size_t WS_ACT0 = 224 * MiB;
static_assert(WS_WUV + 512 * 1024 <= WS_ACT0, "weights region");
constexpr size_t WS_HB = WS_ACT0;
constexpr size_t WS_ACT = WS_HB + 32 * MiB;
constexpr size_t WS_F = WS_ACT + 88 * MiB;
constexpr size_t WS_Z = WS_F + 64 * MiB;
constexpr size_t WS_RS = WS_Z + 236 * MiB;
constexpr size_t WS_FSS = WS_RS + 64 * 1024;
constexpr size_t WS_MISC = WS_FSS + 64 * 1024;
constexpr size_t WS_RW = WS_MISC + 896 * 1024;
constexpr size_t RW_STRIDE = 32 * MiB;
constexpr size_t WS_DSA = WS_RW + 9 * RW_STRIDE;
constexpr size_t WS_DC = WS_DSA;
constexpr size_t WS_DKI = WS_DC + 4 * MiB;
constexpr size_t WS_DWI = WS_DKI + 1 * MiB;
constexpr size_t WS_DIDX = WS_DWI + 1 * MiB;
constexpr size_t WS_DQL = WS_DIDX + 8 * MiB;
constexpr size_t WS_DOL = WS_DQL + 32 * MiB;
constexpr size_t WS_DSC = WS_DOL + 32 * MiB;
constexpr size_t WS_ML = WS_DSC + 256 * MiB;
constexpr size_t WS_MQK = WS_ML;
constexpr size_t WS_MKL = WS_MQK + 16 * MiB;
constexpr size_t WS_MCS = WS_MKL + 32 * MiB;
constexpr size_t WS_MSM = WS_MCS + 16 * MiB;
constexpr size_t WS_Y = WS_MSM + 2 * MiB;
constexpr size_t WS_MIXG = WS_Y + 48 * MiB;
constexpr size_t WS_E = WS_MIXG + 32 * MiB;
constexpr size_t WS_PB = WS_E + 32 * MiB;
constexpr size_t WS_END = WS_PB + 4 * MiB;
static_assert(WS_END <= (size_t)1800 * MiB, "workspace budget");
constexpr int CW_TMO = 0, CW_BAR = 4096;

constexpr int LDS_BYTES = 147456;
constexpr int LDSCTL_OFF = 146432, MISC_OFF = LDSCTL_OFF + 256;

#define GAS __attribute__((address_space(1)))
#define LAS __attribute__((address_space(3)))
#define DI __device__ __forceinline__
typedef unsigned short bf16;
typedef unsigned v4u __attribute__((ext_vector_type(4)));
typedef unsigned v2u __attribute__((ext_vector_type(2)));
typedef float f32x4 __attribute__((ext_vector_type(4)));
typedef float f32x2 __attribute__((ext_vector_type(2)));
typedef short bf16x8 __attribute__((ext_vector_type(8)));
typedef short bf16x4 __attribute__((ext_vector_type(4)));
typedef GAS unsigned gu32;
#define RLX_AGENT __ATOMIC_RELAXED, __HIP_MEMORY_SCOPE_AGENT
#define LDS_WAIT() asm volatile("s_waitcnt lgkmcnt(0)" ::: "memory")
#define VM_WAIT() asm volatile("s_waitcnt vmcnt(0)" ::: "memory")
DI unsigned f2bf(float f) { unsigned u = __builtin_bit_cast(unsigned, f); return (u + 0x7fffu + ((u >> 16) & 1u)) >> 16; }
DI unsigned pk2(float lo, float hi) { return f2bf(lo) | (f2bf(hi) << 16); }
DI float bf2f(unsigned short b) { return __uint_as_float(((unsigned)b) << 16); }
DI float bflo(unsigned w) { return __uint_as_float(w << 16); }
DI float bfhi(unsigned w) { return __uint_as_float(w & 0xffff0000u); }
DI float fexp(float x) { return __builtin_amdgcn_exp2f(x * 1.44269504089f); }
DI float flog(float x) { return __builtin_amdgcn_logf(x) * 0.69314718056f; }
DI float frcp(float x) { return __builtin_amdgcn_rcpf(x); }
DI float sigmoidf_(float x) { return frcp(1.0f + fexp(-x)); }
DI float ftanh(float x) { const float e = fexp(-2.0f * fabsf(x)); const float t = (1.0f - e) * frcp(1.0f + e); return x < 0.f ? -t : t; }
DI float flog_sigmoid(float x) { return fminf(x, 0.f) - flog(1.0f + fexp(-fabsf(x))); }
DI float wave_sum(float v) {
#pragma unroll
    for (int o = 1; o < 64; o <<= 1) v += __shfl_xor(v, o);
    return v;
}
DI float wave_max(float v) {
#pragma unroll
    for (int o = 1; o < 64; o <<= 1) v = fmaxf(v, __shfl_xor(v, o));
    return v;
}
#define MFMA16(a, b, c) __builtin_amdgcn_mfma_f32_16x16x32_bf16((a), (b), (c), 0, 0, 0)
#define MFMA32(a, b, c) __builtin_amdgcn_mfma_f32_32x32x16_bf16((a), (b), (c), 0, 0, 0)
typedef float f32x16 __attribute__((ext_vector_type(16)));
DI bf16x4 tr_read(unsigned lds_addr) { bf16x4 r; asm volatile("ds_read_b64_tr_b16 %0, %1\n\ts_waitcnt lgkmcnt(0)" : "=&v"(r) : "v"(lds_addr) : "memory"); return r; }
DI bf16x8 cat8(bf16x4 lo, bf16x4 hi) { return __builtin_shufflevector(lo, hi, 0, 1, 2, 3, 4, 5, 6, 7); }
#define XB_TMO      128
#define XB_XCNT(j)  (256  + 64 * (j))
#define XB_XSUB(j)  (1280 + 64 * (j))
#define XB_XGEN(j)  (2304 + 64 * (j))
#define XB_TOP      3328
#define XB_TOPGEN   3392
#define XCD_BAR_WORDS 3456
#define XB_SPIN_CAP (1u << 18)

__device__ __forceinline__ unsigned xb_ld(unsigned* p)              { return __hip_atomic_load(p, __ATOMIC_RELAXED, __HIP_MEMORY_SCOPE_AGENT); }
__device__ __forceinline__ unsigned xb_add(unsigned* p, unsigned v) { return __hip_atomic_fetch_add(p, v, __ATOMIC_RELAXED, __HIP_MEMORY_SCOPE_AGENT); }
__device__ __forceinline__ unsigned xb_xcc_id() { return (unsigned)__builtin_amdgcn_s_getreg((3 << 11) | 20) & 0xFu; }
#define XB_SPIN(cond, bar) do { unsigned _sp = 0; while (cond) { __builtin_amdgcn_s_sleep(1); \
    if ((++_sp & 255u) == 0u) { if (xb_ld(&(bar)[XB_TMO])) break; if (_sp > XB_SPIN_CAP) { atomicAdd(&(bar)[XB_TMO], 1u); break; } } } } while (0)

struct XcdBarrier {
    unsigned* bar; unsigned x; bool t0;
    volatile LAS unsigned* st;
};

__device__ __forceinline__ XcdBarrier xcd_barrier_post(unsigned* bar, volatile LAS unsigned* st) {
    XcdBarrier b; b.bar = bar; b.x = xb_xcc_id(); b.st = st;
    if (threadIdx.x == 0) (void)xb_add(&bar[XB_XCNT(b.x)], 1u);
    return b;
}
__device__ __forceinline__ void xcd_barrier_complete(unsigned* bar, unsigned x, unsigned& nloc, unsigned& nx) {
    const unsigned G = gridDim.x * gridDim.y * gridDim.z;
    unsigned sum, cnt, mine, sp = 0u;
    for (;;) {
        sum = 0u; cnt = 0u; mine = 0u;
#pragma unroll
        for (unsigned j = 0; j < 16; ++j) { const unsigned c = xb_ld(&bar[XB_XCNT(j)]); sum += c; cnt += (c > 0u) ? 1u : 0u; mine = (j == x) ? c : mine; }
        if (sum == G) break;
        __builtin_amdgcn_s_sleep(1);
        if ((++sp & 255u) == 0u) { if (xb_ld(&bar[XB_TMO])) break; if (sp > XB_SPIN_CAP) { atomicAdd(&bar[XB_TMO], 1u); break; } }
    }
    nloc = mine > 0u ? mine : 1u; nx = cnt > 0u ? cnt : 1u;
}

__device__ __forceinline__ void xcd_barrier(const XcdBarrier& b) {
    asm volatile("s_waitcnt vmcnt(0)" ::: "memory");
    __syncthreads();
    if (b.t0) {
        unsigned* bar = b.bar;
        __builtin_amdgcn_s_waitcnt(0);
        unsigned nloc = b.st[0], nx = b.st[1];
        if (nloc == 0u) { xcd_barrier_complete(bar, b.x, nloc, nx); b.st[0] = nloc; b.st[1] = nx; }
        const unsigned old = xb_add(&bar[XB_XSUB(b.x)], 1u);
        const unsigned gen = old / nloc;
        if (old + 1u == (gen + 1u) * nloc) {
            __builtin_amdgcn_fence(__ATOMIC_RELEASE, "agent");
            asm volatile("s_waitcnt vmcnt(0)" ::: "memory");
            const unsigned og = xb_add(&bar[XB_TOP], 1u);
            const unsigned tg = og / nx;
            if (og + 1u == (tg + 1u) * nx) xb_add(&bar[XB_TOPGEN], 1u);
            else XB_SPIN(xb_ld(&bar[XB_TOPGEN]) == tg, bar);
            __builtin_amdgcn_fence(__ATOMIC_ACQUIRE, "agent");
            xb_add(&bar[XB_XGEN(b.x)], 1u);
            asm volatile("s_waitcnt vmcnt(0)" ::: "memory");
        } else {
            XB_SPIN(xb_ld(&bar[XB_XGEN(b.x)]) == gen, bar);
            __builtin_amdgcn_fence(__ATOMIC_ACQUIRE, "agent");
            asm volatile("s_waitcnt vmcnt(0)" ::: "memory");
        }
    }
    __syncthreads();
}
struct Ctx { LAS unsigned char* lds; unsigned char* ws; int tid, lane, wave, gw, NGW, G, bid; };
struct Args { const float* in[34]; float* out; unsigned char* ws; int ph_lo, ph_hi; };
struct InTab { const Args* a; DI const float* operator[](int i) const { asm volatile("" : "+s"(i)); return (const float*)(const GAS float*)a->in[i]; } };
DI unsigned char* opaque_ws(const Args& args) { const unsigned long long w0_ = (unsigned long long)args.ws; unsigned wl_ = __builtin_amdgcn_readfirstlane((unsigned)w0_), wh_ = __builtin_amdgcn_readfirstlane((unsigned)(w0_ >> 32)); asm volatile("" : "+s"(wl_), "+s"(wh_)); return (unsigned char*)(GAS unsigned char*)(((unsigned long long)wh_ << 32) | wl_); }
DI int lane_id() { int l; asm volatile("v_mbcnt_lo_u32_b32 %0, -1, 0\n\tv_mbcnt_hi_u32_b32 %0, -1, %0" : "=v"(l)); return l; }
DI Ctx make_ctx(const Args& args, LAS unsigned char* lds, int wave_s) {
    Ctx F; int tid = wave_s * 64 + lane_id(); asm volatile("" : "+v"(tid));
    const unsigned long long w0_ = (unsigned long long)args.ws; unsigned wl_ = __builtin_amdgcn_readfirstlane((unsigned)w0_), wh_ = __builtin_amdgcn_readfirstlane((unsigned)(w0_ >> 32)); asm volatile("" : "+s"(wl_), "+s"(wh_)); const unsigned long long w = ((unsigned long long)wh_ << 32) | wl_;
    int bid = __builtin_amdgcn_readfirstlane((int)blockIdx.x), G = __builtin_amdgcn_readfirstlane((int)gridDim.x); asm volatile("" : "+s"(bid), "+s"(G));
    F.lds = lds; F.ws = (unsigned char*)(GAS unsigned char*)w; F.tid = tid; F.lane = tid & 63; F.wave = __builtin_amdgcn_readfirstlane(tid >> 6);
    F.G = G; F.bid = bid; F.gw = bid * NWAVES + F.wave; F.NGW = G * NWAVES; return F;
}

DI void tr_item(const float* W, int ldn, int K, const float* gain, float scale, bf16* WT, int drow, int nvalid, int nwrite, int k0, LAS float* scr, int lane) {
    float v[64];
    const float* wp = W + (size_t)k0 * ldn + lane;
    if (lane < nvalid) {
#pragma unroll
        for (int kk = 0; kk < 64; ++kk) v[kk] = wp[(size_t)kk * ldn];
    } else {
#pragma unroll
        for (int kk = 0; kk < 64; ++kk) v[kk] = 0.f;
    }
    if (gain) {
#pragma unroll
        for (int kk = 0; kk < 64; ++kk) v[kk] *= gain[k0 + kk] * scale;
    } else if (scale != 1.f) {
#pragma unroll
        for (int kk = 0; kk < 64; ++kk) v[kk] *= scale;
    }
#pragma unroll
    for (int kk = 0; kk < 64; ++kk) scr[kk * 65 + lane] = v[kk];
    LDS_WAIT(); asm volatile("" ::: "memory");
    const int c8 = lane & 7;
#pragma unroll
    for (int j = 0; j < 8; ++j) { const int n = (lane >> 3) + 8 * j; const LAS float* s = scr + (8 * c8) * 65 + n;
        v4u o; o.x = pk2(s[0 * 65], s[1 * 65]); o.y = pk2(s[2 * 65], s[3 * 65]); o.z = pk2(s[4 * 65], s[5 * 65]); o.w = pk2(s[6 * 65], s[7 * 65]);
        if (n < nwrite) *(v4u*)(WT + (size_t)(drow + n) * K + k0 + 8 * c8) = o; }
    LDS_WAIT(); asm volatile("" ::: "memory");
}
DI void conv_seg(const Ctx& F, const float* W, int ldn, int K, int ncols, int nsrc, const float* gain, float scale, bf16* WT, int dst0, int kind, int& base, LAS float* scr) {
    const int nblk = (ncols + 63) / 64, nitems = (K / 64) * nblk;
    const int start = (F.gw - base % F.NGW + F.NGW) % F.NGW;
    for (int it = start; it < nitems; it += F.NGW) {
        const int kb = it / nblk, nb = it - kb * nblk, n0 = nb * 64; int nvalid = nsrc - n0; nvalid = nvalid < 0 ? 0 : (nvalid > 64 ? 64 : nvalid); int nwrite = ncols - n0; nwrite = nwrite > 64 ? 64 : nwrite;
        const int drow = kind ? (256 * (n0 >> 7) + dst0 + (n0 & 127)) : (dst0 + n0);
        tr_item(W + n0, ldn, K, gain, scale, WT, drow, nvalid, nwrite, kb * 64, scr, F.lane);
    }
    base += nitems;
}
DI void phase_conv(const Ctx& F, const InTab in, int l) {
    LAS float* scr = (LAS float*)(F.lds + F.wave * 16640);
    unsigned char* ws = F.ws; int base = 0;
    const float* ng = in[2] + (size_t)l * 8 * D;
    conv_seg(F, in[3] + (size_t)l * D * FF, FF, D, FF, FF, ng + 0 * D, 1.f, (bf16*)(ws + WS_WGU1), 0, 1, base, scr);
    conv_seg(F, in[4] + (size_t)l * D * FF, FF, D, FF, FF, ng + 0 * D, 1.f, (bf16*)(ws + WS_WGU1), 128, 1, base, scr);
    conv_seg(F, in[5] + (size_t)l * FF * D, D, FF, D, D, nullptr, 1.f, (bf16*)(ws + WS_WD1), 0, 0, base, scr);
    { const float* W = in[6] + (size_t)l * D * NIN; bf16* WT = (bf16*)(ws + WS_WIN); const float* g2 = ng + 2 * D;
      conv_seg(F, W + 0, NIN, D, 3360, 3360, g2, 1.f, WT, 0, 0, base, scr);
      conv_seg(F, W + 3360, NIN, D, 2400, 2384, g2, 1.f, WT, ZDQ, 0, base, scr);
      conv_seg(F, W + 5744, NIN, D, 3104, 3080, g2, 1.f, WT, ZMQ, 0, base, scr);
      conv_seg(F, W + 8824, NIN, D, 6144, 6144, g2, 1.f, WT, ZG, 0, base, scr);
      conv_seg(F, W, NIN, D, 96, 0, g2, 1.f, WT, 15008, 0, base, scr); }
    for (int b = 0; b < 3; ++b) conv_seg(F, in[27] + ((size_t)l * 3 + b) * 1024 * D, D, 1024, D, D, nullptr, 1.f, (bf16*)(ws + WS_WBR) + (size_t)b * D * 1024, 0, 0, base, scr);
    conv_seg(F, in[28] + (size_t)l * D * D, D, D, D, D, nullptr, 1.f, (bf16*)(ws + WS_WOUT), 0, 0, base, scr);
    conv_seg(F, in[29] + (size_t)l * D * FF, FF, D, FF, FF, ng + 4 * D, 1.f, (bf16*)(ws + WS_WGU2), 0, 1, base, scr);
    conv_seg(F, in[30] + (size_t)l * D * FF, FF, D, FF, FF, ng + 4 * D, 1.f, (bf16*)(ws + WS_WGU2), 128, 1, base, scr);
    conv_seg(F, in[31] + (size_t)l * FF * D, D, FF, D, D, nullptr, 1.f, (bf16*)(ws + WS_WD2), 0, 0, base, scr);
    conv_seg(F, in[33] + (size_t)l * D * D, D, D, D, D, ng + 6 * D, 1.f, (bf16*)(ws + WS_WPG), 0, 0, base, scr);
    conv_seg(F, in[32] + (size_t)l * PLE * D, D, PLE, D, D, nullptr, 1.f, (bf16*)(ws + WS_WPP), 0, 0, base, scr);
    conv_seg(F, in[9] + (size_t)l * 64 * 1024, 1024, 64, 1024, 1024, nullptr, 1.f, (bf16*)(ws + WS_WLW), 0, 0, base, scr);
    conv_seg(F, in[11] + (size_t)l * 64 * 1024, 1024, 64, 1024, 1024, nullptr, 1.f, (bf16*)(ws + WS_WLA), 0, 0, base, scr);
    for (int h = 0; h < 8; ++h) conv_seg(F, in[20] + ((size_t)l * 8 + h) * 128 * 256, 256, 128, 256, 256, nullptr, 0.08838834764831845f, (bf16*)(ws + WS_WUK) + (size_t)h * 256 * 128, 0, 0, base, scr);
    for (int h = 0; h < 8; ++h) conv_seg(F, in[21] + ((size_t)l * 8 + h) * 256 * 128, 128, 256, 128, 128, nullptr, 1.f, (bf16*)(ws + WS_WUV) + (size_t)h * 128 * 256, 0, 0, base, scr);
    { const float* W = in[12] + (size_t)l * 160 * 1024; bf16* WT = (bf16*)(ws + WS_WLG);
      for (int i = F.bid * NTHR + F.tid; i < 1024 * 160; i += F.G * NTHR) { const int n = i / 160, k = i - n * 160; WT[i] = (bf16)f2bf(W[(size_t)k * 1024 + n]); } }
    { const f32x4* P = (const f32x4*)(in[1] + (size_t)l * T * PLE); v2u* PB = (v2u*)(ws + WS_PB);
      for (int i = F.bid * NTHR + F.tid; i < T * PLE / 4; i += F.G * NTHR) { const f32x4 v = P[i]; v2u o; o.x = pk2(v[0], v[1]); o.y = pk2(v[2], v[3]); PB[i] = o; } }
}

template <bool INIT>
DI void phase_resid(const Ctx& F, const float* src, const float* gain, float alpha, float* h) {
    bf16* hb = (bf16*)(F.ws + WS_HB); float* rs = (float*)(F.ws + WS_RS);
    f32x4 g[8];
    if (!INIT) {
#pragma unroll
        for (int j = 0; j < 8; ++j) g[j] = *(const f32x4*)(gain + 4 * F.lane + 256 * j);
    }
    for (int m = F.gw; m < T; m += F.NGW) {
        const f32x4* sr = (const f32x4*)(src + (size_t)m * D) + F.lane; f32x4* hr = (f32x4*)(h + (size_t)m * D) + F.lane;
        v2u* ob = (v2u*)(hb + (size_t)m * D) + F.lane;
        f32x4 v[8]; float fs = 0.f;
#pragma unroll
        for (int j = 0; j < 8; ++j) { v[j] = sr[64 * j]; fs += (v[j][0] * v[j][0] + v[j][1] * v[j][1]) + (v[j][2] * v[j][2] + v[j][3] * v[j][3]); }
        float rinv = 0.f; if (!INIT) rinv = alpha * __builtin_amdgcn_rsqf(wave_sum(fs) * (1.0f / D) + EPS);
        float s2 = 0.f;
#pragma unroll
        for (int j = 0; j < 8; ++j) {
            f32x4 x = v[j];
            if (!INIT) x = hr[64 * j] + x * rinv * g[j];
            hr[64 * j] = x; v2u o; o.x = pk2(x[0], x[1]); o.y = pk2(x[2], x[3]); ob[64 * j] = o;
            s2 += (x[0] * x[0] + x[1] * x[1]) + (x[2] * x[2] + x[3] * x[3]);
        }
        s2 = wave_sum(s2);
        if (F.lane == 0) rs[m] = s2;
    }
}

DI void wave_gemm32_bf16(const bf16* A, int lda, const bf16* Bt, int ldb, int K, bf16* O, int ldo, int lane) {
    const int r = lane & 15, q = lane >> 4;
    f32x4 acc[2][2];
#pragma unroll
    for (int i = 0; i < 2; ++i)
#pragma unroll
        for (int j = 0; j < 2; ++j) acc[i][j] = (f32x4){0.f, 0.f, 0.f, 0.f};
    for (int k0 = 0; k0 < K; k0 += 32) {
        bf16x8 a[2], b[2];
#pragma unroll
        for (int i = 0; i < 2; ++i) { a[i] = *(const bf16x8*)(A + (size_t)(16 * i + r) * lda + k0 + 8 * q); b[i] = *(const bf16x8*)(Bt + (size_t)(16 * i + r) * ldb + k0 + 8 * q); }
#pragma unroll
        for (int i = 0; i < 2; ++i)
#pragma unroll
            for (int j = 0; j < 2; ++j) acc[i][j] = MFMA16(b[j], a[i], acc[i][j]);
    }
#pragma unroll
    for (int i = 0; i < 2; ++i)
#pragma unroll
        for (int j = 0; j < 2; ++j) { v2u w; w.x = pk2(acc[i][j][0], acc[i][j][1]); w.y = pk2(acc[i][j][2], acc[i][j][3]); *(v2u*)(O + (size_t)(16 * i + r) * ldo + 16 * j + 4 * q) = w; }
}
DI float* rwbuf(const Ctx& F, int i) { return (float*)(F.ws + WS_RW + (size_t)i * RW_STRIDE); }
enum { RW_R = 0, RW_W = 1, RW_K = 2, RW_V = 3, RW_AA = 4, RW_BB = 5, RW_G = 6, RW_Y = 7 };
DI f32x4 shift4(const bf16* Z, int t, int col, const float* mu) {
    const v2u c = *(const v2u*)(Z + (size_t)t * NZ + col); v2u p = (v2u){0u, 0u}; if (t > 0) p = *(const v2u*)(Z + (size_t)(t - 1) * NZ + col);
    const f32x4 m = *(const f32x4*)(mu + col);
    f32x4 cv = (f32x4){bflo(c.x), bfhi(c.x), bflo(c.y), bfhi(c.y)}, pv = (f32x4){bflo(p.x), bfhi(p.x), bflo(p.y), bfhi(p.y)};
    return cv + (pv - cv) * m;
}
DI void phase_rw_prep(const Ctx& F, const InTab in, int l) {
    const bf16* Z = (const bf16*)(F.ws + WS_Z);
    const float* mu = in[7] + (size_t)l * 3360; const float* w0 = in[8] + (size_t)l * 1024; const float* a0 = in[10] + (size_t)l * 1024;
    const float* k_k = in[13] + (size_t)l * 1024; const float* k_a = in[14] + (size_t)l * 1024;
    const bf16* WLW = (const bf16*)(F.ws + WS_WLW); const bf16* WLA = (const bf16*)(F.ws + WS_WLA); const bf16* WLG = (const bf16*)(F.ws + WS_WLG);
    float* R = rwbuf(F, RW_R); float* W = rwbuf(F, RW_W); float* K2 = rwbuf(F, RW_K); float* V = rwbuf(F, RW_V); float* AA = rwbuf(F, RW_AA); float* BB = rwbuf(F, RW_BB); float* G = rwbuf(F, RW_G);
    LAS bf16* As = (LAS bf16*)F.lds;
    const int r = F.lane & 15, q = F.lane >> 4;
    for (int tile = F.bid; tile < T / 16; tile += F.G) {
        const int t0 = tile * 16;
        for (int i = F.tid; i < 16 * 288; i += NTHR) { const int row = i / 288, c = i - row * 288, t = t0 + row, zc = ZWD + c;
            const float cur = bf2f(Z[(size_t)t * NZ + zc]); const float prev = t > 0 ? bf2f(Z[(size_t)(t - 1) * NZ + zc]) : 0.f;
            const float zs = cur + (prev - cur) * mu[zc];
            const float val = c < 64 ? ftanh(zs) : (c < 128 ? zs : sigmoidf_(zs));
            As[row * 296 + c] = (bf16)f2bf(val); }
        __syncthreads();
        bf16x8 aw[2], aa[2], ag[5];
#pragma unroll
        for (int s = 0; s < 2; ++s) { aw[s] = *(const LAS bf16x8*)(As + r * 296 + 32 * s + 8 * q); aa[s] = *(const LAS bf16x8*)(As + r * 296 + 64 + 32 * s + 8 * q); }
#pragma unroll
        for (int s = 0; s < 5; ++s) ag[s] = *(const LAS bf16x8*)(As + r * 296 + 128 + 32 * s + 8 * q);
        const int t = t0 + r;
#pragma unroll 1
        for (int hh = 0; hh < 2; ++hh) {
            f32x4 kraw[4], av[4]; float ssq = 0.f;
#pragma unroll
            for (int ct = 0; ct < 4; ++ct) {
                const int n0 = F.wave * 128 + hh * 64 + ct * 16, n = n0 + 4 * q;
                f32x4 cw = (f32x4){0.f, 0.f, 0.f, 0.f}, ca = cw, cg = cw;
#pragma unroll
                for (int s = 0; s < 2; ++s) { cw = MFMA16(*(const bf16x8*)(WLW + (size_t)(n0 + r) * 64 + 32 * s + 8 * q), aw[s], cw); ca = MFMA16(*(const bf16x8*)(WLA + (size_t)(n0 + r) * 64 + 32 * s + 8 * q), aa[s], ca); }
#pragma unroll
                for (int s = 0; s < 5; ++s) cg = MFMA16(*(const bf16x8*)(WLG + (size_t)(n0 + r) * 160 + 32 * s + 8 * q), ag[s], cg);
                const f32x4 w0v = *(const f32x4*)(w0 + n), a0v = *(const f32x4*)(a0 + n), kkv = *(const f32x4*)(k_k + n), kav = *(const f32x4*)(k_a + n);
                const f32x4 rs_ = shift4(Z, t, ZR + n, mu), ks_ = shift4(Z, t, ZK + n, mu), vs_ = shift4(Z, t, ZV + n, mu);
                f32x4 dec, a, k2;
#pragma unroll
                for (int j = 0; j < 4; ++j) { const float wl = w0v[j] + cw[j]; const float ls = flog_sigmoid(wl);
                    dec[j] = fexp(-fexp(ls - 0.5f)); a[j] = sigmoidf_(a0v[j] + ca[j]); k2[j] = ks_[j] * (1.0f + (a[j] - 1.0f) * kav[j]); }
                kraw[ct] = ks_ * kkv; av[ct] = a; ssq += (kraw[ct][0] * kraw[ct][0] + kraw[ct][1] * kraw[ct][1]) + (kraw[ct][2] * kraw[ct][2] + kraw[ct][3] * kraw[ct][3]);
                const size_t o = (size_t)t * 1024 + n;
                *(f32x4*)(R + o) = rs_; *(f32x4*)(W + o) = dec; *(f32x4*)(K2 + o) = k2; *(f32x4*)(V + o) = vs_; *(f32x4*)(G + o) = cg;
            }
            ssq += __shfl_xor(ssq, 16); ssq += __shfl_xor(ssq, 32);
            const float inv = fminf(__builtin_amdgcn_rsqf(ssq), 1e12f);
#pragma unroll
            for (int ct = 0; ct < 4; ++ct) { const size_t o = (size_t)t * 1024 + F.wave * 128 + hh * 64 + ct * 16 + 4 * q; const f32x4 kk = kraw[ct] * inv;
                *(f32x4*)(AA + o) = -kk; *(f32x4*)(BB + o) = kk * av[ct]; }
        }
        __syncthreads();
    }
}
DI void lds_read8(unsigned addr, f32x4 (&d)[8]) {
    asm volatile("ds_read_b128 %0, %8\n\tds_read_b128 %1, %8 offset:16\n\tds_read_b128 %2, %8 offset:32\n\tds_read_b128 %3, %8 offset:48\n\t"
                 "ds_read_b128 %4, %8 offset:64\n\tds_read_b128 %5, %8 offset:80\n\tds_read_b128 %6, %8 offset:96\n\tds_read_b128 %7, %8 offset:112\n\ts_waitcnt lgkmcnt(0)"
                 : "=&v"(d[0]), "=&v"(d[1]), "=&v"(d[2]), "=&v"(d[3]), "=&v"(d[4]), "=&v"(d[5]), "=&v"(d[6]), "=&v"(d[7]) : "v"(addr) : "memory");
}
DI void lds_read4x1(unsigned addr, f32x4& w, f32x4& b, f32x4& k, f32x4& r) {
    asm volatile("ds_read_b128 %0, %4\n\tds_read_b128 %1, %4 offset:256\n\tds_read_b128 %2, %4 offset:512\n\tds_read_b128 %3, %4 offset:768\n\ts_waitcnt lgkmcnt(0)"
                 : "=&v"(w), "=&v"(b), "=&v"(k), "=&v"(r) : "v"(addr) : "memory");
}
DI void phase_rw_local(const Ctx& F) {
    const float* AA = rwbuf(F, RW_AA); const float* W = rwbuf(F, RW_W); const float* BB = rwbuf(F, RW_BB); const float* K2 = rwbuf(F, RW_K); const float* R = rwbuf(F, RW_R); const float* V = rwbuf(F, RW_V);
    float* YL = rwbuf(F, RW_Y); float* QT = rwbuf(F, 8);
    bf16* MTb = (bf16*)(F.ws + WS_ACT); float* GTt = (float*)(F.ws + WS_ACT + 32 * MiB);
    LAS unsigned char* buf = F.lds + F.wave * 12288;
    const unsigned bufa = (unsigned)(size_t)buf;
    const int lane = F.lane;
    for (int unit = F.gw; unit < 2048; unit += F.NGW) {
        const int c = unit >> 4, h = unit & 15; const unsigned ob0 = (unsigned)(((c * 64) * 1024 + h * 64 + lane) * 4);
        float Sr[64], Si[64];
#pragma unroll
        for (int k = 0; k < 64; ++k) { Sr[k] = 0.f; Si[k] = (k == lane) ? 1.f : 0.f; }
#define RW_DMA(sub_, pb_) do { _Pragma("unroll") for (int s_ = 0; s_ < 4; ++s_) { const unsigned o_ = ob0 + (unsigned)((4 * (sub_) + s_) * 4096); LAS unsigned* lp_ = (LAS unsigned*)(buf + (pb_) * 6144 + s_ * 1536); \
            __builtin_amdgcn_global_load_lds((const unsigned*)((const char*)AA + o_), lp_, 4, 0, 0); __builtin_amdgcn_global_load_lds((const unsigned*)((const char*)W + o_), lp_ + 64, 4, 0, 0); __builtin_amdgcn_global_load_lds((const unsigned*)((const char*)BB + o_), lp_ + 128, 4, 0, 0); \
            __builtin_amdgcn_global_load_lds((const unsigned*)((const char*)K2 + o_), lp_ + 192, 4, 0, 0); __builtin_amdgcn_global_load_lds((const unsigned*)((const char*)R + o_), lp_ + 256, 4, 0, 0); __builtin_amdgcn_global_load_lds((const unsigned*)((const char*)V + o_), lp_ + 320, 4, 0, 0); } } while (0)
        RW_DMA(0, 0);
#pragma unroll 1
        for (int sub = 0; sub < 16; ++sub) {
            const int pb = sub & 1;
            asm volatile("s_waitcnt vmcnt(0)" ::: "memory");
            if (sub < 15) RW_DMA(sub + 1, pb ^ 1);
#pragma unroll 1
            for (int s = 0; s < 4; ++s) {
                const unsigned sa_ = bufa + (unsigned)(pb * 6144 + s * 1536);
                const float v = *(const LAS float*)(buf + pb * 6144 + s * 1536 + 1280 + 4 * lane);
                float sar0 = 0.f, sar1 = 0.f, sai0 = 0.f, sai1 = 0.f;
#pragma unroll
                for (int qd = 0; qd < 4; ++qd) { f32x4 d[4];
                    asm volatile("ds_read_b128 %0, %4\n\tds_read_b128 %1, %4 offset:16\n\tds_read_b128 %2, %4 offset:32\n\tds_read_b128 %3, %4 offset:48\n\ts_waitcnt lgkmcnt(0)"
                                 : "=&v"(d[0]), "=&v"(d[1]), "=&v"(d[2]), "=&v"(d[3]) : "v"(sa_ + (unsigned)(qd * 64)) : "memory");
#pragma unroll
                    for (int k4 = 0; k4 < 4; ++k4) { const int k = 16 * qd + 4 * k4; sar0 = fmaf(Sr[k], d[k4][0], sar0); sar1 = fmaf(Sr[k + 1], d[k4][1], sar1); sar0 = fmaf(Sr[k + 2], d[k4][2], sar0); sar1 = fmaf(Sr[k + 3], d[k4][3], sar1);
                        sai0 = fmaf(Si[k], d[k4][0], sai0); sai1 = fmaf(Si[k + 1], d[k4][1], sai1); sai0 = fmaf(Si[k + 2], d[k4][2], sai0); sai1 = fmaf(Si[k + 3], d[k4][3], sai1); } }
                const float sar = sar0 + sar1, sai = sai0 + sai1;
                float yr0 = 0.f, yi0 = 0.f;
#pragma unroll
                for (int g = 0; g < 16; ++g) {
                    f32x4 w4, b4, k4_, r4; lds_read4x1(sa_ + 256u + (unsigned)(g * 16), w4, b4, k4_, r4);
#pragma unroll
                    for (int j = 0; j < 4; ++j) { const int k = 4 * g + j;
                        float x = Sr[k] * w4[j]; x = fmaf(sar, b4[j], x); x = fmaf(v, k4_[j], x); Sr[k] = x;
                        float z = Si[k] * w4[j]; z = fmaf(sai, b4[j], z); Si[k] = z;
                        yr0 = fmaf(x, r4[j], yr0); yi0 = fmaf(z, r4[j], yi0); }
                }
                const unsigned o = ob0 + (unsigned)((4 * sub + s) * 4096);
                *(float*)((char*)YL + o) = yr0; *(float*)((char*)QT + o) = yi0;
            }
        }
#undef RW_DMA
        int lane2 = lane; asm volatile("" : "+v"(lane2));
        bf16* mp = MTb + (size_t)unit * 4096 + lane2; float* gp = GTt + (size_t)unit * 4096 + lane2;
#pragma unroll
        for (int k = 0; k < 64; ++k) { mp[k * 64] = (bf16)f2bf(Si[k]); gp[k * 64] = Sr[k]; }
        asm volatile("s_waitcnt vmcnt(0)" ::: "memory");
    }
}
DI void phase_rw_combine(const Ctx& F, int cw) {
    const bf16* MTb = (const bf16*)(F.ws + WS_ACT); const float* GTt = (const float*)(F.ws + WS_ACT + 32 * MiB); bf16* SCb = (bf16*)(F.ws + WS_F);
    const int h = cw >> 2, i0 = (cw & 3) * 16, lane = F.lane, r = lane & 15, q = lane >> 4;
    f32x4 X[4];
#pragma unroll
    for (int kt = 0; kt < 4; ++kt) X[kt] = (f32x4){0.f, 0.f, 0.f, 0.f};
    f32x4 gq[4]; v4u af[4][2];
#define RWC_LOAD(unit_) do { const bf16* mrow_ = MTb + (size_t)(unit_) * 4096 + 4 * q; const float* gcol_ = GTt + (size_t)(unit_) * 4096 + i0 + r; \
        _Pragma("unroll") for (int kt = 0; kt < 4; ++kt) { _Pragma("unroll") for (int e = 0; e < 4; ++e) gq[kt][e] = gcol_[(size_t)(16 * kt + 4 * q + e) * 64]; \
            _Pragma("unroll") for (int ks = 0; ks < 2; ++ks) { const bf16* ap_ = mrow_ + (size_t)(16 * kt + r) * 64 + 32 * ks; const v2u lo_ = *(const v2u*)ap_, hi_ = *(const v2u*)(ap_ + 16); af[kt][ks] = (v4u){lo_.x, lo_.y, hi_.x, hi_.y}; } } } while (0)
    RWC_LOAD(h);
#pragma unroll 1
    for (int c = 0; c < 128; ++c) {
        const int unit = c * 16 + h;
        bf16* sp = SCb + (size_t)unit * 4096 + (size_t)(i0 + r) * 64 + 4 * q;
        bf16x8 Bf[2];
        { v4u b0, b1;
          b0.x = pk2(X[0][0], X[0][1]); b0.y = pk2(X[0][2], X[0][3]); b0.z = pk2(X[1][0], X[1][1]); b0.w = pk2(X[1][2], X[1][3]);
          b1.x = pk2(X[2][0], X[2][1]); b1.y = pk2(X[2][2], X[2][3]); b1.z = pk2(X[3][0], X[3][1]); b1.w = pk2(X[3][2], X[3][3]);
          *(v2u*)(sp + 0) = (v2u){b0.x, b0.y}; *(v2u*)(sp + 16) = (v2u){b0.z, b0.w}; *(v2u*)(sp + 32) = (v2u){b1.x, b1.y}; *(v2u*)(sp + 48) = (v2u){b1.z, b1.w};
          Bf[0] = __builtin_bit_cast(bf16x8, b0); Bf[1] = __builtin_bit_cast(bf16x8, b1); }
        if (c == 127) break;
        f32x4 gc[4]; v4u ac[4][2];
#pragma unroll
        for (int kt = 0; kt < 4; ++kt) { gc[kt] = gq[kt]; ac[kt][0] = af[kt][0]; ac[kt][1] = af[kt][1]; }
        if (c < 126) RWC_LOAD(unit + 16);
#pragma unroll
        for (int kt = 0; kt < 4; ++kt) {
            f32x4 acc = gc[kt];
#pragma unroll
            for (int ks = 0; ks < 2; ++ks) acc = MFMA16(__builtin_bit_cast(bf16x8, ac[kt][ks]), Bf[ks], acc);
            X[kt] = acc;
        }
    }
#undef RWC_LOAD
}
DI void phase_rw_out(const Ctx& F, const InTab in, int l) {
    const float* YL = rwbuf(F, RW_Y); const float* QT = rwbuf(F, 8); const float* R = rwbuf(F, RW_R); const float* K2 = rwbuf(F, RW_K); const float* V = rwbuf(F, RW_V); const float* G = rwbuf(F, RW_G);
    const bf16* SCb = (const bf16*)(F.ws + WS_F);
    const float* r_k = in[15] + (size_t)l * 1024; const float* lg = in[16] + (size_t)l * 1024; const float* lb = in[17] + (size_t)l * 1024;
    bf16* YO = (bf16*)(F.ws + WS_Y);
    const int lane = F.lane, r = lane & 15, q = lane >> 4;
    for (int unit = F.gw; unit < 2048; unit += F.NGW) {
        const int c = unit >> 4, h = unit & 15, t0 = c * 64;
        bf16x8 Sf[4][2];
#pragma unroll
        for (int it = 0; it < 4; ++it)
#pragma unroll
            for (int ks = 0; ks < 2; ++ks) Sf[it][ks] = *(const bf16x8*)(SCb + (size_t)unit * 4096 + (size_t)(16 * it + r) * 64 + 32 * ks + 8 * q);
#pragma unroll 1
        for (int tt = 0; tt < 4; ++tt) {
            const int t = t0 + 16 * tt + r; const size_t ob = (size_t)t * 1024 + h * 64;
            bf16x8 Af[2];
#pragma unroll
            for (int ks = 0; ks < 2; ++ks) { const f32x4 x0 = *(const f32x4*)(QT + ob + 32 * ks + 8 * q), x1 = *(const f32x4*)(QT + ob + 32 * ks + 8 * q + 4);
                v4u o; o.x = pk2(x0[0], x0[1]); o.y = pk2(x0[2], x0[3]); o.z = pk2(x1[0], x1[1]); o.w = pk2(x1[2], x1[3]); Af[ks] = __builtin_bit_cast(bf16x8, o); }
            f32x4 y[4], rr[4], kk[4], vv[4]; float s = 0.f, bs = 0.f;
#pragma unroll
            for (int it = 0; it < 4; ++it) { const size_t o = ob + 16 * it + 4 * q;
                f32x4 acc = *(const f32x4*)(YL + o);
#pragma unroll
                for (int ks = 0; ks < 2; ++ks) acc = MFMA16(Sf[it][ks], Af[ks], acc);
                y[it] = acc; rr[it] = *(const f32x4*)(R + o); kk[it] = *(const f32x4*)(K2 + o); vv[it] = *(const f32x4*)(V + o);
                const f32x4 rk = *(const f32x4*)(r_k + h * 64 + 16 * it + 4 * q);
#pragma unroll
                for (int e = 0; e < 4; ++e) { s += acc[e]; bs += rr[it][e] * kk[it][e] * rk[e]; } }
            s += __shfl_xor(s, 16); s += __shfl_xor(s, 32); bs += __shfl_xor(bs, 16); bs += __shfl_xor(bs, 32);
            const float mean = s * (1.0f / 64.0f); float q2 = 0.f;
#pragma unroll
            for (int it = 0; it < 4; ++it)
#pragma unroll
                for (int e = 0; e < 4; ++e) { const float d = y[it][e] - mean; q2 += d * d; }
            q2 += __shfl_xor(q2, 16); q2 += __shfl_xor(q2, 32);
            const float rstd = __builtin_amdgcn_rsqf(q2 * (1.0f / 64.0f) + 64e-5f);
#pragma unroll
            for (int it = 0; it < 4; ++it) { const int ch = h * 64 + 16 * it + 4 * q; const f32x4 g4 = *(const f32x4*)(lg + ch), b4 = *(const f32x4*)(lb + ch), gg = *(const f32x4*)(G + (size_t)t * 1024 + ch); float ov[4];
#pragma unroll
                for (int e = 0; e < 4; ++e) ov[e] = (((y[it][e] - mean) * rstd) * g4[e] + b4[e] + bs * vv[it][e]) * gg[e];
                v2u w; w.x = pk2(ov[0], ov[1]); w.y = pk2(ov[2], ov[3]); *(v2u*)(YO + (size_t)t * 1024 + ch) = w; }
        }
    }
}
DI void phase_dsa_prep(const Ctx& F, const InTab in, int l) {
    const bf16* Z = (const bf16*)(F.ws + WS_Z); bf16* DC = (bf16*)(F.ws + WS_DC); bf16* DKI = (bf16*)(F.ws + WS_DKI); float* DWI = (float*)(F.ws + WS_DWI);
    const float* cg = in[18] + (size_t)l * 256; const float* kg = in[19] + (size_t)l * 64;
    const f32x4 cg4 = *(const f32x4*)(cg + 4 * F.lane); const float kg1 = kg[F.lane];
    for (int t = F.gw; t < T; t += F.NGW) {
        const v2u c = *(const v2u*)(Z + (size_t)t * NZ + ZCKV + 4 * F.lane);
        f32x4 cv = (f32x4){bflo(c.x), bfhi(c.x), bflo(c.y), bfhi(c.y)};
        const float ss = wave_sum((cv[0] * cv[0] + cv[1] * cv[1]) + (cv[2] * cv[2] + cv[3] * cv[3]));
        cv = cv * __builtin_amdgcn_rsqf(ss * (1.0f / 256.0f) + EPS) * cg4;
        v2u o; o.x = pk2(cv[0], cv[1]); o.y = pk2(cv[2], cv[3]); *(v2u*)(DC + (size_t)t * 256 + 4 * F.lane) = o;
        const float kv = bf2f(Z[(size_t)t * NZ + ZKI + F.lane]);
        const float ks = wave_sum(kv * kv);
        DKI[(size_t)t * 64 + F.lane] = (bf16)f2bf(kv * __builtin_amdgcn_rsqf(ks * (1.0f / 64.0f) + EPS) * kg1);
        if (F.lane < 16) DWI[(size_t)t * 16 + F.lane] = bf2f(Z[(size_t)t * NZ + ZWI + F.lane]) * (1.0f / 32.0f);
    }
    const bf16* WUK = (const bf16*)(F.ws + WS_WUK); bf16* DQL = (bf16*)(F.ws + WS_DQL);
    for (int it = F.gw; it < 256 * 8; it += F.NGW) { const int mt = it >> 3, h = it & 7;
#pragma unroll 1
        for (int nt = 0; nt < 8; ++nt)
            wave_gemm32_bf16(Z + (size_t)(mt * 32) * NZ + ZDQ + h * 128, NZ, WUK + (size_t)h * 256 * 128 + (size_t)(nt * 32) * 128, 128, 128, DQL + (size_t)(mt * 32) * 2048 + h * 256 + nt * 32, 2048, F.lane); }
}
DI void phase_dsa_index(const Ctx& F, int wi, int nw) {
    const bf16* Z = (const bf16*)(F.ws + WS_Z); const bf16* DKI = (const bf16*)(F.ws + WS_DKI); const float* DWI = (const float*)(F.ws + WS_DWI); float* DSC = (float*)(F.ws + WS_DSC);
    const int r = F.lane & 31, hh = F.lane >> 5;
    for (int task = wi; task < 4608; task += nw) {
        int c = 0, rem = task; while (rem >= 1024 - 128 * c) { rem -= 1024 - 128 * c; ++c; }
        const int g = 128 * c + rem, t0 = 8 * g, kstart = 1024 * c; int kend = kstart + 1024; if (kend > t0 + 8) kend = t0 + 8;
        const int nblk = (kend - kstart + 31) >> 5;
        bf16x8 A[4][4]; float wv[4][2][8];
#pragma unroll
        for (int rb = 0; rb < 4; ++rb) { const int tok = t0 + 2 * rb + (r >> 4), head = r & 15;
#pragma unroll
            for (int s = 0; s < 4; ++s) A[rb][s] = *(const bf16x8*)(Z + (size_t)tok * NZ + ZQI + head * 64 + 16 * s + 8 * hh);
#pragma unroll
            for (int tk = 0; tk < 2; ++tk)
#pragma unroll
                for (int i = 0; i < 8; ++i) wv[rb][tk][i] = DWI[(size_t)(t0 + 2 * rb + tk) * 16 + (i & 3) + 8 * (i >> 2) + 4 * hh]; }
#pragma unroll 1
        for (int kb = 0; kb < nblk; ++kb) {
            const int s0 = kstart + 32 * kb;
            bf16x8 B[4];
#pragma unroll
            for (int s = 0; s < 4; ++s) B[s] = *(const bf16x8*)(DKI + (size_t)(s0 + r) * 64 + 16 * s + 8 * hh);
#pragma unroll
            for (int rb = 0; rb < 4; ++rb) {
                f32x16 x;
#pragma unroll
                for (int i = 0; i < 16; ++i) x[i] = 0.f;
#pragma unroll
                for (int s = 0; s < 4; ++s) x = MFMA32(A[rb][s], B[s], x);
                float p0 = 0.f, p1 = 0.f;
#pragma unroll
                for (int i = 0; i < 8; ++i) { p0 = fmaf(wv[rb][0][i], fmaxf(x[i], 0.f), p0); p1 = fmaf(wv[rb][1][i], fmaxf(x[8 + i], 0.f), p1); }
                p0 += __shfl_xor(p0, 32); p1 += __shfl_xor(p1, 32);
                DSC[(size_t)(t0 + 2 * rb + hh) * T + s0 + r] = hh ? p1 : p0;
            }
        }
    }
}
DI unsigned fkey(float f) { const unsigned u = __float_as_uint(f); return (u & 0x80000000u) ? ~u : (u | 0x80000000u); }
DI void phase_dsa_topk(const Ctx& F) {
    const float* DSC = (const float*)(F.ws + WS_DSC); int* IDX = (int*)(F.ws + WS_DIDX);
    LAS unsigned* hist = (LAS unsigned*)(F.lds + F.wave * 8192);
    const int lane = F.lane;
    for (int t = F.gw; t < T; t += F.NGW) {
        const int n = t + 1; int* out = IDX + (size_t)t * 256; const float* row = DSC + (size_t)t * T + lane;
        if (n <= 256) { for (int i = lane; i < 256; i += 64) out[i] = i < n ? i : -1; continue; }
        const int nreg = (n + 63) >> 6;
        unsigned key[128];
#pragma unroll
        for (int g = 0; g < 8; ++g) {
            if (16 * g < nreg) {
#pragma unroll
                for (int j = 0; j < 16; ++j) { const int i = 16 * g + j; key[i] = (64 * i + lane < n) ? fkey(row[64 * i]) : 0u; }
            } else {
#pragma unroll
                for (int j = 0; j < 16; ++j) key[16 * g + j] = 0u;
            }
        }
        unsigned prefix = 0u, mask = 0u; int need = 256;
#pragma unroll
        for (int pass = 0; pass < 3; ++pass) {
            const int shift = pass == 0 ? 21 : (pass == 1 ? 10 : 0); const unsigned bm = pass == 2 ? 1023u : 2047u;
#pragma unroll
            for (int j = 0; j < 8; ++j) *(LAS v4u*)(hist + 4 * lane + 256 * j) = (v4u){0u, 0u, 0u, 0u};
            LDS_WAIT(); asm volatile("" ::: "memory");
#pragma unroll
            for (int g = 0; g < 8; ++g) {
                if (16 * g < nreg) {
#pragma unroll
                    for (int j = 0; j < 16; ++j) { const unsigned u = key[16 * g + j]; if (u != 0u && (u & mask) == prefix) __hip_atomic_fetch_add(hist + ((u >> shift) & bm), 1u, __ATOMIC_RELAXED, __HIP_MEMORY_SCOPE_WORKGROUP); }
                }
            }
            LDS_WAIT(); asm volatile("" ::: "memory");
            int ct = 0;
#pragma unroll
            for (int j = 0; j < 8; ++j) { const v4u c4 = *(const LAS v4u*)(hist + 32 * lane + 4 * j); ct += (int)(c4.x + c4.y) + (int)(c4.z + c4.w); }
            int incl = ct;
#pragma unroll
            for (int o = 1; o < 64; o <<= 1) { const int v = __shfl_down(incl, o); if (lane + o < 64) incl += v; }
            const int above = incl - ct;
            const bool target = (above < need) && (incl >= need);
            int bin_l = 0, cab_l = 0;
            if (target) { int cum = above; bool done = false;
#pragma unroll 1
                for (int j = 7; j >= 0 && !done; --j) { const v4u c4 = *(const LAS v4u*)(hist + 32 * lane + 4 * j); const unsigned cc[4] = {c4.x, c4.y, c4.z, c4.w};
#pragma unroll
                    for (int e = 3; e >= 0; --e) { if (!done) { if (cum + (int)cc[e] >= need) { bin_l = 32 * lane + 4 * j + e; cab_l = cum; done = true; } else cum += (int)cc[e]; } } } }
            LDS_WAIT(); asm volatile("" ::: "memory");
            const unsigned long long bal = __ballot(target); const int src = bal ? (__ffsll((long long)bal) - 1) : 0;
            const int bin = __shfl(bin_l, src), cab = __shfl(cab_l, src);
            need -= cab; prefix |= ((unsigned)bin) << shift; mask |= bm << shift;
        }
        const int ngt = 256 - need; int cgt = 0, ceq = 0; const unsigned long long lt = (1ull << lane) - 1ull;
#pragma unroll
        for (int g = 0; g < 8; ++g) {
            if (16 * g < nreg) {
#pragma unroll
                for (int j = 0; j < 16; ++j) { const int i = 16 * g + j; const unsigned u = key[i];
                    const bool gt = u > prefix, eq = u == prefix;
                    const unsigned long long bg = __ballot(gt), be = __ballot(eq);
                    if (gt) { const int pos = cgt + __popcll(bg & lt); if (pos < 256) out[pos] = 64 * i + lane; }
                    if (eq) { const int pe = ceq + __popcll(be & lt); if (pe < need) out[ngt + pe] = 64 * i + lane; }
                    cgt += __popcll(bg); ceq += __popcll(be); }
            }
        }
    }
}
constexpr int ATT_RS = 544;
DI void phase_dsa_attn(const Ctx& F, const InTab in) {
    const bf16* DC = (const bf16*)(F.ws + WS_DC); const bf16* DQL = (const bf16*)(F.ws + WS_DQL); const int* IDX = (const int*)(F.ws + WS_DIDX); bf16* DOL = (bf16*)(F.ws + WS_DOL);
    LAS int* tab = (LAS int*)(F.lds + 139264); LAS float* rbs = (LAS float*)(F.lds + 139264 + 512);
    if (F.tid < 128) { const int nn = F.tid; int b;
        if (nn < 16) b = nn; else { b = 16 + (nn >= 19) + (nn >= 21) + (nn >= 24) + (nn >= 27) + (nn >= 31) + (nn >= 35) + (nn >= 40) + (nn >= 46) + (nn >= 52) + (nn >= 59) + (nn >= 67) + (nn >= 77) + (nn >= 87) + (nn >= 99) + (nn >= 113); }
        tab[nn] = b; }
    if (F.tid < 256) rbs[F.tid] = in[22][F.tid];
    __syncthreads();
    LAS unsigned char* tile = F.lds + F.wave * (32 * ATT_RS);
    const unsigned tile_a = (unsigned)(size_t)tile;
    const int lane = F.lane, r = lane & 15, q = lane >> 4, head = r & 7;
    for (int t = F.gw; t < T; t += F.NGW) {
        const int cnt = t + 1 < 256 ? t + 1 : 256, nch = (cnt + 31) >> 5;
        bf16x8 Qf[8];
#pragma unroll
        for (int s = 0; s < 8; ++s) Qf[s] = *(const bf16x8*)(DQL + (size_t)t * 2048 + head * 256 + 32 * s + 8 * q);
        f32x4 OT[16];
#pragma unroll
        for (int d = 0; d < 16; ++d) OT[d] = (f32x4){0.f, 0.f, 0.f, 0.f};
        float mrun = -INFINITY, lrun = 0.f;
#pragma unroll 1
        for (int ch = 0; ch < nch; ++ch) {
            const int slot_l = 32 * ch + (lane & 31);
            int idxv = slot_l < cnt ? IDX[(size_t)t * 256 + slot_l] : 0;
#pragma unroll
            for (int i = 0; i < 16; ++i) { const int row = 2 * i + (lane >> 5); const int src = __shfl(idxv, row);
                const v4u v = *(const v4u*)(DC + (size_t)src * 256 + 8 * (lane & 31)); *(LAS v4u*)(tile + row * ATT_RS + 16 * (lane & 31)) = v; }
            LDS_WAIT(); asm volatile("" ::: "memory");
            f32x4 st[2];
#pragma unroll
            for (int rt = 0; rt < 2; ++rt) { st[rt] = (f32x4){0.f, 0.f, 0.f, 0.f};
#pragma unroll
                for (int s = 0; s < 8; ++s) { const bf16x8 cf = *(const LAS bf16x8*)(tile + (16 * rt + r) * ATT_RS + (32 * s + 8 * q) * 2); st[rt] = MFMA16(cf, Qf[s], st[rt]); } }
            float p[2][4]; float cmax = -INFINITY;
#pragma unroll
            for (int rt = 0; rt < 2; ++rt)
#pragma unroll
                for (int e = 0; e < 4; ++e) { const int kl = 16 * rt + 4 * q + e; const int kidx = __shfl(idxv, kl); const int dist = t - kidx;
                    const int bkt = dist < 128 ? tab[dist < 0 ? 0 : dist] : 31; const float lg = (32 * ch + kl < cnt) ? st[rt][e] + rbs[bkt * 8 + head] : -INFINITY;
                    p[rt][e] = lg; cmax = fmaxf(cmax, lg); }
            cmax = fmaxf(cmax, __shfl_xor(cmax, 16)); cmax = fmaxf(cmax, __shfl_xor(cmax, 32));
            const float mnew = fmaxf(mrun, cmax); const float alpha = fexp(mrun - mnew); float psum = 0.f;
#pragma unroll
            for (int rt = 0; rt < 2; ++rt)
#pragma unroll
                for (int e = 0; e < 4; ++e) { p[rt][e] = fexp(p[rt][e] - mnew); psum += p[rt][e]; }
            psum += __shfl_xor(psum, 16); psum += __shfl_xor(psum, 32);
            lrun = lrun * alpha + psum; mrun = mnew;
            v4u pbw; pbw.x = pk2(p[0][0], p[0][1]); pbw.y = pk2(p[0][2], p[0][3]); pbw.z = pk2(p[1][0], p[1][1]); pbw.w = pk2(p[1][2], p[1][3]);
            const bf16x8 pb = __builtin_bit_cast(bf16x8, pbw);
            const unsigned ra = tile_a + (unsigned)((4 * q + (r >> 2)) * ATT_RS + 8 * (r & 3));
#pragma unroll
            for (int d = 0; d < 16; ++d) { OT[d] = OT[d] * alpha;
                const bf16x4 lo = tr_read(ra + 32 * d), hi = tr_read(ra + 16 * ATT_RS + 32 * d);
                OT[d] = MFMA16(cat8(lo, hi), pb, OT[d]); }
        }
        const float inv = frcp(lrun);
        if (r < 8) {
#pragma unroll
            for (int d = 0; d < 16; ++d) { v2u w; w.x = pk2(OT[d][0] * inv, OT[d][1] * inv); w.y = pk2(OT[d][2] * inv, OT[d][3] * inv);
                *(v2u*)(DOL + (size_t)t * 2048 + head * 256 + 16 * d + 4 * q) = w; }
        }
    }
}
DI void phase_dsa_uv(const Ctx& F) {
    const bf16* DOL = (const bf16*)(F.ws + WS_DOL); const bf16* WUV = (const bf16*)(F.ws + WS_WUV); bf16* YO = (bf16*)(F.ws + WS_Y) + (size_t)T * 1024;
    for (int it = F.gw; it < 256 * 8; it += F.NGW) { const int mt = it >> 3, h = it & 7;
#pragma unroll 1
        for (int nt = 0; nt < 4; ++nt)
            wave_gemm32_bf16(DOL + (size_t)(mt * 32) * 2048 + h * 256, 2048, WUV + (size_t)h * 128 * 256 + (size_t)(nt * 32) * 256, 256, 256, YO + (size_t)(mt * 32) * 1024 + h * 128 + nt * 32, 1024, F.lane); }
}
DI float* ml_small(const Ctx& F, int off_floats) { return (float*)(F.ws + WS_MSM) + off_floats; }
constexpr int MS_LI = 0, MS_LF = 32768, MS_GC = 65536, MS_GTOT = 98304, MS_WMAX = 98560, MS_MST = 98816, MS_NLOC = 99072, MS_NST = 99072 + 32768;
DI float log_sigmoid(float x) { return flog_sigmoid(x); }
DI void phase_ml_prep(const Ctx& F, const InTab in, int l) {
    const bf16* Z = (const bf16*)(F.ws + WS_Z); bf16* MQK = (bf16*)(F.ws + WS_MQK);
    const float* cw = in[23] + (size_t)l * 4 * 1024; const float* b_i = in[24] + (size_t)l * 4; const float* b_f = in[25] + (size_t)l * 4;
    float* LI = ml_small(F, MS_LI); float* LF = ml_small(F, MS_LF);
    const int c0 = 16 * F.lane; const float qs = c0 < 512 ? 0.08838834764831845f : 1.0f;
    for (int t = F.gw; t < T; t += F.NGW) {
        float acc[16];
#pragma unroll
        for (int e = 0; e < 16; ++e) acc[e] = 0.f;
#pragma unroll
        for (int j = 0; j < 4; ++j) { const int tt = t - 3 + j; if (tt < 0) continue;
            const v4u z0 = *(const v4u*)(Z + (size_t)tt * NZ + ZMQ + c0), z1 = *(const v4u*)(Z + (size_t)tt * NZ + ZMQ + c0 + 8);
            const unsigned zw[8] = {z0.x, z0.y, z0.z, z0.w, z1.x, z1.y, z1.z, z1.w};
#pragma unroll
            for (int e = 0; e < 8; ++e) { const f32x2 w2 = *(const f32x2*)(cw + (size_t)j * 1024 + c0 + 2 * e); acc[2 * e] = fmaf(w2[0], bflo(zw[e]), acc[2 * e]); acc[2 * e + 1] = fmaf(w2[1], bfhi(zw[e]), acc[2 * e + 1]); } }
        unsigned w[8];
#pragma unroll
        for (int e = 0; e < 8; ++e) { const float a = acc[2 * e], b = acc[2 * e + 1]; w[e] = pk2(a * sigmoidf_(a) * qs, b * sigmoidf_(b) * qs); }
        v4u* op = (v4u*)(MQK + (size_t)t * 1024 + c0); op[0] = (v4u){w[0], w[1], w[2], w[3]}; op[1] = (v4u){w[4], w[5], w[6], w[7]};
        if (F.lane < 4) LI[t * 4 + F.lane] = bf2f(Z[(size_t)t * NZ + ZMI + F.lane]) + b_i[F.lane];
        else if (F.lane < 8) LF[t * 4 + F.lane - 4] = log_sigmoid(bf2f(Z[(size_t)t * NZ + ZMF + F.lane - 4]) + b_f[F.lane - 4]);
    }
}
constexpr int ML_KRS = 288, ML_VRS = 544;
DI void phase_ml_local(const Ctx& F) {
    const bf16* Z = (const bf16*)(F.ws + WS_Z); const bf16* MQK = (const bf16*)(F.ws + WS_MQK); float* MKL = (float*)(F.ws + WS_MKL);
    float* LI = ml_small(F, MS_LI); float* LF = ml_small(F, MS_LF); float* GC = ml_small(F, MS_GC); float* GTOT = ml_small(F, MS_GTOT); float* WMAX = ml_small(F, MS_WMAX); float* NLOC = ml_small(F, MS_NLOC);
    LAS unsigned char* vt = F.lds; LAS unsigned char* kt = F.lds + 128 * ML_VRS; LAS float* wgt = (LAS float*)(F.lds + 128 * ML_VRS + 128 * ML_KRS);
    const int lane = F.lane, r = lane & 15, q = lane >> 4;
    for (int unit = F.bid; unit < 256; unit += F.G) {
        const int c = unit >> 2, h = unit & 3, t0 = c * 128;
        if (F.wave == 0) {
            float f0 = LF[(t0 + 2 * lane) * 4 + h], f1 = LF[(t0 + 2 * lane + 1) * 4 + h];
            float s = f0 + f1;
#pragma unroll
            for (int o = 1; o < 64; o <<= 1) { const float v = __shfl_up(s, o); if (lane >= o) s += v; }
            const float g1 = s, g0 = s - f1;
            const float gtot = __shfl(g1, 63);
            GC[(t0 + 2 * lane) * 4 + h] = g0; GC[(t0 + 2 * lane + 1) * 4 + h] = g1;
            const float w0 = gtot - g0 + LI[(t0 + 2 * lane) * 4 + h], w1 = gtot - g1 + LI[(t0 + 2 * lane + 1) * 4 + h];
            const float wm = wave_max(fmaxf(w0, w1));
            wgt[2 * lane] = fexp(w0 - wm); wgt[2 * lane + 1] = fexp(w1 - wm);
            if (lane == 0) { GTOT[unit] = gtot; WMAX[unit] = wm; }
        }
        __syncthreads();
        for (int i = F.tid; i < 128 * 16; i += NTHR) { const int s = i >> 4, ch = i & 15;
            const v4u kv = *(const v4u*)(MQK + (size_t)(t0 + s) * 1024 + 512 + h * 128 + 8 * ch); const float wg = wgt[s];
            v4u o; o.x = pk2(bflo(kv.x) * wg, bfhi(kv.x) * wg); o.y = pk2(bflo(kv.y) * wg, bfhi(kv.y) * wg); o.z = pk2(bflo(kv.z) * wg, bfhi(kv.z) * wg); o.w = pk2(bflo(kv.w) * wg, bfhi(kv.w) * wg);
            *(LAS v4u*)(kt + s * ML_KRS + 16 * ch) = o; }
        for (int i = F.tid; i < 128 * 32; i += NTHR) { const int s = i >> 5, ch = i & 31;
            *(LAS v4u*)(vt + s * ML_VRS + 16 * ch) = *(const v4u*)(Z + (size_t)(t0 + s) * NZ + ZMV + h * 256 + 8 * ch); }
        __syncthreads();
        f32x4 acc[2][8];
#pragma unroll
        for (int i = 0; i < 2; ++i)
#pragma unroll
            for (int j = 0; j < 8; ++j) acc[i][j] = (f32x4){0.f, 0.f, 0.f, 0.f};
        const unsigned va = (unsigned)(size_t)vt + (unsigned)((r >> 2) * ML_VRS + 8 * (r & 3)), ka = (unsigned)(size_t)kt + (unsigned)((r >> 2) * ML_KRS + 8 * (r & 3));
#pragma unroll 1
        for (int ks = 0; ks < 4; ++ks) {
            bf16x8 af[2], bfr[8];
#pragma unroll
            for (int i = 0; i < 2; ++i) { const unsigned a0 = va + (unsigned)((32 * ks + 8 * q) * ML_VRS + 32 * (2 * F.wave + i)); af[i] = cat8(tr_read(a0), tr_read(a0 + 4 * ML_VRS)); }
#pragma unroll
            for (int j = 0; j < 8; ++j) { const unsigned b0 = ka + (unsigned)((32 * ks + 8 * q) * ML_KRS + 32 * j); bfr[j] = cat8(tr_read(b0), tr_read(b0 + 4 * ML_KRS)); }
#pragma unroll
            for (int i = 0; i < 2; ++i)
#pragma unroll
                for (int j = 0; j < 8; ++j) acc[i][j] = MFMA16(af[i], bfr[j], acc[i][j]);
        }
#pragma unroll
        for (int i = 0; i < 2; ++i)
#pragma unroll
            for (int j = 0; j < 8; ++j)
#pragma unroll
                for (int e = 0; e < 4; ++e) MKL[((size_t)unit * 256 + 16 * (2 * F.wave + i) + 4 * q + e) * 128 + 16 * j + r] = acc[i][j][e];
        if (F.tid < 128) { float s = 0.f; for (int ss = 0; ss < 128; ++ss) s += bf2f(*(const LAS bf16*)(kt + ss * ML_KRS + 2 * F.tid)); NLOC[unit * 128 + F.tid] = s; }
        __syncthreads();
    }
}
DI void phase_ml_scan(const Ctx& F) {
    const float* MKL = (const float*)(F.ws + WS_MKL); bf16* MCS = (bf16*)(F.ws + WS_MCS);
    const float* GTOT = ml_small(F, MS_GTOT); const float* WMAX = ml_small(F, MS_WMAX); float* MST = ml_small(F, MS_MST); const float* NLOC = ml_small(F, MS_NLOC); float* NST = ml_small(F, MS_NST);
    for (int idx = F.bid * NTHR + F.tid; idx < 4 * 256 * 128; idx += F.G * NTHR) {
        const int h = idx >> 15, e = (idx >> 7) & 255, d = idx & 127;
        float m = 0.f, cur = 0.f, ncur = 0.f;
        for (int c = 0; c < 64; ++c) { const int unit = c * 4 + h;
            MCS[((size_t)unit * 256 + e) * 128 + d] = (bf16)f2bf(cur);
            if (e == 0) { NST[unit * 128 + d] = ncur; if (d == 0) MST[unit] = m; }
            const float gt = GTOT[unit], wm = WMAX[unit]; const float mn = fmaxf(gt + m, wm); const float cd = fexp(gt + m - mn), cl = fexp(wm - mn);
            cur = cd * cur + cl * MKL[((size_t)unit * 256 + e) * 128 + d];
            if (e == 0) ncur = cd * ncur + cl * NLOC[unit * 128 + d];
            m = mn; }
    }
}
DI void phase_ml_out(const Ctx& F, const InTab in, int l) {
    const bf16* Z = (const bf16*)(F.ws + WS_Z); const bf16* MQK = (const bf16*)(F.ws + WS_MQK); const bf16* MCS = (const bf16*)(F.ws + WS_MCS);
    const float* LI = ml_small(F, MS_LI); const float* GC = ml_small(F, MS_GC); const float* MST = ml_small(F, MS_MST); const float* NST = ml_small(F, MS_NST);
    const float* hn = in[26] + (size_t)l * 1024; bf16* YO = (bf16*)(F.ws + WS_Y) + (size_t)2 * T * 1024;
    LAS unsigned char* vt = F.lds; LAS float* gcs = (LAS float*)(F.lds + 128 * ML_VRS); LAS float* lgs = gcs + 128; LAS float* pms = gcs + 256; LAS float* nsts = gcs + 384;
    const int lane = F.lane, r = lane & 15, q = lane >> 4, w = F.wave;
    for (int unit = F.bid; unit < 256; unit += F.G) {
        const int c = unit >> 2, h = unit & 3, t0 = c * 128;
        for (int i = F.tid; i < 128 * 32; i += NTHR) { const int s = i >> 5, ch = i & 31;
            *(LAS v4u*)(vt + s * ML_VRS + 16 * ch) = *(const v4u*)(Z + (size_t)(t0 + s) * NZ + ZMV + h * 256 + 8 * ch); }
        if (w == 0) {
            const float g0 = GC[(t0 + 2 * lane) * 4 + h], g1 = GC[(t0 + 2 * lane + 1) * 4 + h];
            const float l0 = LI[(t0 + 2 * lane) * 4 + h] - g0, l1 = LI[(t0 + 2 * lane + 1) * 4 + h] - g1;
            float pm = fmaxf(l0, l1);
#pragma unroll
            for (int o = 1; o < 64; o <<= 1) { const float v = __shfl_up(pm, o); if (lane >= o) pm = fmaxf(pm, v); }
            float pprev = __shfl_up(pm, 1); if (lane == 0) pprev = -INFINITY;
            gcs[2 * lane] = g0; gcs[2 * lane + 1] = g1; lgs[2 * lane] = l0; lgs[2 * lane + 1] = l1; pms[2 * lane] = fmaxf(pprev, l0); pms[2 * lane + 1] = pm;
        }
        if (w == 1) { nsts[lane] = NST[unit * 128 + lane]; nsts[64 + lane] = NST[unit * 128 + 64 + lane]; }
        __syncthreads();
        const int j = 16 * w + r; const float mst = MST[unit];
        const float gcj = gcs[j], alog = gcj + mst, mq = fmaxf(alog, gcj + pms[j]), inter = fexp(alog - mq), gm = gcj - mq;
        bf16x8 qf[4], qi[4];
#pragma unroll
        for (int ks = 0; ks < 4; ++ks) { const v4u qv = *(const v4u*)(MQK + (size_t)(t0 + j) * 1024 + h * 128 + 32 * ks + 8 * q); qf[ks] = __builtin_bit_cast(bf16x8, qv);
            v4u o; o.x = pk2(bflo(qv.x) * inter, bfhi(qv.x) * inter); o.y = pk2(bflo(qv.y) * inter, bfhi(qv.y) * inter); o.z = pk2(bflo(qv.z) * inter, bfhi(qv.z) * inter); o.w = pk2(bflo(qv.w) * inter, bfhi(qv.w) * inter);
            qi[ks] = __builtin_bit_cast(bf16x8, o); }
        const int nkp = (w >> 1) + 1;
        LAS v4u* pls = (LAS v4u*)(F.lds + 73728) + w * 256;
#pragma unroll 1
        for (int kp = 0; kp < nkp; ++kp) {
            float pv[8];
#pragma unroll
            for (int hf = 0; hf < 2; ++hf) { const int st = 2 * kp + hf;
                f32x4 sacc = (f32x4){0.f, 0.f, 0.f, 0.f};
                if (st <= w) {
                    const bf16* kr = MQK + (size_t)(t0 + 16 * st + r) * 1024 + 512 + h * 128 + 8 * q;
#pragma unroll
                    for (int ks = 0; ks < 4; ++ks) { const bf16x8 kf = *(const bf16x8*)(kr + 32 * ks); sacc = MFMA16(kf, qf[ks], sacc); }
                }
#pragma unroll
                for (int e = 0; e < 4; ++e) { const int s = 16 * st + 4 * q + e; pv[4 * hf + e] = (st <= w && s <= j) ? sacc[e] * fexp(gm + lgs[s]) : 0.f; } }
            v4u o; o.x = pk2(pv[0], pv[1]); o.y = pk2(pv[2], pv[3]); o.z = pk2(pv[4], pv[5]); o.w = pk2(pv[6], pv[7]); pls[kp * 64 + lane] = o;
        }
        LDS_WAIT(); asm volatile("" ::: "memory");
        const unsigned va = (unsigned)(size_t)vt + (unsigned)((r >> 2) * ML_VRS + 8 * (r & 3)) + (unsigned)(4 * q * ML_VRS);
        const bf16* crow = MCS + ((size_t)unit * 256 + r) * 128 + 8 * q;
        f32x4 dacc = (f32x4){0.f, 0.f, 0.f, 0.f};
#pragma unroll
        for (int ks = 0; ks < 4; ++ks) { v4u o = (v4u){0u, 0u, 0u, 0u};
            if (r == 0) { const LAS float* np = nsts + 32 * ks + 8 * q; o.x = pk2(np[0], np[1]); o.y = pk2(np[2], np[3]); o.z = pk2(np[4], np[5]); o.w = pk2(np[6], np[7]); }
            dacc = MFMA16(__builtin_bit_cast(bf16x8, o), qi[ks], dacc); }
#pragma unroll
        for (int kp = 0; kp < 4; ++kp) if (kp < nkp) { const unsigned one2 = r == 0 ? 0x3f803f80u : 0u; const v4u o = (v4u){one2, one2, one2, one2}; dacc = MFMA16(__builtin_bit_cast(bf16x8, o), __builtin_bit_cast(bf16x8, pls[kp * 64 + lane]), dacc); }
        const float den = __shfl(dacc[0], r);
        const float dinv = frcp(fmaxf(fabsf(den), fexp(-mq)));
        float ss = 0.f;
#pragma unroll 1
        for (int et = 0; et < 16; ++et) {
            f32x4 a = (f32x4){0.f, 0.f, 0.f, 0.f};
#pragma unroll
            for (int ks = 0; ks < 4; ++ks) { const bf16x8 cf = *(const bf16x8*)(crow + (size_t)(16 * et) * 128 + 32 * ks); a = MFMA16(cf, qi[ks], a); }
#pragma unroll
            for (int kp = 0; kp < 4; ++kp) if (kp < nkp) { const unsigned a0 = va + (unsigned)((32 * kp) * ML_VRS + 32 * et); a = MFMA16(cat8(tr_read(a0), tr_read(a0 + 16 * ML_VRS)), __builtin_bit_cast(bf16x8, pls[kp * 64 + lane]), a); }
            a = a * dinv; ss += (a[0] * a[0] + a[1] * a[1]) + (a[2] * a[2] + a[3] * a[3]);
        }
        ss += __shfl_xor(ss, 16); ss += __shfl_xor(ss, 32);
        const float rinv = __builtin_amdgcn_rsqf(ss * (1.0f / 256.0f) + EPS) * dinv;
        const int t = t0 + j;
#pragma unroll 1
        for (int et = 0; et < 16; ++et) {
            f32x4 a = (f32x4){0.f, 0.f, 0.f, 0.f};
#pragma unroll
            for (int ks = 0; ks < 4; ++ks) { const bf16x8 cf = *(const bf16x8*)(crow + (size_t)(16 * et) * 128 + 32 * ks); a = MFMA16(cf, qi[ks], a); }
#pragma unroll
            for (int kp = 0; kp < 4; ++kp) if (kp < nkp) { const unsigned a0 = va + (unsigned)((32 * kp) * ML_VRS + 32 * et); a = MFMA16(cat8(tr_read(a0), tr_read(a0 + 16 * ML_VRS)), __builtin_bit_cast(bf16x8, pls[kp * 64 + lane]), a); }
            const int e0 = 16 * et + 4 * q; const v2u ov = *(const v2u*)(Z + (size_t)t * NZ + ZMO + h * 256 + e0); const f32x4 g4 = *(const f32x4*)(hn + h * 256 + e0);
            const float o0 = sigmoidf_(bflo(ov.x)) * a[0] * rinv * g4[0], o1 = sigmoidf_(bfhi(ov.x)) * a[1] * rinv * g4[1], o2 = sigmoidf_(bflo(ov.y)) * a[2] * rinv * g4[2], o3 = sigmoidf_(bfhi(ov.y)) * a[3] * rinv * g4[3];
            v2u wv; wv.x = pk2(o0, o1); wv.y = pk2(o2, o3); *(v2u*)(YO + (size_t)t * 1024 + h * 256 + e0) = wv;
        }
        __syncthreads();
    }
}
constexpr int NPH = 20;
#ifndef PROBE_MASK
#define PROBE_MASK 0u
#endif
#ifndef MK_PER_PHASE
#define MK_PER_PHASE 0
#endif

template <int PH> __global__ void __launch_bounds__(NTHR, 2) mega(Args args) {
    extern __shared__ __attribute__((aligned(16))) unsigned char lds_raw[];
    LAS unsigned char* glds = (LAS unsigned char*)lds_raw;
    const int wave_s = __builtin_amdgcn_readfirstlane((int)(threadIdx.x >> 6));
    for (int u = threadIdx.x; u < (LDS_BYTES - LDSCTL_OFF) / 4; u += NTHR) ((LAS unsigned*)(glds + LDSCTL_OFF))[u] = 0u;
    __syncthreads();
    const int lo = args.ph_lo, hi = args.ph_hi;
    if (hi - lo > 1) (void)xcd_barrier_post((unsigned*)(opaque_ws(args) + WS_CTL) + CW_BAR, (volatile LAS unsigned*)(glds + MISC_OFF));
    const InTab in{&args};
#pragma unroll
    for (int l = 0; l < NL; ++l) {
        const int pb = l * NPH;
#define IN(k) ((PH < 0 || PH == (k)) && lo <= pb + (k) && pb + (k) < hi)
#define SEAM(k) do { if (IN(k) && pb + (k) + 1 < hi) { XcdBarrier b_; b_.bar = (unsigned*)(opaque_ws(args) + WS_CTL) + CW_BAR; b_.x = xb_xcc_id(); b_.st = (volatile LAS unsigned*)(glds + MISC_OFF); b_.t0 = (wave_s == 0) && (lane_id() == 0); xcd_barrier(b_); } } while (0)
#define SEAMX(k, more) do { if (IN(k) && ((more) || pb + (k) + 1 < hi)) { XcdBarrier b_; b_.bar = (unsigned*)(opaque_ws(args) + WS_CTL) + CW_BAR; b_.x = xb_xcc_id(); b_.st = (volatile LAS unsigned*)(glds + MISC_OFF); b_.t0 = (wave_s == 0) && (lane_id() == 0); xcd_barrier(b_); } } while (0)
#define PHX const Ctx F = make_ctx(args, glds, wave_s); unsigned char* ws = F.ws; bf16* HB = (bf16*)(ws + WS_HB); bf16* ACT = (bf16*)(ws + WS_ACT); float* FB = (float*)(ws + WS_F); bf16* Zb = (bf16*)(ws + WS_Z); float* RS = (float*)(ws + WS_RS); float* FSS = (float*)(ws + WS_FSS); \
        const float* ng = in[2] + (size_t)l * 8 * D; (void)HB; (void)ACT; (void)FB; (void)Zb; (void)RS; (void)FSS; (void)ng;
        for (int rep_ = 0; rep_ < 1 + (int)((PROBE_MASK >> 0) & 1u); ++rep_) {
        if (IN(0)) { PHX phase_conv(F, in, l); if (l == 0) phase_resid<true>(F, in[0], nullptr, 0.f, args.out); }
        SEAMX(0, rep_ + 1 < 1 + (int)((PROBE_MASK >> 0) & 1u)); }
        for (int rep_ = 0; rep_ < 1 + (int)((PROBE_MASK >> 1) & 1u); ++rep_) {
        if (IN(1)) { PHX pg8::Gemm g{HB, (const bf16*)(ws + WS_WGU1), T, 2 * FF, D}; pg8::StaticOrder S; S.init(T, 2 * FF, F.G, F.bid);
            pg8::EpiSwiglu E{ACT, FF, RS, 1.0f / D, EPS}; pg8::gemm_phase<pg8::EpiSwiglu, pg8::StaticOrder, true, true>(glds, g, S, E, F.tid); }
        SEAMX(1, rep_ + 1 < 1 + (int)((PROBE_MASK >> 1) & 1u)); }
        for (int rep_ = 0; rep_ < 1 + (int)((PROBE_MASK >> 2) & 1u); ++rep_) {
        if (IN(2)) { PHX pg8::Gemm g{ACT, (const bf16*)(ws + WS_WD1), T, D, FF}; pg8::StaticOrder S; S.init(T, D, F.G, F.bid);
            pg8::EpiF32SS E{FB, D, FSS}; pg8::gemm_phase<pg8::EpiF32SS, pg8::StaticOrder, true, true>(glds, g, S, E, F.tid); }
        SEAMX(2, rep_ + 1 < 1 + (int)((PROBE_MASK >> 2) & 1u)); }
        for (int rep_ = 0; rep_ < 1 + (int)((PROBE_MASK >> 3) & 1u); ++rep_) {
        if (IN(3)) { PHX phase_resid<false>(F, FB, ng + 1 * D, 0.5f, args.out); }
        SEAMX(3, rep_ + 1 < 1 + (int)((PROBE_MASK >> 3) & 1u)); }
        for (int rep_ = 0; rep_ < 1 + (int)((PROBE_MASK >> 4) & 1u); ++rep_) {
        if (IN(4)) { PHX pg8::Gemm g{HB, (const bf16*)(ws + WS_WIN), T, NZ, D}; pg8::StaticOrder S; S.init(T, NZ, F.G, F.bid);
            pg8::EpiScaleBf16 E{Zb, NZ, RS, 1.0f / D, EPS}; pg8::gemm_phase<pg8::EpiScaleBf16, pg8::StaticOrder, true, true>(glds, g, S, E, F.tid); }
        SEAMX(4, rep_ + 1 < 1 + (int)((PROBE_MASK >> 4) & 1u)); }
        for (int rep_ = 0; rep_ < 1 + (int)((PROBE_MASK >> 5) & 1u); ++rep_) {
        if (IN(5)) { PHX phase_rw_prep(F, in, l); phase_dsa_prep(F, in, l); phase_ml_prep(F, in, l); }
        SEAMX(5, rep_ + 1 < 1 + (int)((PROBE_MASK >> 5) & 1u)); }
        for (int rep_ = 0; rep_ < 1 + (int)((PROBE_MASK >> 6) & 1u); ++rep_) {
        if (IN(6)) { PHX phase_rw_local(F); }
        SEAMX(6, rep_ + 1 < 1 + (int)((PROBE_MASK >> 6) & 1u)); }
        for (int rep_ = 0; rep_ < 1 + (int)((PROBE_MASK >> 7) & 1u); ++rep_) {
        if (IN(7)) { PHX
            if (F.wave == 0 && F.bid < 64) phase_rw_combine(F, F.bid);
            else { const int nskip = F.bid < 64 ? F.bid + 1 : 64; phase_dsa_index(F, F.gw - nskip, F.NGW - 64); }
            __syncthreads(); phase_ml_local(F); }
        SEAMX(7, rep_ + 1 < 1 + (int)((PROBE_MASK >> 7) & 1u)); }
        for (int rep_ = 0; rep_ < 1 + (int)((PROBE_MASK >> 8) & 1u); ++rep_) {
        if (IN(8)) { PHX phase_dsa_topk(F); phase_ml_scan(F); phase_rw_out(F, in, l); }
        SEAMX(8, rep_ + 1 < 1 + (int)((PROBE_MASK >> 8) & 1u)); }
        for (int rep_ = 0; rep_ < 1 + (int)((PROBE_MASK >> 9) & 1u); ++rep_) {
        if (IN(9)) { PHX
            __syncthreads(); phase_dsa_attn(F, in);
            __syncthreads(); phase_ml_out(F, in, l);
        }
        SEAMX(9, rep_ + 1 < 1 + (int)((PROBE_MASK >> 9) & 1u)); }
        for (int rep_ = 0; rep_ < 1 + (int)((PROBE_MASK >> 10) & 1u); ++rep_) {
        if (IN(10)) { PHX phase_dsa_uv(F); }
        SEAMX(10, rep_ + 1 < 1 + (int)((PROBE_MASK >> 10) & 1u)); }
        for (int rep_ = 0; rep_ < 1 + (int)((PROBE_MASK >> 11) & 1u); ++rep_) {
        if (IN(11)) { PHX pg8::Gemm g{(const bf16*)(ws + WS_Y), (const bf16*)(ws + WS_WBR), 3 * T, 3 * D, 1024}; pg8::BranchOrder S{F.G, F.bid};
            pg8::EpiBranch E{FB, (bf16*)(ws + WS_MIXG), Zb, NZ, ZG}; pg8::gemm_phase<pg8::EpiBranch, pg8::BranchOrder, true, true>(glds, g, S, E, F.tid); }
        SEAMX(11, rep_ + 1 < 1 + (int)((PROBE_MASK >> 11) & 1u)); }
        for (int rep_ = 0; rep_ < 1 + (int)((PROBE_MASK >> 12) & 1u); ++rep_) {
        if (IN(12)) { PHX pg8::Gemm g{(const bf16*)(ws + WS_MIXG), (const bf16*)(ws + WS_WOUT), T, D, D}; pg8::StaticOrder S; S.init(T, D, F.G, F.bid);
            pg8::EpiF32SS E{FB, D, FSS}; pg8::gemm_phase<pg8::EpiF32SS, pg8::StaticOrder, true, true>(glds, g, S, E, F.tid); }
        SEAMX(12, rep_ + 1 < 1 + (int)((PROBE_MASK >> 12) & 1u)); }
        for (int rep_ = 0; rep_ < 1 + (int)((PROBE_MASK >> 13) & 1u); ++rep_) {
        if (IN(13)) { PHX phase_resid<false>(F, FB, ng + 3 * D, 1.0f, args.out); }
        SEAMX(13, rep_ + 1 < 1 + (int)((PROBE_MASK >> 13) & 1u)); }
        for (int rep_ = 0; rep_ < 1 + (int)((PROBE_MASK >> 14) & 1u); ++rep_) {
        if (IN(14)) { PHX pg8::Gemm g{HB, (const bf16*)(ws + WS_WGU2), T, 2 * FF, D}; pg8::StaticOrder S; S.init(T, 2 * FF, F.G, F.bid);
            pg8::EpiSwiglu E{ACT, FF, RS, 1.0f / D, EPS}; pg8::gemm_phase<pg8::EpiSwiglu, pg8::StaticOrder, true, true>(glds, g, S, E, F.tid); }
        SEAMX(14, rep_ + 1 < 1 + (int)((PROBE_MASK >> 14) & 1u)); }
        for (int rep_ = 0; rep_ < 1 + (int)((PROBE_MASK >> 15) & 1u); ++rep_) {
        if (IN(15)) { PHX pg8::Gemm g{ACT, (const bf16*)(ws + WS_WD2), T, D, FF}; pg8::StaticOrder S; S.init(T, D, F.G, F.bid);
            pg8::EpiF32SS E{FB, D, FSS}; pg8::gemm_phase<pg8::EpiF32SS, pg8::StaticOrder, true, true>(glds, g, S, E, F.tid); }
        SEAMX(15, rep_ + 1 < 1 + (int)((PROBE_MASK >> 15) & 1u)); }
        for (int rep_ = 0; rep_ < 1 + (int)((PROBE_MASK >> 16) & 1u); ++rep_) {
        if (IN(16)) { PHX phase_resid<false>(F, FB, ng + 5 * D, 0.5f, args.out); }
        SEAMX(16, rep_ + 1 < 1 + (int)((PROBE_MASK >> 16) & 1u)); }
        for (int rep_ = 0; rep_ < 1 + (int)((PROBE_MASK >> 17) & 1u); ++rep_) {
        if (IN(17)) { PHX int kple = PLE; asm volatile("" : "+s"(kple)); pg8::Gemm g{(const bf16*)(ws + WS_PB), (const bf16*)(ws + WS_WPP), T, D, kple}; pg8::StaticOrder S; S.init(T, D, F.G, F.bid);
            pg8::EpiScaleBf16 E{(bf16*)(ws + WS_E), D, nullptr, 0.f, 0.f}; pg8::gemm_phase<pg8::EpiScaleBf16, pg8::StaticOrder, true, true>(glds, g, S, E, F.tid); }
        SEAMX(17, rep_ + 1 < 1 + (int)((PROBE_MASK >> 17) & 1u)); }
        for (int rep_ = 0; rep_ < 1 + (int)((PROBE_MASK >> 18) & 1u); ++rep_) {
        if (IN(18)) { PHX pg8::Gemm g{HB, (const bf16*)(ws + WS_WPG), T, D, D}; pg8::StaticOrder S; S.init(T, D, F.G, F.bid);
            pg8::EpiPleGate E{FB, D, FSS, RS, (const bf16*)(ws + WS_E), 1.0f / D, EPS}; pg8::gemm_phase<pg8::EpiPleGate, pg8::StaticOrder, true, true>(glds, g, S, E, F.tid); }
        SEAMX(18, rep_ + 1 < 1 + (int)((PROBE_MASK >> 18) & 1u)); }
        for (int rep_ = 0; rep_ < 1 + (int)((PROBE_MASK >> 19) & 1u); ++rep_) {
        if (IN(19)) { PHX phase_resid<false>(F, FB, ng + 7 * D, 1.0f, args.out); }
        SEAMX(19, rep_ + 1 < 1 + (int)((PROBE_MASK >> 19) & 1u)); }
#undef IN
#undef SEAM
#undef PHX
#undef SEAMX
    }
}

extern "C" void kernel_launch(void* const* d_in, const int* in_sizes, int n_in, void* d_out, int out_size, void* d_ws, size_t ws_size, hipStream_t stream) {
    static int grid = 0;
    if (grid == 0) {
        if (n_in != 34 || in_sizes[0] != T * D || out_size != T * D || ws_size < WS_END) { fprintf(stderr, "kernel_launch: unexpected problem (n_in %d, in0 %d, out %d, ws %zu < %zu); nothing launched\n", n_in, n_in > 0 ? in_sizes[0] : -1, out_size, ws_size, (size_t)WS_END); grid = -1; return; }
        int dev = 0, cus = 0;
        if (hipGetDevice(&dev) != hipSuccess || hipDeviceGetAttribute(&cus, hipDeviceAttributeMultiprocessorCount, dev) != hipSuccess) { grid = -1; return; }
        grid = cus;
    }
    if (grid < 0) return;
    (void)hipMemsetAsync((char*)d_ws + WS_CTL, 0, CTL_ZERO_BYTES, stream);
    Args a{};
    for (int i = 0; i < 34; ++i) a.in[i] = (const float*)d_in[i];
    a.out = (float*)d_out; a.ws = (unsigned char*)d_ws;
#if MK_PER_PHASE
    typedef void (*kfn)(Args);
    static const kfn tab[NPH] = { mega<0>, mega<1>, mega<2>, mega<3>, mega<4>, mega<5>, mega<6>, mega<7>, mega<8>, mega<9>, mega<10>, mega<11>, mega<12>, mega<13>, mega<14>, mega<15>, mega<16>, mega<17>, mega<18>, mega<19> };
    static bool attr = false;
    if (!attr) { for (int k = 0; k < NPH; ++k) if (hipFuncSetAttribute((const void*)tab[k], hipFuncAttributeMaxDynamicSharedMemorySize, LDS_BYTES) != hipSuccess) fprintf(stderr, "kernel_launch: hipFuncSetAttribute failed (phase %d)\n", k); attr = true; }
    for (int p = 0; p < NL * NPH; ++p) { a.ph_lo = p; a.ph_hi = p + 1; hipLaunchKernelGGL(tab[p % NPH], dim3(grid), dim3(NTHR), LDS_BYTES, stream, a); }
#else
    static bool attr = false;
    if (!attr) { if (hipFuncSetAttribute((const void*)mega<-1>, hipFuncAttributeMaxDynamicSharedMemorySize, LDS_BYTES) != hipSuccess) fprintf(stderr, "kernel_launch: hipFuncSetAttribute failed\n"); attr = true; }
    a.ph_lo = 0; a.ph_hi = NL * NPH; hipLaunchKernelGGL(mega<-1>, dim3(grid), dim3(NTHR), LDS_BYTES, stream, a);
#endif
}
```
